# Optimizing an MI355X kernel written in HIP

```python
import math
import jax, jax.numpy as jnp
from jax import lax
import numpy as np

D_MODEL = 1024
BATCH = 4
SEQ = 4096
DEPTH = 1

D_SSM = 512
SSM_CH = 16
SSM_GROUPS = D_SSM // SSM_CH
SSM_STATE = 64
D_ATT = 512
HEAD_DIM = 64
N_HEADS = D_ATT // HEAD_DIM
N_KV = 2
HPG = N_HEADS // N_KV
D_KV = N_KV * HEAD_DIM
N_BRANCH = 3
D_IN = D_SSM + D_ATT + 6 * D_KV + N_BRANCH * N_HEADS
D_MIX = D_SSM + D_ATT
CMP_STRIDE = 16
CMP_BLOCK = 2 * CMP_STRIDE
CMP_HIDDEN = 256
SEL_BLOCK = 64
N_SELECT = 16
WINDOW = 512
Q_BLOCK = 128
N_EXP_GROUPS = 4
EXPERTS_PER_GROUP = 8
N_EXPERTS = N_EXP_GROUPS * EXPERTS_PER_GROUP
TOP_K = 2
D_EXPERT = 256

EPS = 1e-6
NEG = -1e30
FORCE = 1e9

kernel_name = "hymba_s5_nsa_hier_moe"


def rms_norm(x, g):
    xf = x.astype(jnp.float32)
    y = xf * lax.rsqrt(jnp.mean(xf * xf, axis=-1, keepdims=True) + EPS)
    return (y * g.astype(jnp.float32)).astype(x.dtype)


def s5_mixer(u, lam_re, lam_im, log_step, b_re, b_im, c_re, c_im, d_skip, w_glu, b_glu):
    f32 = jnp.float32
    bsz, L, _ = u.shape
    ug = u.astype(f32).reshape(bsz, L, SSM_GROUPS, SSM_CH)
    lam = lax.complex(lam_re.astype(f32), lam_im.astype(f32))
    step = jnp.exp(log_step.astype(f32))[:, None]
    lam_bar = jnp.exp(lam * step)
    b = lax.complex(b_re.astype(f32), b_im.astype(f32))
    b_bar = ((lam_bar - 1.0) / lam)[..., None] * b
    bu = lax.complex(jnp.einsum('gph,blgh->blgp', jnp.real(b_bar), ug),
                     jnp.einsum('gph,blgh->blgp', jnp.imag(b_bar), ug))
    a = jnp.broadcast_to(lam_bar, bu.shape)

    def combine(left, right):
        a_l, b_l = left
        a_r, b_r = right
        return a_r * a_l, a_r * b_l + b_r

    _, states = lax.associative_scan(combine, (a, bu), axis=1)
    y = (jnp.einsum('ghp,blgp->blgh', c_re.astype(f32), jnp.real(states))
         - jnp.einsum('ghp,blgp->blgh', c_im.astype(f32), jnp.imag(states))
         + d_skip.astype(f32) * ug)
    y = jax.nn.gelu(y.reshape(bsz, L, D_SSM))
    y = y * jax.nn.sigmoid(y @ w_glu.astype(f32) + b_glu.astype(f32))
    return y.astype(u.dtype)


def compress_blocks(t, pos, w1, w2):
    bsz, L = t.shape[0], t.shape[1]
    chunks = t.reshape(bsz, L // CMP_STRIDE, CMP_STRIDE, N_KV, HEAD_DIM)
    blocks = jnp.concatenate([chunks[:, :-1], chunks[:, 1:]], axis=2)
    blocks = blocks + pos[None, None, :, None, :]
    nc = blocks.shape[1]
    flat = blocks.transpose(0, 1, 3, 2, 4).reshape(bsz, nc, N_KV, CMP_BLOCK * HEAD_DIM)
    return jax.nn.gelu(flat @ w1) @ w2


def nsa_mixer(att, g_q, g_kc, g_ks, g_kw, pos_k, pos_v, w_ck1, w_ck2, w_cv1, w_cv2):
    f32 = jnp.float32
    bsz, L, _ = att.shape
    splits = [D_ATT + i * D_KV for i in range(7)]
    q, kc, vc, ks, vs, kw, vw, gate = jnp.split(att, splits, axis=-1)
    kv_shape = (bsz, L, N_KV, HEAD_DIM)
    q = rms_norm(q.reshape(bsz, L, N_KV, HPG, HEAD_DIM), g_q) * (HEAD_DIM ** -0.5)
    ks = rms_norm(ks.reshape(kv_shape), g_ks)
    vs = vs.reshape(kv_shape)
    kw = rms_norm(kw.reshape(kv_shape), g_kw)
    vw = vw.reshape(kv_shape)
    qpos = jnp.arange(L)

    kcmp = rms_norm(compress_blocks(kc.reshape(kv_shape), pos_k, w_ck1, w_ck2), g_kc)
    vcmp = compress_blocks(vc.reshape(kv_shape), pos_v, w_cv1, w_cv2)
    nc = kcmp.shape[1]
    cstart = jnp.arange(nc) * CMP_STRIDE
    cmask = (cstart[None, :] + CMP_BLOCK - 1) <= qpos[:, None]
    s = jnp.einsum('blghd,bcgd->bghlc', q, kcmp).astype(f32)
    s = jnp.where(cmask, s, NEG)
    p_cmp = jax.nn.softmax(s, axis=-1) * jnp.any(cmask, axis=-1)[:, None].astype(f32)
    o_cmp = jnp.einsum('bghlc,bcgd->blghd', p_cmp.astype(vcmp.dtype), vcmp)

    ns = L // SEL_BLOCK
    sstart = jnp.arange(ns) * SEL_BLOCK
    overlap = ((cstart[:, None] < sstart[None, :] + SEL_BLOCK)
               & (cstart[:, None] + CMP_BLOCK > sstart[None, :])).astype(f32)
    imp = jnp.einsum('bghlc,cs->bgls', p_cmp, overlap)
    cur = qpos // SEL_BLOCK
    blk = jnp.arange(ns)
    valid = blk[None, :] <= cur[:, None]
    forced = (blk[None, :] == 0) | (blk[None, :] == cur[:, None]) | (blk[None, :] == cur[:, None] - 1)
    imp = jnp.where(forced, FORCE, jnp.where(valid, imp, NEG))
    n_sel = min(N_SELECT, ns)
    _, idx = lax.top_k(imp, n_sel)

    ks_blk = ks.reshape(bsz, ns, SEL_BLOCK, N_KV, HEAD_DIM).transpose(0, 3, 1, 2, 4)
    vs_blk = vs.reshape(bsz, ns, SEL_BLOCK, N_KV, HEAD_DIM).transpose(0, 3, 1, 2, 4)
    nq = L // Q_BLOCK
    q_chunks = q.reshape(bsz, nq, Q_BLOCK, N_KV, HPG, HEAD_DIM).transpose(1, 0, 2, 3, 4, 5)
    idx_chunks = idx.reshape(bsz, N_KV, nq, Q_BLOCK, n_sel).transpose(2, 0, 1, 3, 4)
    starts = jnp.arange(nq) * Q_BLOCK
    bi = jnp.arange(bsz)[:, None, None, None]
    gi = jnp.arange(N_KV)[None, :, None, None]

    def sel_block(args):
        qc, ic, st = args
        kb = ks_blk[bi, gi, ic]
        vb = vs_blk[bi, gi, ic]
        kpos = ic[..., None] * SEL_BLOCK + jnp.arange(SEL_BLOCK)
        tpos = st + jnp.arange(Q_BLOCK)
        m = kpos <= tpos[None, None, :, None, None]
        sc = jnp.einsum('bqghd,bgqnkd->bghqnk', qc, kb).astype(f32)
        sc = jnp.where(m[:, :, None], sc, NEG)
        sc = sc.reshape(bsz, N_KV, HPG, Q_BLOCK, n_sel * SEL_BLOCK)
        pr = jax.nn.softmax(sc, axis=-1).reshape(bsz, N_KV, HPG, Q_BLOCK, n_sel, SEL_BLOCK)
        return jnp.einsum('bghqnk,bgqnkd->bqghd', pr.astype(vb.dtype), vb)

    o_sel = lax.map(sel_block, (q_chunks, idx_chunks, starts))
    o_sel = o_sel.transpose(1, 0, 2, 3, 4, 5).reshape(bsz, L, N_KV, HPG, HEAD_DIM)

    pad = WINDOW // Q_BLOCK
    kw_p = jnp.pad(kw, ((0, 0), (WINDOW, 0), (0, 0), (0, 0))).reshape(bsz, nq + pad, Q_BLOCK, N_KV, HEAD_DIM)
    vw_p = jnp.pad(vw, ((0, 0), (WINDOW, 0), (0, 0), (0, 0))).reshape(bsz, nq + pad, Q_BLOCK, N_KV, HEAD_DIM)
    kw_band = jnp.concatenate([kw_p[:, i:i + nq] for i in range(pad + 1)], axis=2)
    vw_band = jnp.concatenate([vw_p[:, i:i + nq] for i in range(pad + 1)], axis=2)
    qb = q.reshape(bsz, nq, Q_BLOCK, N_KV, HPG, HEAD_DIM)
    sw = jnp.einsum('bnqghd,bnkgd->bnghqk', qb, kw_band).astype(f32)
    qp = jnp.arange(nq)[:, None] * Q_BLOCK + jnp.arange(Q_BLOCK)[None, :]
    kp = jnp.arange(nq)[:, None] * Q_BLOCK - WINDOW + jnp.arange((pad + 1) * Q_BLOCK)[None, :]
    wm = ((kp[:, None, :] <= qp[:, :, None]) & (kp[:, None, :] > qp[:, :, None] - WINDOW)
          & (kp[:, None, :] >= 0))
    sw = jnp.where(wm[None, :, None, None], sw, NEG)
    pw = jax.nn.softmax(sw, axis=-1)
    o_win = jnp.einsum('bnghqk,bnkgd->bnqghd', pw.astype(vw_band.dtype), vw_band)
    o_win = o_win.reshape(bsz, L, N_KV, HPG, HEAD_DIM)

    g = jax.nn.sigmoid(gate.astype(f32)).reshape(bsz, L, N_KV, HPG, N_BRANCH).astype(att.dtype)
    o = g[..., 0:1] * o_cmp + g[..., 1:2] * o_sel + g[..., 2:3] * o_win
    return o.reshape(bsz, L, D_ATT)


def hier_moe(h, w_grp, b_grp, w_exp, b_exp, w_gate, w_up, w_down):
    f32 = jnp.float32
    bsz, L, D = h.shape
    t = h.reshape(-1, D)
    n_tok = t.shape[0]
    glog = (t @ w_grp + b_grp).astype(f32)
    gprob = jax.nn.softmax(glog, axis=-1)
    gsel = jnp.argmax(glog, axis=-1)
    elog = (t @ w_exp + b_exp).astype(f32).reshape(n_tok, N_EXP_GROUPS, EXPERTS_PER_GROUP)
    elog_sel = jnp.take_along_axis(elog, gsel[:, None, None], axis=1)[:, 0]
    eprob = jax.nn.softmax(elog_sel, axis=-1)
    topv, topi = lax.top_k(eprob, TOP_K)
    topv = topv / jnp.sum(topv, axis=-1, keepdims=True)
    wsel = topv * jnp.take_along_axis(gprob, gsel[:, None], axis=1)
    eid = gsel[:, None] * EXPERTS_PER_GROUP + topi
    comb = jnp.sum(jax.nn.one_hot(eid, N_EXPERTS, dtype=f32) * wsel[..., None], axis=1)
    out = jnp.zeros((n_tok, D), f32)
    for e in range(N_EXPERTS):
        a = jax.nn.silu(t @ w_gate[e]) * (t @ w_up[e])
        out = out + comb[:, e:e + 1] * (a @ w_down[e]).astype(f32)
    return out.reshape(bsz, L, D).astype(h.dtype)


def setup_inputs(seed: int = 0) -> dict:
    key = jax.random.key(seed)
    ks = jax.random.split(key, 34)
    nrm = lambda k, shape, s: jax.random.normal(k, shape, jnp.float32) * s
    L = DEPTH
    G, P, H = SSM_GROUPS, SSM_STATE, SSM_CH
    lam_im0 = jnp.broadcast_to(jnp.pi * jnp.arange(P, dtype=jnp.float32), (L, G, P))
    return {
        "x": nrm(ks[0], (BATCH, SEQ, D_MODEL), 1.0),
        "norm1_g": 1.0 + nrm(ks[1], (L, D_MODEL), 0.02),
        "w_in": nrm(ks[2], (L, D_MODEL, D_IN), D_MODEL ** -0.5),
        "lam_re": -0.5 + nrm(ks[3], (L, G, P), 0.01),
        "lam_im": lam_im0 + nrm(ks[4], (L, G, P), 0.01),
        "log_step": jax.random.uniform(ks[5], (L, G), jnp.float32, math.log(1e-3), math.log(1e-1)),
        "b_re": nrm(ks[6], (L, G, P, H), (2 * H) ** -0.5),
        "b_im": nrm(ks[7], (L, G, P, H), (2 * H) ** -0.5),
        "c_re": nrm(ks[8], (L, G, H, P), (2 * P) ** -0.5),
        "c_im": nrm(ks[9], (L, G, H, P), (2 * P) ** -0.5),
        "d_skip": nrm(ks[10], (L, G, H), 1.0),
        "w_glu": nrm(ks[11], (L, D_SSM, D_SSM), D_SSM ** -0.5),
        "b_glu": nrm(ks[12], (L, D_SSM), 0.01),
        "g_q": 1.0 + nrm(ks[13], (L, HEAD_DIM), 0.02),
        "g_kc": 1.0 + nrm(ks[14], (L, HEAD_DIM), 0.02),
        "g_ks": 1.0 + nrm(ks[15], (L, HEAD_DIM), 0.02),
        "g_kw": 1.0 + nrm(ks[16], (L, HEAD_DIM), 0.02),
        "pos_k": nrm(ks[17], (L, CMP_BLOCK, HEAD_DIM), 0.02),
        "pos_v": nrm(ks[18], (L, CMP_BLOCK, HEAD_DIM), 0.02),
        "w_ck1": nrm(ks[19], (L, CMP_BLOCK * HEAD_DIM, CMP_HIDDEN), (CMP_BLOCK * HEAD_DIM) ** -0.5),
        "w_ck2": nrm(ks[20], (L, CMP_HIDDEN, HEAD_DIM), CMP_HIDDEN ** -0.5),
        "w_cv1": nrm(ks[21], (L, CMP_BLOCK * HEAD_DIM, CMP_HIDDEN), (CMP_BLOCK * HEAD_DIM) ** -0.5),
        "w_cv2": nrm(ks[22], (L, CMP_HIDDEN, HEAD_DIM), CMP_HIDDEN ** -0.5),
        "out_g_ssm": 1.0 + nrm(ks[23], (L, D_SSM), 0.02),
        "out_g_att": 1.0 + nrm(ks[24], (L, D_ATT), 0.02),
        "w_out": nrm(ks[25], (L, D_MIX, D_MODEL), D_MIX ** -0.5),
        "norm2_g": 1.0 + nrm(ks[26], (L, D_MODEL), 0.02),
        "w_grp": nrm(ks[27], (L, D_MODEL, N_EXP_GROUPS), D_MODEL ** -0.5),
        "b_grp": nrm(ks[28], (L, N_EXP_GROUPS), 0.01),
        "w_exp": nrm(ks[29], (L, D_MODEL, N_EXPERTS), D_MODEL ** -0.5),
        "b_exp": nrm(ks[30], (L, N_EXPERTS), 0.01),
        "w_gate": nrm(ks[31], (L, N_EXPERTS, D_MODEL, D_EXPERT), D_MODEL ** -0.5),
        "w_up": nrm(ks[32], (L, N_EXPERTS, D_MODEL, D_EXPERT), D_MODEL ** -0.5),
        "w_down": nrm(ks[33], (L, N_EXPERTS, D_EXPERT, D_MODEL), D_EXPERT ** -0.5),
    }


def reference(x, norm1_g, w_in, lam_re, lam_im, log_step, b_re, b_im, c_re, c_im, d_skip,
              w_glu, b_glu, g_q, g_kc, g_ks, g_kw, pos_k, pos_v, w_ck1, w_ck2, w_cv1, w_cv2,
              out_g_ssm, out_g_att, w_out, norm2_g, w_grp, b_grp, w_exp, b_exp,
              w_gate, w_up, w_down):
    for l in range(DEPTH):
        h = rms_norm(x, norm1_g[l])
        proj = h @ w_in[l]
        y_ssm = s5_mixer(proj[..., :D_SSM], lam_re[l], lam_im[l], log_step[l], b_re[l], b_im[l],
                         c_re[l], c_im[l], d_skip[l], w_glu[l], b_glu[l])
        y_att = nsa_mixer(proj[..., D_SSM:], g_q[l], g_kc[l], g_ks[l], g_kw[l], pos_k[l], pos_v[l],
                          w_ck1[l], w_ck2[l], w_cv1[l], w_cv2[l])
        mix = jnp.concatenate([rms_norm(y_ssm, out_g_ssm[l]), rms_norm(y_att, out_g_att[l])], axis=-1)
        x = x + mix @ w_out[l]
        x = x + hier_moe(rms_norm(x, norm2_g[l]), w_grp[l], b_grp[l], w_exp[l], b_exp[l],
                         w_gate[l], w_up[l], w_down[l])
    return x
```

```cpp
#define MK_ONE_LAUNCH 1
#include <hip/hip_runtime.h>
#include <stdint.h>
#include <cstdio>

#define DI __device__ __forceinline__
typedef unsigned short bf16_t;
typedef short bf16x8 __attribute__((ext_vector_type(8)));
typedef short s16x4 __attribute__((ext_vector_type(4)));
typedef float f32x16 __attribute__((ext_vector_type(16)));
typedef float f32x4 __attribute__((ext_vector_type(4)));
typedef unsigned u32x4 __attribute__((ext_vector_type(4)));
typedef unsigned u32x2 __attribute__((ext_vector_type(2)));

constexpr int T = 16384, SEQ = 4096, NBATCH = 4, DM = 1024, DIN = 1816;
constexpr int NTHREADS = 512;
constexpr float EPS = 1e-6f;

constexpr size_t al256(size_t x) { return (x + 255) & ~(size_t)255; }
constexpr size_t OFF_CTL   = 0;
constexpr size_t CTL_BYTES = 65536;
constexpr size_t OFF_XN    = OFF_CTL + CTL_BYTES;
constexpr size_t OFF_U     = OFF_XN + (size_t)T * 1024 * 2;
constexpr size_t OFF_QN    = OFF_U + (size_t)T * 512 * 2;
constexpr size_t KV_BYTES  = (size_t)8 * 4096 * 64 * 2;
constexpr size_t OFF_KC    = OFF_QN + (size_t)T * 512 * 2;
constexpr size_t OFF_VC    = OFF_KC + KV_BYTES;
constexpr size_t OFF_KSN   = OFF_VC + KV_BYTES;
constexpr size_t OFF_KWN   = OFF_KSN + KV_BYTES;
constexpr size_t OFF_VST   = OFF_KWN + KV_BYTES;
constexpr size_t OFF_VWT   = OFF_VST + KV_BYTES;
constexpr size_t OFF_GATES = OFF_VWT + KV_BYTES;
constexpr size_t OFF_TGT   = OFF_GATES + (size_t)T * 24 * 4;
constexpr size_t OFF_EGT   = OFF_TGT + (size_t)32 * 512 * 512 * 2;
constexpr size_t OFF_FGT   = OFF_EGT + (size_t)32 * 128 * 512 * 2;
constexpr size_t OFF_LAM32 = OFF_FGT + (size_t)32 * 512 * 128 * 2;
constexpr size_t OFF_BIASP = OFF_LAM32 + 32 * 64 * 2 * 4;
constexpr size_t OFF_Z     = OFF_BIASP + 2 * 16 * 256 * 4;
constexpr size_t OFF_SIN   = OFF_Z + (size_t)32 * 512 * 128 * 4;
constexpr size_t OFF_P     = OFF_SIN + (size_t)32 * 512 * 128 * 2;
constexpr size_t OFF_KCMP  = OFF_P + (size_t)2 * 8 * 2 * 256 * 256 * 4;
constexpr size_t OFF_VCMPT = OFF_KCMP + 8 * 256 * 64 * 2;
constexpr size_t OFF_Y1    = OFF_VCMPT + 8 * 64 * 256 * 2;
constexpr size_t OFF_H2HI  = OFF_U;
constexpr size_t OFF_H2LO  = OFF_TGT;
constexpr size_t OFF_ACT   = OFF_Y1;
constexpr size_t OFF_LIST  = OFF_Y1 + (size_t)T * 512 * 2;
constexpr size_t OFF_LISTW = OFF_LIST + (size_t)64 * T * 4;
constexpr size_t OFF_RS2   = OFF_LISTW + (size_t)64 * T * 4;
constexpr size_t OFF_SSQ   = OFF_RS2 + (size_t)T * 4;
constexpr size_t OFF_WINT  = OFF_SSQ + (size_t)T * 2 * 4;
constexpr size_t OFF_WGLUT = OFF_WINT + (size_t)1816 * 1024 * 2;
constexpr size_t OFF_WC1T  = OFF_WGLUT + (size_t)512 * 512 * 2;
constexpr size_t OFF_WOUTT = OFF_WC1T + (size_t)4 * 256 * 1024 * 2;
constexpr size_t OFF_WRT   = OFF_WOUTT + (size_t)1024 * 1024 * 2;
constexpr size_t OFF_WGUT  = OFF_WRT + (size_t)2 * 40 * 1024 * 2;
constexpr size_t OFF_WDT   = OFF_WGUT + (size_t)32 * 512 * 1024 * 2;
constexpr size_t WS_END    = OFF_WDT + (size_t)32 * 1024 * 256 * 2;
static_assert(OFF_H2HI + (size_t)T * 1024 * 2 <= OFF_KC, "h2hi overlay");
static_assert(OFF_H2LO + (size_t)T * 1024 * 2 <= OFF_SIN, "h2lo overlay");
static_assert(WS_END <= (size_t)256 * 1024 * 1024, "workspace");

constexpr int CW_CNT = 8192;
constexpr int CNT_STRIDE = 32;
constexpr int CW_WQ = 4736;
constexpr int CW_S0DONE = 4608;
constexpr int CW_DONE = 12288;
constexpr int CW_PDONE = 4864;
constexpr int CW_BAR = 1024;

constexpr int LDS_BYTES = 151552;
constexpr int BM = 256, BN = 128, BK = 64;
constexpr int LSTR = 72;
constexpr int A_TILE = BM * LSTR;
constexpr int B_TILE = BN * LSTR;
constexpr int STAGE_ELEMS = A_TILE + B_TILE;
constexpr int CT_STRIDE = 132;
constexpr int STAGE2_ELEMS = (BM + 256) * LSTR;

struct Params {
    const float* in[34];
    float* out;
    unsigned char* ws;
    int ph_lo, ph_hi;
};

DI unsigned f2bf(float f) { unsigned u = __builtin_bit_cast(unsigned, f); return (u + 0x7fffu + ((u >> 16) & 1u)) >> 16; }
DI float bf2f(unsigned b) { return __builtin_bit_cast(float, b << 16); }
typedef float f32x2 __attribute__((ext_vector_type(2)));
typedef __bf16 bf16x2_t __attribute__((ext_vector_type(2)));
DI unsigned pk2(float lo, float hi) { f32x2 v = {lo, hi}; bf16x2_t b = __builtin_convertvector(v, bf16x2_t); return __builtin_bit_cast(unsigned, b); }
DI float wave_sum(float v) {
#pragma unroll
    for (int o = 1; o < 64; o <<= 1) v += __shfl_xor(v, o);
    return v;
}
DI float gelu_tanh(float x) {
    const float k0 = 0.7978845608028654f, k1 = 0.044715f;
    float u = k0 * (x + k1 * x * x * x);
    float e = __expf(2.f * u);
    float th = 1.f - 2.f / (e + 1.f);
    return 0.5f * x * (1.f + th);
}
DI float sigmoidf(float x) { return 1.f / (1.f + __expf(-x)); }
DI int vbid() { const int G = gridDim.x, b = blockIdx.x; return (G & 7) == 0 ? (b & 7) * (G >> 3) + (b >> 3) : b; }
DI int crow(int reg, int h) { return (reg & 3) + 8 * (reg >> 2) + 4 * h; }
#define MFMA32(a, b, c) __builtin_amdgcn_mfma_f32_32x32x16_bf16((a), (b), (c), 0, 0, 0)

#define XB_TMO      128
#define XB_XCNT(j)  (256  + 64 * (j))
#define XB_XSUB(j)  (1280 + 64 * (j))
#define XB_XGEN(j)  (2304 + 64 * (j))
#define XB_TOP      3328
#define XB_TOPGEN   3392
#define XCD_BAR_WORDS 3456
#define XB_SPIN_CAP (1u << 22)
DI unsigned xb_ld(unsigned* p)              { return __hip_atomic_load(p, __ATOMIC_RELAXED, __HIP_MEMORY_SCOPE_AGENT); }
DI unsigned xb_add(unsigned* p, unsigned v) { return __hip_atomic_fetch_add(p, v, __ATOMIC_RELAXED, __HIP_MEMORY_SCOPE_AGENT); }
DI unsigned xb_xcc_id() { return (unsigned)__builtin_amdgcn_s_getreg((3 << 11) | 20) & 0xFu; }
#define XB_SPIN(cond, bar) do { unsigned _sp = 0; while (cond) { __builtin_amdgcn_s_sleep(1); \
    if ((++_sp & 255u) == 0u) { if (xb_ld(&(bar)[XB_TMO])) break; if (_sp > XB_SPIN_CAP) { atomicAdd(&(bar)[XB_TMO], 1u); break; } } } } while (0)
struct XcdBarrier { unsigned* bar; unsigned x; volatile unsigned* st; };
DI XcdBarrier xcd_barrier_post(unsigned* bar, volatile unsigned* st) {
    XcdBarrier b; b.bar = bar; b.x = xb_xcc_id(); b.st = st;
    if (threadIdx.x == 0) (void)xb_add(&bar[XB_XCNT(b.x)], 1u);
    return b;
}
DI void xcd_barrier_complete(unsigned* bar, unsigned x, unsigned& nloc, unsigned& nx) {
    const unsigned G = gridDim.x;
    unsigned sum, cnt, mine, sp = 0u;
    for (;;) {
        sum = 0u; cnt = 0u; mine = 0u;
#pragma unroll
        for (unsigned j = 0; j < 16; ++j) { const unsigned c = xb_ld(&bar[XB_XCNT(j)]); sum += c; cnt += (c > 0u) ? 1u : 0u; mine = (j == x) ? c : mine; }
        if (sum == G) break;
        __builtin_amdgcn_s_sleep(1);
        if ((++sp & 255u) == 0u) { if (xb_ld(&bar[XB_TMO])) break; if (sp > XB_SPIN_CAP) { atomicAdd(&bar[XB_TMO], 1u); break; } }
    }
    nloc = mine > 0u ? mine : 1u; nx = cnt > 0u ? cnt : 1u;
}
DI void xcd_barrier(const XcdBarrier& b) {
    asm volatile("s_waitcnt vmcnt(0)" ::: "memory");
    __syncthreads();
    if (threadIdx.x == 0) {
        unsigned* bar = b.bar;
        __builtin_amdgcn_s_waitcnt(0);
        unsigned nloc = b.st[0], nx = b.st[1];
        if (nloc == 0u) { xcd_barrier_complete(bar, b.x, nloc, nx); b.st[0] = nloc; b.st[1] = nx; }
        const unsigned old = xb_add(&bar[XB_XSUB(b.x)], 1u);
        const unsigned gen = old / nloc;
        if (old + 1u == (gen + 1u) * nloc) {
            __builtin_amdgcn_fence(__ATOMIC_RELEASE, "agent");
            asm volatile("s_waitcnt vmcnt(0)" ::: "memory");
            const unsigned og = xb_add(&bar[XB_TOP], 1u);
            const unsigned tg = og / nx;
            if (og + 1u == (tg + 1u) * nx) xb_add(&bar[XB_TOPGEN], 1u);
            else XB_SPIN(xb_ld(&bar[XB_TOPGEN]) == tg, bar);
            __builtin_amdgcn_fence(__ATOMIC_ACQUIRE, "agent");
            xb_add(&bar[XB_XGEN(b.x)], 1u);
            asm volatile("s_waitcnt vmcnt(0)" ::: "memory");
        } else {
            XB_SPIN(xb_ld(&bar[XB_XGEN(b.x)]) == gen, bar);
            __builtin_amdgcn_fence(__ATOMIC_ACQUIRE, "agent");
            asm volatile("s_waitcnt vmcnt(0)" ::: "memory");
        }
    }
    __syncthreads();
}

struct BSrcBf { const bf16_t* p0; const bf16_t* p1; };
struct GRegs { u32x4 a0, a1, a2, a3, b0, b1; };
struct ASrc { const bf16_t* a0; const bf16_t* a1; const bf16_t* a2; const bf16_t* a3; };
DI void g_load(GRegs& r, const ASrc& A, const BSrcBf& B, int kb) {
    const int ko = kb * BK;
    r.a0 = *(const u32x4*)(A.a0 + ko); r.a1 = *(const u32x4*)(A.a1 + ko); r.a2 = *(const u32x4*)(A.a2 + ko); r.a3 = *(const u32x4*)(A.a3 + ko);
    r.b0 = *(const u32x4*)(B.p0 + ko); r.b1 = *(const u32x4*)(B.p1 + ko);
}
DI void g_store(const GRegs& r, bf16_t* st, int tid) {
    const int off = (tid >> 3) * LSTR + (tid & 7) * 8;
    *(u32x4*)(st + off) = r.a0; *(u32x4*)(st + off + 64 * LSTR) = r.a1; *(u32x4*)(st + off + 128 * LSTR) = r.a2; *(u32x4*)(st + off + 192 * LSTR) = r.a3;
    *(u32x4*)(st + A_TILE + off) = r.b0; *(u32x4*)(st + A_TILE + off + 64 * LSTR) = r.b1;
}
DI void g_compute(f32x16 (&acc)[2][2], const bf16_t* st, int wm, int wn, int r, int h) {
    const bf16_t* ab = st + (wm * 64 + r) * LSTR + h * 8;
    const bf16_t* bb = st + A_TILE + (wn * 64 + r) * LSTR + h * 8;
#pragma unroll
    for (int s = 0; s < 4; ++s) {
        const bf16x8 af0 = *(const bf16x8*)(ab + s * 16);
        const bf16x8 af1 = *(const bf16x8*)(ab + 32 * LSTR + s * 16);
        const bf16x8 bf0 = *(const bf16x8*)(bb + s * 16);
        const bf16x8 bf1 = *(const bf16x8*)(bb + 32 * LSTR + s * 16);
        acc[0][0] = MFMA32(af0, bf0, acc[0][0]);
        acc[0][1] = MFMA32(af0, bf1, acc[0][1]);
        acc[1][0] = MFMA32(af1, bf0, acc[1][0]);
        acc[1][1] = MFMA32(af1, bf1, acc[1][1]);
    }
}
DI void gemm_mainloop(f32x16 (&acc)[2][2], const ASrc& A, const BSrcBf& B, int K, bf16_t* lds, int tid, int xmode = 0) {
    const int lane = tid & 63, w = tid >> 6, r = lane & 31, h = lane >> 5;
    const int wm = w >> 1, wn = w & 1;
    const int nk = K / BK;
    GRegs RA, RB;
    g_load(RA, A, B, 0);
    g_store(RA, lds, tid);
    if (nk > 1) g_load(RA, A, B, 1);
    if (nk > 2) g_load(RB, A, B, 2);
    __syncthreads();
    for (int kb = 0; kb < nk; kb += 2) {
        if (xmode != 2) g_compute(acc, lds, wm, wn, r, h);
        if (kb + 1 < nk) g_store(RA, lds + STAGE_ELEMS, tid);
        if (kb + 3 < nk) g_load(RA, A, B, xmode == 1 ? 0 : kb + 3);
        __syncthreads();
        if (kb + 1 >= nk) break;
        if (xmode != 2) g_compute(acc, lds + STAGE_ELEMS, wm, wn, r, h);
        if (kb + 2 < nk) g_store(RB, lds, tid);
        if (kb + 4 < nk) g_load(RB, A, B, xmode == 1 ? 1 : kb + 4);
        __syncthreads();
    }
}

DI void zero_acc(f32x16 (&acc)[2][2]) {
#pragma unroll
    for (int a = 0; a < 2; ++a)
#pragma unroll
        for (int b = 0; b < 2; ++b)
#pragma unroll
            for (int i = 0; i < 16; ++i) acc[a][b][i] = 0.f;
}
DI void dump_acc(const f32x16 (&acc)[2][2], float* Ct, int tid) {
    const int lane = tid & 63, w = tid >> 6, r = lane & 31, h = lane >> 5;
    const int wm = w >> 1, wn = w & 1;
#pragma unroll
    for (int tm = 0; tm < 2; ++tm)
#pragma unroll
        for (int tn = 0; tn < 2; ++tn)
#pragma unroll
            for (int i = 0; i < 16; ++i)
                Ct[(wm * 64 + tm * 32 + crow(i, h)) * CT_STRIDE + wn * 64 + tn * 32 + r] = acc[tm][tn][i];
}
struct BSrc2 { const bf16_t* p0; const bf16_t* p1; const bf16_t* p2; const bf16_t* p3; };
struct GRegs2 { u32x4 a0, a1, a2, a3, b0, b1, b2, b3; };
DI void g2_load(GRegs2& r, const ASrc& A, const BSrc2& B, int kb) {
    const int ko = kb * BK;
    r.a0 = *(const u32x4*)(A.a0 + ko); r.a1 = *(const u32x4*)(A.a1 + ko); r.a2 = *(const u32x4*)(A.a2 + ko); r.a3 = *(const u32x4*)(A.a3 + ko);
    r.b0 = *(const u32x4*)(B.p0 + ko); r.b1 = *(const u32x4*)(B.p1 + ko); r.b2 = *(const u32x4*)(B.p2 + ko); r.b3 = *(const u32x4*)(B.p3 + ko);
}
DI void g2_store(const GRegs2& r, bf16_t* st, int tid) {
    const int off = (tid >> 3) * LSTR + (tid & 7) * 8;
    *(u32x4*)(st + off) = r.a0; *(u32x4*)(st + off + 64 * LSTR) = r.a1; *(u32x4*)(st + off + 128 * LSTR) = r.a2; *(u32x4*)(st + off + 192 * LSTR) = r.a3;
    bf16_t* sb = st + A_TILE;
    *(u32x4*)(sb + off) = r.b0; *(u32x4*)(sb + off + 64 * LSTR) = r.b1; *(u32x4*)(sb + off + 128 * LSTR) = r.b2; *(u32x4*)(sb + off + 192 * LSTR) = r.b3;
}
DI void g2_compute(f32x16 (&acc)[2][4], const bf16_t* st, int wm, int wn, int r, int h) {
    const bf16_t* ab = st + (wm * 64 + r) * LSTR + h * 8;
    const bf16_t* bb = st + A_TILE + (wn * 128 + r) * LSTR + h * 8;
#pragma unroll
    for (int s = 0; s < 4; ++s) {
        const bf16x8 af0 = *(const bf16x8*)(ab + s * 16);
        const bf16x8 af1 = *(const bf16x8*)(ab + 32 * LSTR + s * 16);
#pragma unroll
        for (int tn = 0; tn < 4; ++tn) {
            const bf16x8 bf = *(const bf16x8*)(bb + tn * 32 * LSTR + s * 16);
            acc[0][tn] = MFMA32(af0, bf, acc[0][tn]);
            acc[1][tn] = MFMA32(af1, bf, acc[1][tn]);
        }
    }
}
DI void gemm_mainloop2(f32x16 (&acc)[2][4], const ASrc& A, const BSrc2& B, int K, bf16_t* lds, int tid) {
    const int lane = tid & 63, w = tid >> 6, r = lane & 31, h = lane >> 5;
    const int wm = w >> 1, wn = w & 1;
    const int nk = K / BK;
    GRegs2 RA;
    g2_load(RA, A, B, 0);
    g2_store(RA, lds, tid);
    if (nk > 1) g2_load(RA, A, B, 1);
    __syncthreads();
    for (int kb = 0; kb < nk; ++kb) {
        g2_compute(acc, lds + (kb & 1) * STAGE2_ELEMS, wm, wn, r, h);
        if (kb + 1 < nk) g2_store(RA, lds + ((kb + 1) & 1) * STAGE2_ELEMS, tid);
        if (kb + 2 < nk) g2_load(RA, A, B, kb + 2);
        __syncthreads();
    }
}
DI u32x4 scale8(u32x4 v, float sc) {
    u32x4 o;
    o.x = pk2(__builtin_bit_cast(float, v.x << 16) * sc, __builtin_bit_cast(float, v.x & 0xffff0000u) * sc);
    o.y = pk2(__builtin_bit_cast(float, v.y << 16) * sc, __builtin_bit_cast(float, v.y & 0xffff0000u) * sc);
    o.z = pk2(__builtin_bit_cast(float, v.z << 16) * sc, __builtin_bit_cast(float, v.z & 0xffff0000u) * sc);
    o.w = pk2(__builtin_bit_cast(float, v.w << 16) * sc, __builtin_bit_cast(float, v.w & 0xffff0000u) * sc);
    return o;
}
DI void gemm_mainloop2s(f32x16 (&acc)[2][4], const ASrc& A, const BSrc2& B, int K, bf16_t* lds, int tid, const float (&sc)[8]) {
    const int lane = tid & 63, w = tid >> 6, r = lane & 31, h = lane >> 5;
    const int wm = w >> 1, wn = w & 1;
    const int nk = K / BK;
    GRegs2 RA;
    g2_load(RA, A, B, 0);
    { RA.a0 = scale8(RA.a0, sc[0]); RA.a1 = scale8(RA.a1, sc[1]); RA.a2 = scale8(RA.a2, sc[2]); RA.a3 = scale8(RA.a3, sc[3]); }
    g2_store(RA, lds, tid);
    if (nk > 1) g2_load(RA, A, B, 1);
    __syncthreads();
    for (int kb = 0; kb < nk; ++kb) {
        g2_compute(acc, lds + (kb & 1) * STAGE2_ELEMS, wm, wn, r, h);
        if (kb + 1 < nk) {
            const int o = ((kb + 1) * BK < 512) ? 0 : 4;
            RA.a0 = scale8(RA.a0, sc[o]); RA.a1 = scale8(RA.a1, sc[o + 1]); RA.a2 = scale8(RA.a2, sc[o + 2]); RA.a3 = scale8(RA.a3, sc[o + 3]);
            g2_store(RA, lds + ((kb + 1) & 1) * STAGE2_ELEMS, tid);
        }
        if (kb + 2 < nk) g2_load(RA, A, B, kb + 2);
        __syncthreads();
    }
}
DI void zero_acc2(f32x16 (&acc)[2][4]) {
#pragma unroll
    for (int a = 0; a < 2; ++a)
#pragma unroll
        for (int b = 0; b < 4; ++b)
#pragma unroll
            for (int i = 0; i < 16; ++i) acc[a][b][i] = 0.f;
}
DI void dump_acc2(const f32x16 (&acc)[2][4], float* Ct, int tid, int half) {
    const int lane = tid & 63, w = tid >> 6, r = lane & 31, h = lane >> 5;
    const int wm = w >> 1, wn = w & 1;
    if (wn == half) {
#pragma unroll
        for (int tm = 0; tm < 2; ++tm)
#pragma unroll
            for (int tn = 0; tn < 4; ++tn)
#pragma unroll
                for (int i = 0; i < 16; ++i)
                    Ct[(wm * 64 + tm * 32 + crow(i, h)) * CT_STRIDE + tn * 32 + r] = acc[tm][tn][i];
    }
}
DI BSrc2 make_b2(const bf16_t* Bt, long ldb, int N, int n0, int tid) {
    BSrc2 s; const int c = (tid & 7) * 8;
    int n = n0 + (tid >> 3);
    int q0 = n < N ? n : N - 1, q1 = n + 64 < N ? n + 64 : N - 1, q2 = n + 128 < N ? n + 128 : N - 1, q3 = n + 192 < N ? n + 192 : N - 1;
    s.p0 = Bt + (long)q0 * ldb + c; s.p1 = Bt + (long)q1 * ldb + c; s.p2 = Bt + (long)q2 * ldb + c; s.p3 = Bt + (long)q3 * ldb + c; return s;
}
DI const bf16_t* a_ptr(const bf16_t* base, long lda, const int* rows, int M, int m0, int i, int tid) {
    int gm = m0 + (tid >> 3) + 64 * i;
    gm = gm < M ? gm : M - 1;
    const long src = rows ? (long)rows[gm] : (long)gm;
    return base + src * lda + (tid & 7) * 8;
}
DI ASrc make_a(const bf16_t* base, long lda, const int* rows, int M, int m0, int tid) {
    ASrc A; A.a0 = a_ptr(base, lda, rows, M, m0, 0, tid); A.a1 = a_ptr(base, lda, rows, M, m0, 1, tid);
    A.a2 = a_ptr(base, lda, rows, M, m0, 2, tid); A.a3 = a_ptr(base, lda, rows, M, m0, 3, tid); return A;
}
DI BSrcBf make_bbf(const bf16_t* Bt, long ldb, int N, int n0, int tid) {
    int n = n0 + (tid >> 3); int n1 = n + 64;
    n = n < N ? n : N - 1; n1 = n1 < N ? n1 : N - 1;
    BSrcBf s; s.p0 = Bt + (long)n * ldb + (tid & 7) * 8; s.p1 = Bt + (long)n1 * ldb + (tid & 7) * 8; return s;
}
template <class RM>
DI void tconv(const float* src, long sbatch, long sld, int K, int N, bf16_t* dst, long dbatch, long ldd, int nbatch, RM rm, int lo, long gtid, long gstride,
              const float* ks0 = nullptr, const float* ks1 = nullptr) {
    const long per = (long)N * (K >> 5), total = per * nbatch;
    for (long i = gtid; i < total; i += gstride) {
        const int bi = (int)(i / per); const long rem = i - (long)bi * per;
        const int k32 = (int)(rem / N), n = (int)(rem - (long)k32 * N);
        const float* sp = src + bi * sbatch + (long)(k32 * 32) * sld + n;
        float f[32];
#pragma unroll
        for (int j = 0; j < 32; ++j) f[j] = sp[(long)j * sld];
        if (lo) {
#pragma unroll
            for (int j = 0; j < 32; ++j) f[j] = f[j] - bf2f(f2bf(f[j]));
        }
        if (ks0) {
            const float* kp = (k32 * 32 < 512) ? ks0 + k32 * 32 : ks1 + k32 * 32 - 512;
#pragma unroll
            for (int j = 0; j < 32; ++j) f[j] *= kp[j];
        }
        bf16_t* dp = dst + bi * dbatch + (long)rm(n) * ldd + k32 * 32;
#pragma unroll
        for (int q = 0; q < 4; ++q) {
            u32x4 o; o.x = pk2(f[8 * q], f[8 * q + 1]); o.y = pk2(f[8 * q + 2], f[8 * q + 3]); o.z = pk2(f[8 * q + 4], f[8 * q + 5]); o.w = pk2(f[8 * q + 6], f[8 * q + 7]);
            *(u32x4*)(dp + 8 * q) = o;
        }
    }
}
struct RowId { DI int operator()(int n) const { return n; } };
struct RowGU { int tn; DI int operator()(int n) const { return (n >> 6) * 128 + ((n >> 5) & 1) * 64 + tn * 32 + (n & 31); } };
struct RowOff { int off; DI int operator()(int n) const { return n + off; } };

DI void cpow(float lr, float li, float step, int tau, float& re, float& im) {
    const float mag = expf(lr * step * (float)tau);
    const double ang = (double)li * (double)step * (double)tau;
    const double k = rint(ang * 0.15915494309189535);
    const float red = (float)(ang - k * 6.283185307179586);
    float sn, cs; sn = sinf(red); cs = cosf(red);
    re = mag * cs; im = mag * sn;
}
DI void phase0(const Params& P, unsigned char* lds_raw, int tid, int xmode = 0) {
    unsigned char* ws = P.ws;
    const int lane = tid & 63, wv = tid >> 6;
    const int G = gridDim.x, bid = blockIdx.x;
    if (xmode == 0 || xmode == 1) {
        const float* x = P.in[0]; const float* g1 = P.in[1];
        bf16_t* xn = (bf16_t*)(ws + OFF_XN);
        for (int row0 = (bid * 8 + wv) * 2; row0 < T; row0 += G * 16) {
            f32x4 v[2][4]; float s0 = 0.f, s1 = 0.f;
#pragma unroll
            for (int q = 0; q < 2; ++q) {
                const f32x4* xr = (const f32x4*)(x + (size_t)(row0 + q) * 1024) + lane;
#pragma unroll
                for (int j = 0; j < 4; ++j) v[q][j] = xr[64 * j];
            }
#pragma unroll
            for (int j = 0; j < 4; ++j) {
                s0 += v[0][j].x * v[0][j].x + v[0][j].y * v[0][j].y + v[0][j].z * v[0][j].z + v[0][j].w * v[0][j].w;
                s1 += v[1][j].x * v[1][j].x + v[1][j].y * v[1][j].y + v[1][j].z * v[1][j].z + v[1][j].w * v[1][j].w;
            }
            s0 = wave_sum(s0); s1 = wave_sum(s1);
            const float rs0 = rsqrtf(s0 * (1.f / 1024.f) + EPS), rs1 = rsqrtf(s1 * (1.f / 1024.f) + EPS);
#pragma unroll
            for (int j = 0; j < 4; ++j) {
                const f32x4 g = ((const f32x4*)g1)[lane + 64 * j];
                u32x2 o; o.x = pk2(v[0][j].x * rs0 * g.x, v[0][j].y * rs0 * g.y); o.y = pk2(v[0][j].z * rs0 * g.z, v[0][j].w * rs0 * g.w);
                *(u32x2*)(xn + (size_t)row0 * 1024 + lane * 4 + 256 * j) = o;
                o.x = pk2(v[1][j].x * rs1 * g.x, v[1][j].y * rs1 * g.y); o.y = pk2(v[1][j].z * rs1 * g.z, v[1][j].w * rs1 * g.w);
                *(u32x2*)(xn + (size_t)(row0 + 1) * 1024 + lane * 4 + 256 * j) = o;
            }
        }
    }
    if (xmode == 0 || xmode == 2) {
        const float* lam_re = P.in[3]; const float* lam_im = P.in[4]; const float* log_step = P.in[5];
        const float* b_re = P.in[6]; const float* b_im = P.in[7]; const float* c_re = P.in[8]; const float* c_im = P.in[9];
        float* pw_re = (float*)lds_raw;
        float* pw_im = pw_re + 64 * 33;
        float* bb_re = pw_im + 64 * 33;
        float* bb_im = bb_re + 1024;
        float* cc_re = bb_im + 1024;
        float* cc_im = cc_re + 64;
        float* Km = cc_im + 64;
        bf16_t* TgT = (bf16_t*)(ws + OFF_TGT); bf16_t* EgT = (bf16_t*)(ws + OFF_EGT); bf16_t* FgT = (bf16_t*)(ws + OFF_FGT);
        float* lam32 = (float*)(ws + OFF_LAM32);
        for (int u = bid; u < 512; u += G) {
            const int g = u >> 4, h = u & 15;
            const float step = expf(log_step[g]);
            __syncthreads();
            if (tid < 64) {
                const int p = tid;
                float ar, ai; cpow(lam_re[g * 64 + p], lam_im[g * 64 + p], step, 1, ar, ai);
                float zr = 1.f, zi = 0.f;
                for (int tau = 0; tau <= 32; ++tau) {
                    pw_re[p * 33 + tau] = zr; pw_im[p * 33 + tau] = zi;
                    const float nr = zr * ar - zi * ai, ni = zr * ai + zi * ar; zr = nr; zi = ni;
                }
                cc_re[tid] = c_re[(g * 16 + h) * 64 + tid]; cc_im[tid] = c_im[(g * 16 + h) * 64 + tid];
            }
            __syncthreads();
            for (int idx = tid; idx < 1024; idx += NTHREADS) {
                const int p = idx >> 4, hp = idx & 15;
                const float lr = lam_re[g * 64 + p], li = lam_im[g * 64 + p];
                const float re = pw_re[p * 33 + 1], im = pw_im[p * 33 + 1];
                const float nr = re - 1.f, ni = im, den = lr * lr + li * li;
                const float qr = (nr * lr + ni * li) / den, qi = (ni * lr - nr * li) / den;
                const float br = b_re[(g * 64 + p) * 16 + hp], bi = b_im[(g * 64 + p) * 16 + hp];
                bb_re[idx] = qr * br - qi * bi; bb_im[idx] = qr * bi + qi * br;
            }
            __syncthreads();
            {
                const int tau = tid >> 4, hp = tid & 15;
                float s = 0.f;
                for (int p = 0; p < 64; ++p) {
                    const float zr = cc_re[p] * pw_re[p * 33 + tau] - cc_im[p] * pw_im[p * 33 + tau];
                    const float zi = cc_re[p] * pw_im[p * 33 + tau] + cc_im[p] * pw_re[p * 33 + tau];
                    s += zr * bb_re[p * 16 + hp] - zi * bb_im[p * 16 + hp];
                }
                Km[tid] = s;
            }
            __syncthreads();
            for (int it = tid; it < 2048; it += NTHREADS) {
                const int t = it >> 6, q = it & 63, k = q >> 1, hp0 = (q & 1) * 8;
                u32x4 o = {0u, 0u, 0u, 0u};
                if (t >= k) { const float* km = Km + (t - k) * 16 + hp0; o.x = pk2(km[0], km[1]); o.y = pk2(km[2], km[3]); o.z = pk2(km[4], km[5]); o.w = pk2(km[6], km[7]); }
                *(u32x4*)(TgT + ((size_t)g * 512 + t * 16 + h) * 512 + q * 8) = o;
            }
            {
                const int t = tid >> 4, c = tid & 15;
                float f[8];
#pragma unroll
                for (int j = 0; j < 4; ++j) {
                    const int p = 4 * c + j;
                    const float zr = cc_re[p] * pw_re[p * 33 + t + 1] - cc_im[p] * pw_im[p * 33 + t + 1];
                    const float zi = cc_re[p] * pw_im[p * 33 + t + 1] + cc_im[p] * pw_re[p * 33 + t + 1];
                    f[2 * j] = zr; f[2 * j + 1] = -zi;
                }
                u32x4 o; o.x = pk2(f[0], f[1]); o.y = pk2(f[2], f[3]); o.z = pk2(f[4], f[5]); o.w = pk2(f[6], f[7]);
                *(u32x4*)(FgT + ((size_t)g * 512 + t * 16 + h) * 128 + c * 8) = o;
            }
            {
                const int nl = tid >> 6, q = tid & 63, p = 4 * h + (nl >> 1), ri = nl & 1, k = q >> 1, hp0 = (q & 1) * 8;
                const float ar = pw_re[p * 33 + 31 - k], ai = pw_im[p * 33 + 31 - k];
                float f[8];
#pragma unroll
                for (int j = 0; j < 8; ++j) {
                    const float br = bb_re[p * 16 + hp0 + j], bi = bb_im[p * 16 + hp0 + j];
                    f[j] = ri ? (ar * bi + ai * br) : (ar * br - ai * bi);
                }
                u32x4 o; o.x = pk2(f[0], f[1]); o.y = pk2(f[2], f[3]); o.z = pk2(f[4], f[5]); o.w = pk2(f[6], f[7]);
                *(u32x4*)(EgT + ((size_t)g * 128 + 2 * p + ri) * 512 + q * 8) = o;
            }
            if (h == 0 && tid < 64) { lam32[(g * 64 + tid) * 2] = pw_re[tid * 33 + 32]; lam32[(g * 64 + tid) * 2 + 1] = pw_im[tid * 33 + 32]; }
        }
        __syncthreads();
    }
    if (xmode == 0 || xmode == 3) {
        float* red = (float*)lds_raw;
        float* biasp = (float*)(ws + OFF_BIASP);
        for (int u = bid; u < 32; u += G) {
            const int kv = u >> 4, part = u & 15;
            const float* pos = P.in[kv ? 18 : 17]; const float* w1 = P.in[kv ? 21 : 19];
            const int n = tid & 255, half = tid >> 8;
            float s = 0.f;
            const int k0 = part * 128 + half * 64;
            for (int kk = k0; kk < k0 + 64; ++kk) s += pos[kk] * w1[(size_t)kk * 256 + n];
            __syncthreads();
            red[tid] = s;
            __syncthreads();
            if (tid < 256) biasp[(kv * 16 + part) * 256 + tid] = red[tid] + red[tid + 256];
        }
        __syncthreads();
    }
    if (xmode == 0 || xmode == 4) {
        const long gt = (long)bid * NTHREADS + tid, gs = (long)G * NTHREADS;
        tconv(P.in[2], 0, 1816, 1024, 1816, (bf16_t*)(ws + OFF_WINT), 0, 1024, 1, RowId(), 0, gt, gs);
        tconv(P.in[11], 0, 512, 512, 512, (bf16_t*)(ws + OFF_WGLUT), 0, 512, 1, RowId(), 0, gt, gs);
        tconv(P.in[19], (long)1024 * 256, 256, 1024, 256, (bf16_t*)(ws + OFF_WC1T), (long)256 * 1024, 1024, 2, RowId(), 0, gt, gs);
        tconv(P.in[21], (long)1024 * 256, 256, 1024, 256, (bf16_t*)(ws + OFF_WC1T) + (size_t)2 * 256 * 1024, (long)256 * 1024, 1024, 2, RowId(), 0, gt, gs);
        tconv(P.in[25], 0, 1024, 1024, 1024, (bf16_t*)(ws + OFF_WOUTT), 0, 1024, 1, RowId(), 0, gt, gs, P.in[23], P.in[24]);
        { float* ssq = (float*)(ws + OFF_SSQ); for (long i = gt; i < (long)T * 2; i += gs) ssq[i] = 0.f; }
        tconv(P.in[27], 0, 4, 1024, 4, (bf16_t*)(ws + OFF_WRT), 0, 1024, 1, RowId(), 0, gt, gs);
        tconv(P.in[29], 0, 32, 1024, 32, (bf16_t*)(ws + OFF_WRT), 0, 1024, 1, RowOff{4}, 0, gt, gs);
        tconv(P.in[27], 0, 4, 1024, 4, (bf16_t*)(ws + OFF_WRT) + 40 * 1024, 0, 1024, 1, RowId(), 1, gt, gs);
        tconv(P.in[29], 0, 32, 1024, 32, (bf16_t*)(ws + OFF_WRT) + 40 * 1024, 0, 1024, 1, RowOff{4}, 1, gt, gs);
    }
}

DI void epi_inproj(const Params& P, const float* Ct, int m0, int nt, int tid) {
    unsigned char* ws = P.ws;
    const int n0 = nt * 128;
    if (n0 < 512) {
        bf16_t* U = (bf16_t*)(ws + OFF_U);
        for (int it = tid; it < 2048; it += NTHREADS) {
            const int row = it >> 3, gi = it & 7;
            const float* s = Ct + row * CT_STRIDE + gi * 16;
            u32x4 o0, o1;
            o0.x = pk2(s[0], s[1]); o0.y = pk2(s[2], s[3]); o0.z = pk2(s[4], s[5]); o0.w = pk2(s[6], s[7]);
            o1.x = pk2(s[8], s[9]); o1.y = pk2(s[10], s[11]); o1.z = pk2(s[12], s[13]); o1.w = pk2(s[14], s[15]);
            bf16_t* d = U + ((size_t)((n0 >> 4) + gi) * T + m0 + row) * 16;
            *(u32x4*)d = o0; *(u32x4*)(d + 8) = o1;
        }
    } else if (n0 < 1792) {
        const int row = tid & 255, seg = tid >> 8;
        const int grow = m0 + row, b = grow >> 12, l = grow & 4095;
        const float* s = Ct + row * CT_STRIDE + seg * 64;
        const int kind = n0 < 1024 ? 0 : 1 + ((n0 - 1024) >> 7);
        if (kind == 4 || kind == 6) {
            bf16_t* dst = (bf16_t*)(ws + (kind == 4 ? OFF_VST : OFF_VWT));
            const int rl = tid & 63, cq = tid >> 6;
#pragma unroll 1
            for (int rr = 0; rr < 4; ++rr) {
                const int r2 = rl + 64 * rr, gr = m0 + r2, b2 = gr >> 12, l2 = gr & 4095;
#pragma unroll
                for (int cc = 0; cc < 16; ++cc) {
                    const int col = cq * 16 + cc, g = col >> 6, d = col & 63;
                    dst[((size_t)((b2 * 2 + g) * 64 + d)) * 4096 + l2] = (bf16_t)f2bf(Ct[r2 * CT_STRIDE + col]);
                }
            }
        } else {
            float scale = 1.f; const float* gw = nullptr; bf16_t* dst;
            if (kind == 0) { gw = P.in[13]; dst = (bf16_t*)(ws + OFF_QN) + (size_t)grow * 512 + (n0 - 512) + seg * 64; scale = 0.125f * 1.4426950408889634f; }
            else {
                const size_t off = kind == 1 ? OFF_KC : kind == 2 ? OFF_VC : kind == 3 ? OFF_KSN : OFF_KWN;
                dst = (bf16_t*)(ws + off) + ((size_t)((b * 2 + seg) * 4096 + l)) * 64;
                if (kind == 3) gw = P.in[15]; else if (kind == 5) gw = P.in[16];
            }
            float rs = 1.f;
            if (gw) {
                float ss = 0.f;
#pragma unroll
                for (int c4 = 0; c4 < 16; ++c4) { const f32x4 v = *(const f32x4*)(s + c4 * 4); ss += v.x * v.x + v.y * v.y + v.z * v.z + v.w * v.w; }
                rs = rsqrtf(ss * (1.f / 64.f) + EPS) * scale;
            }
#pragma unroll
            for (int c8 = 0; c8 < 8; ++c8) {
                f32x4 v0 = *(const f32x4*)(s + c8 * 8), v1 = *(const f32x4*)(s + c8 * 8 + 4);
                if (gw) {
                    const f32x4 g0 = *(const f32x4*)(gw + c8 * 8), g1 = *(const f32x4*)(gw + c8 * 8 + 4);
                    v0 = v0 * g0 * rs; v1 = v1 * g1 * rs;
                }
                u32x4 o; o.x = pk2(v0.x, v0.y); o.y = pk2(v0.z, v0.w); o.z = pk2(v1.x, v1.y); o.w = pk2(v1.z, v1.w);
                *(u32x4*)(dst + c8 * 8) = o;
            }
        }
    } else {
        if (tid < 256) {
            float* gates = (float*)(ws + OFF_GATES) + (size_t)(m0 + tid) * 24;
            const float* s = Ct + tid * CT_STRIDE;
#pragma unroll
            for (int c = 0; c < 24; ++c) gates[c] = sigmoidf(s[c]);
        }
    }
}
DI void phase1(const Params& P, unsigned char* lds_raw, int tid, int xmode = 0) {
    bf16_t* lds = (bf16_t*)lds_raw; float* Ct = (float*)lds_raw;
    const bf16_t* xn = (const bf16_t*)(P.ws + OFF_XN);
    const bf16_t* WinT = (const bf16_t*)(P.ws + OFF_WINT);
    for (int u = vbid(); u < 64 * 8; u += gridDim.x) {
        const int mt = u >> 3, nt2 = u & 7, m0 = mt * 256;
        f32x16 acc[2][4]; zero_acc2(acc);
        const ASrc A = make_a(xn, 1024, nullptr, T, m0, tid);
        const BSrc2 bs = make_b2(WinT, 1024, DIN, nt2 * 256, tid);
        __syncthreads();
        if (xmode != 4) gemm_mainloop2(acc, A, bs, 1024, lds, tid);
#pragma unroll 1
        for (int half = 0; half < 2; ++half) {
            const int nt = nt2 * 2 + half;
            if (nt * 128 >= DIN) break;
            if (xmode == 5) { if (tid == 0 && acc[0][0][0] + acc[1][3][5] + acc[0][1][1] + acc[1][2][7] + acc[0][2][3] + acc[0][3][9] + acc[1][0][4] + acc[1][1][2] == 12345.f) ((float*)P.ws)[1] = 1.f; continue; }
            dump_acc2(acc, Ct, tid, half);
            __syncthreads();
            epi_inproj(P, Ct, m0, nt, tid);
            __syncthreads();
        }
    }
    __syncthreads();
}

DI void st_wt8(void* p, u32x2 v) { asm volatile("global_store_dwordx2 %0, %1, off sc1\n\ts_nop 1" :: "v"(p), "v"(v) : "memory"); }
DI void st_wt16f(void* p, f32x4 v) { asm volatile("global_store_dwordx4 %0, %1, off sc1\n\ts_nop 1" :: "v"(p), "v"(v) : "memory"); }
DI void unit_signal(unsigned* ctr, int tid) {
    asm volatile("s_waitcnt vmcnt(0)" ::: "memory");
    __syncthreads();
    if (tid == 0) __hip_atomic_fetch_add(ctr, 1u, __ATOMIC_RELAXED, __HIP_MEMORY_SCOPE_AGENT);
}
DI void unit_wait2(unsigned* ctr, unsigned target, unsigned* ctr2, unsigned target2, int tid) {
    if (tid == 0) {
        unsigned sp = 0;
        while (__hip_atomic_load(ctr, __ATOMIC_RELAXED, __HIP_MEMORY_SCOPE_AGENT) < target) { __builtin_amdgcn_s_sleep(4); if (++sp > (1u << 22)) break; }
        if (ctr2) { sp = 0; while (__hip_atomic_load(ctr2, __ATOMIC_RELAXED, __HIP_MEMORY_SCOPE_AGENT) < target2) { __builtin_amdgcn_s_sleep(4); if (++sp > (1u << 22)) break; } }
        __builtin_amdgcn_fence(__ATOMIC_ACQUIRE, "agent");
        asm volatile("s_waitcnt vmcnt(0)" ::: "memory");
    }
    __syncthreads();
}
DI void unit_wait(unsigned* ctr, unsigned target, int tid) {
    if (tid == 0) {
        unsigned sp = 0;
        while (__hip_atomic_load(ctr, __ATOMIC_RELAXED, __HIP_MEMORY_SCOPE_AGENT) < target) { __builtin_amdgcn_s_sleep(4); if (++sp > (1u << 22)) break; }
        __builtin_amdgcn_fence(__ATOMIC_ACQUIRE, "agent");
        asm volatile("s_waitcnt vmcnt(0)" ::: "memory");
    }
    __syncthreads();
}
DI void mlp2_unit(const Params& P, unsigned char* lds_raw, int u, int tid) {
    unsigned char* ws = P.ws;
    {
        unit_wait((unsigned*)(ws + OFF_CTL) + CW_PDONE + (u >> 3), 4u, tid);
            const int idx = u, rc = idx & 7, bg = (idx >> 3) & 7, kv = idx >> 6;
            float* Hs = (float*)lds_raw;
            const float* Pt = (const float*)(ws + OFF_P) + ((size_t)((kv * 8 + bg) * 2 + 0) * 256) * 256;
            const float* Pb = (const float*)(ws + OFF_P) + ((size_t)((kv * 8 + bg) * 2 + 1) * 256) * 256;
            const float* biasp = (const float*)(ws + OFF_BIASP) + kv * 16 * 256;
            const int n = tid & 255;
            float bias = 0.f;
#pragma unroll
            for (int pp = 0; pp < 16; ++pp) bias += biasp[pp * 256 + n];
            for (int it = tid; it < 8192; it += NTHREADS) {
                const int rr = it >> 8, j = rc * 32 + rr;
                float hv = 0.f;
                if (j < 255) hv = gelu_tanh(Pt[j * 256 + n] + Pb[(j + 1) * 256 + n] + bias);
                Hs[rr * 256 + n] = hv;
            }
            __syncthreads();
            const int rr = tid >> 4, dq = tid & 15, j = rc * 32 + rr;
            const float* w2 = P.in[kv ? 22 : 20];
            f32x4 a = {0.f, 0.f, 0.f, 0.f};
            for (int k = 0; k < 256; ++k) {
                const float hv = Hs[rr * 256 + k];
                const f32x4 w = *(const f32x4*)(w2 + k * 64 + dq * 4);
                a = a + w * hv;
            }
            if (kv == 0) {
                float ss = a.x * a.x + a.y * a.y + a.z * a.z + a.w * a.w;
                ss += __shfl_xor(ss, 1); ss += __shfl_xor(ss, 2); ss += __shfl_xor(ss, 4); ss += __shfl_xor(ss, 8);
                const float rs = rsqrtf(ss * (1.f / 64.f) + EPS);
                const f32x4 g = *(const f32x4*)(P.in[14] + dq * 4);
                u32x2 o; o.x = pk2(a.x * rs * g.x, a.y * rs * g.y); o.y = pk2(a.z * rs * g.z, a.w * rs * g.w);
                if (j == 255) { o.x = 0u; o.y = 0u; }
                *(u32x2*)((bf16_t*)(ws + OFF_KCMP) + ((size_t)bg * 256 + j) * 64 + dq * 4) = o;
            } else {
                bf16_t* vt = (bf16_t*)(ws + OFF_VCMPT) + (size_t)bg * 64 * 256;
                if (j == 255) a = (f32x4){0.f, 0.f, 0.f, 0.f};
                vt[(dq * 4 + 0) * 256 + j] = (bf16_t)f2bf(a.x); vt[(dq * 4 + 1) * 256 + j] = (bf16_t)f2bf(a.y);
                vt[(dq * 4 + 2) * 256 + j] = (bf16_t)f2bf(a.z); vt[(dq * 4 + 3) * 256 + j] = (bf16_t)f2bf(a.w);
            }
    }
    __syncthreads();
}
DI void phase2(const Params& P, unsigned char* lds_raw, int tid) {
    bf16_t* lds = (bf16_t*)lds_raw; float* Ct = (float*)lds_raw;
    unsigned char* ws = P.ws;
    {
        const int G = gridDim.x, nh = G > 128 ? G - 128 : G, hid = G > 128 ? vbid() - 128 : vbid();
        if (hid >= 0) {
            const long gt = (long)hid * NTHREADS + tid, gs = (long)nh * NTHREADS;
            tconv(P.in[31], (long)1024 * 256, 256, 1024, 256, (bf16_t*)(ws + OFF_WGUT), (long)512 * 1024, 1024, 32, RowGU{0}, 0, gt, gs);
            tconv(P.in[32], (long)1024 * 256, 256, 1024, 256, (bf16_t*)(ws + OFF_WGUT), (long)512 * 1024, 1024, 32, RowGU{1}, 0, gt, gs);
            tconv(P.in[33], (long)256 * 1024, 1024, 256, 1024, (bf16_t*)(ws + OFF_WDT), (long)1024 * 256, 256, 32, RowId(), 0, gt, gs);
        }
    }
    for (int u = vbid(); u < 128; u += gridDim.x) {
        f32x16 acc[2][2]; zero_acc(acc);
        if (u < 64) {
            const int g = u >> 1, mt = u & 1, m0 = mt * 256;
            const bf16_t* A = (const bf16_t*)(ws + OFF_U) + (size_t)g * T * 16;
            const ASrc As = make_a(A, 512, nullptr, 512, m0, tid);
            const BSrcBf bs = make_bbf((const bf16_t*)(ws + OFF_EGT) + (size_t)g * 128 * 512, 512, 128, 0, tid);
            __syncthreads();
            gemm_mainloop(acc, As, bs, 512, lds, tid);
            dump_acc(acc, Ct, tid);
            __syncthreads();
            if (tid < 128) {
                const int bb = tid >> 6, p = tid & 63;
                const float* lam32 = (const float*)(ws + OFF_LAM32) + (g * 64 + p) * 2;
                const float ar = lam32[0], ai = lam32[1];
                float sr = 0.f, si = 0.f;
                float* zp = Ct + (bb * 128) * CT_STRIDE + 2 * p;
                for (int c = 0; c < 128; ++c) {
                    const float zr = zp[c * CT_STRIDE], zi = zp[c * CT_STRIDE + 1];
                    zp[c * CT_STRIDE] = sr; zp[c * CT_STRIDE + 1] = si;
                    const float nr = ar * sr - ai * si + zr, ni = ar * si + ai * sr + zi;
                    sr = nr; si = ni;
                }
            }
            __syncthreads();
            bf16_t* Sin = (bf16_t*)(ws + OFF_SIN) + ((size_t)g * 512 + m0) * 128;
            for (int it = tid; it < 256 * 16; it += NTHREADS) {
                const int row = it >> 4, c8 = it & 15;
                const float* sp = Ct + row * CT_STRIDE + c8 * 8;
                u32x4 o; o.x = pk2(sp[0], sp[1]); o.y = pk2(sp[2], sp[3]); o.z = pk2(sp[4], sp[5]); o.w = pk2(sp[6], sp[7]);
                *(u32x4*)(Sin + row * 128 + c8 * 8) = o;
            }
        } else {
            const int idx = u - 64, nt = idx & 1, part = (idx >> 1) & 1, bg = (idx >> 2) & 7, kv = idx >> 5;
            const bf16_t* A = (const bf16_t*)(ws + (kv ? OFF_VC : OFF_KC)) + (size_t)bg * 4096 * 64;
            const ASrc As = make_a(A, 1024, nullptr, 256, 0, tid);
            const BSrcBf bs = make_bbf((const bf16_t*)(ws + OFF_WC1T) + (size_t)(kv * 2 + part) * 256 * 1024, 1024, 256, nt * 128, tid);
            __syncthreads();
            gemm_mainloop(acc, As, bs, 1024, lds, tid);
            dump_acc(acc, Ct, tid);
            __syncthreads();
            float* Pp = (float*)(ws + OFF_P) + ((size_t)((kv * 8 + bg) * 2 + part) * 256) * 256 + nt * 128;
            for (int it = tid; it < 256 * 32; it += NTHREADS) {
                const int row = it >> 5, c4 = it & 31;
                st_wt16f(Pp + row * 256 + c4 * 4, *(const f32x4*)(Ct + row * CT_STRIDE + c4 * 4));
            }
            unit_signal((unsigned*)(ws + OFF_CTL) + CW_PDONE + kv * 8 + bg, tid);
        }
    }
    for (int u = vbid(); u < 128; u += gridDim.x) mlp2_unit(P, lds_raw, u, tid);
    __syncthreads();
}

DI void s5_main_unit(const Params& P, unsigned char* lds_raw, int u, int tid) {
    bf16_t* lds = (bf16_t*)lds_raw; float* Ct = (float*)lds_raw;
    unsigned char* ws = P.ws;
    const int nt = u & 3, mt = (u >> 2) & 1, g = u >> 3, m0 = mt * 256, n0 = nt * 128;
    f32x16 acc[2][2]; zero_acc(acc);
    const bf16_t* Ug = (const bf16_t*)(ws + OFF_U) + (size_t)g * T * 16;
    {
        const ASrc As = make_a(Ug, 512, nullptr, 512, m0, tid);
        const BSrcBf bs = make_bbf((const bf16_t*)(ws + OFF_TGT) + (size_t)g * 512 * 512, 512, 512, n0, tid);
        __syncthreads();
        gemm_mainloop(acc, As, bs, 512, lds, tid);
    }
    {
        const bf16_t* S = (const bf16_t*)(ws + OFF_SIN) + (size_t)g * 512 * 128;
        const ASrc As = make_a(S, 128, nullptr, 512, m0, tid);
        const BSrcBf bs = make_bbf((const bf16_t*)(ws + OFF_FGT) + (size_t)g * 512 * 128, 128, 512, n0, tid);
        gemm_mainloop(acc, As, bs, 128, lds, tid);
    }
    dump_acc(acc, Ct, tid);
    __syncthreads();
    const float* dsk = P.in[10] + g * 16;
    bf16_t* y1 = (bf16_t*)(ws + OFF_Y1);
    for (int it = tid; it < 2048; it += NTHREADS) {
        const int row = it >> 3, tt = it & 7;
        const int token = 32 * (m0 + row) + (n0 >> 4) + tt;
        const float* s = Ct + row * CT_STRIDE + tt * 16;
        const u32x4 u0 = *(const u32x4*)(Ug + (size_t)token * 16), u1 = *(const u32x4*)(Ug + (size_t)token * 16 + 8);
        const unsigned uw[8] = {u0.x, u0.y, u0.z, u0.w, u1.x, u1.y, u1.z, u1.w};
        unsigned ow[8];
#pragma unroll
        for (int q = 0; q < 8; ++q) {
            const float ua = bf2f(uw[q] & 0xffffu), ub = bf2f(uw[q] >> 16);
            const float ya = gelu_tanh(s[2 * q] + dsk[2 * q] * ua), yb = gelu_tanh(s[2 * q + 1] + dsk[2 * q + 1] * ub);
            ow[q] = pk2(ya, yb);
        }
        bf16_t* d = y1 + (size_t)token * 512 + g * 16;
        *(u32x4*)d = (u32x4){ow[0], ow[1], ow[2], ow[3]}; *(u32x4*)(d + 8) = (u32x4){ow[4], ow[5], ow[6], ow[7]};
    }
}

constexpr int KSTR = 72, VSTR = 68;
constexpr int KSLOT = 64 * KSTR, VSLOT = 64 * VSTR;
constexpr int AT_KBUF = 0;
constexpr int AT_VBUF = AT_KBUF + 3 * KSLOT * 2;
constexpr int VCSTR = 260;
constexpr int AT_CK   = 0;
constexpr int AT_CV   = AT_CK + 256 * KSTR * 2;
constexpr int AT_RING_END = AT_VBUF + 3 * VSLOT * 2;
constexpr int AT_CEND = AT_CV + 64 * VCSTR * 2;
constexpr int AT_IMP  = (AT_CEND > AT_RING_END ? AT_CEND : AT_RING_END);
constexpr int AT_MASK = AT_IMP + 4 * 64 * 64 * 4;
constexpr int AT_INVL = AT_MASK + 64 * 8;
constexpr int AT_END  = AT_INVL + 256 * 4;

struct KVRegs { u32x4 k; u32x4 v; };
DI void kv_load(KVRegs& r, const bf16_t* Kt, const bf16_t* Vt, long ldv, int tid) {
    r.k = *(const u32x4*)(Kt + (tid >> 3) * 64 + (tid & 7) * 8);
    r.v = *(const u32x4*)(Vt + (long)(tid >> 3) * ldv + (tid & 7) * 8);
}
DI void kv_store(const KVRegs& r, bf16_t* Kb, bf16_t* Vb, int tid) {
    *(u32x4*)(Kb + (tid >> 3) * KSTR + (tid & 7) * 8) = r.k;
    u32x2 lo, hi; lo.x = r.v.x; lo.y = r.v.y; hi.x = r.v.z; hi.y = r.v.w;
    *(u32x2*)(Vb + (tid >> 3) * VSTR + (tid & 7) * 8) = lo;
    *(u32x2*)(Vb + (tid >> 3) * VSTR + (tid & 7) * 8 + 4) = hi;
}
DI bf16x8 pack8(const f32x16& x, int s) {
    u32x4 p;
    p.x = pk2(x[8 * s], x[8 * s + 1]); p.y = pk2(x[8 * s + 2], x[8 * s + 3]); p.z = pk2(x[8 * s + 4], x[8 * s + 5]); p.w = pk2(x[8 * s + 6], x[8 * s + 7]);
    return __builtin_bit_cast(bf16x8, p);
}
DI void qk_tile(f32x16 (&S)[2], const bf16_t* Kb, const bf16x8 (&qf)[4], int r, int h, bool edge, int d0, int dmax, int pm) {
    const int NEGB = __builtin_bit_cast(int, -1e30f);
    if (edge) {
#pragma unroll
        for (int kh = 0; kh < 2; ++kh)
#pragma unroll
            for (int i = 0; i < 16; ++i) {
                const int d = d0 - (32 * kh + (i & 3) + 8 * (i >> 2));
                const int m = (d >> 31) | ((dmax - d) >> 31) | pm;
                S[kh][i] = __builtin_bit_cast(float, m & NEGB);
            }
    } else {
        const float iv = __builtin_bit_cast(float, pm & NEGB);
#pragma unroll
        for (int kh = 0; kh < 2; ++kh)
#pragma unroll
            for (int i = 0; i < 16; ++i) S[kh][i] = iv;
    }
    bf16x8 kf[2][4];
#pragma unroll
    for (int kh = 0; kh < 2; ++kh)
#pragma unroll
        for (int s = 0; s < 4; ++s) kf[kh][s] = *(const bf16x8*)(Kb + (32 * kh + r) * KSTR + 16 * s + 8 * h);
    asm volatile("" ::: "memory");
#pragma unroll
    for (int s = 0; s < 4; ++s)
#pragma unroll
        for (int kh = 0; kh < 2; ++kh) S[kh] = MFMA32(kf[kh][s], qf[s], S[kh]);
}
#ifndef AT_X
#define AT_X 0
#endif
DI void softmax_tile(f32x16 (&S)[2], float& lsum, int ax = 0) {
    float ls = 0.f;
#pragma unroll
    for (int kh = 0; kh < 2; ++kh)
#pragma unroll
        for (int i = 0; i < 16; ++i) { const float p = (ax == 1) ? S[kh][i] * 0.001f : __builtin_amdgcn_exp2f(S[kh][i]); S[kh][i] = p; ls += p; }
    lsum += ls;
}
DI void pv_tile(f32x16 (&O)[2], const f32x16 (&Pm)[2], const bf16_t* Vb, int r, int h) {
    bf16x8 vf[2][2][2];
#pragma unroll
    for (int kh = 0; kh < 2; ++kh)
#pragma unroll
        for (int sp = 0; sp < 2; ++sp)
#pragma unroll
            for (int dh = 0; dh < 2; ++dh) {
                const bf16_t* vp = Vb + (32 * dh + r) * VSTR + 32 * kh + 16 * sp + 4 * h;
                const s16x4 lo = *(const s16x4*)vp, hi = *(const s16x4*)(vp + 8);
                vf[kh][sp][dh] = __builtin_shufflevector(lo, hi, 0, 1, 2, 3, 4, 5, 6, 7);
            }
    asm volatile("" ::: "memory");
#pragma unroll
    for (int kh = 0; kh < 2; ++kh)
#pragma unroll
        for (int sp = 0; sp < 2; ++sp) {
            const bf16x8 pf = pack8(Pm[kh], sp);
#pragma unroll
            for (int dh = 0; dh < 2; ++dh) O[dh] = MFMA32(vf[kh][sp][dh], pf, O[dh]);
        }
}
DI void pv_tile_c(f32x16 (&O)[2], const f32x16 (&Pm)[2], const bf16_t* Vc, int kt, int r, int h) {
    bf16x8 vf[2][2][2];
#pragma unroll
    for (int kh = 0; kh < 2; ++kh)
#pragma unroll
        for (int sp = 0; sp < 2; ++sp)
#pragma unroll
            for (int dh = 0; dh < 2; ++dh) {
                const bf16_t* vp = Vc + (32 * dh + r) * VCSTR + 64 * kt + 32 * kh + 16 * sp + 4 * h;
                const s16x4 lo = *(const s16x4*)vp, hi = *(const s16x4*)(vp + 8);
                vf[kh][sp][dh] = __builtin_shufflevector(lo, hi, 0, 1, 2, 3, 4, 5, 6, 7);
            }
    asm volatile("" ::: "memory");
#pragma unroll
    for (int kh = 0; kh < 2; ++kh)
#pragma unroll
        for (int sp = 0; sp < 2; ++sp) {
            const bf16x8 pf = pack8(Pm[kh], sp);
#pragma unroll
            for (int dh = 0; dh < 2; ++dh) O[dh] = MFMA32(vf[kh][sp][dh], pf, O[dh]);
        }
}
struct SeqBits { unsigned long long rem; DI int pop() { if (rem == 0ull) return -1; const int k = __builtin_ctzll(rem); rem &= rem - 1; return k; } };
struct SeqDown { int cur, lo; DI int pop() { if (cur < lo) return -1; return cur--; } };
template <int BR, class Seq>
DI void attn_stream(f32x16 (&O)[2], float& lsum, Seq seq, const bf16_t* Kg, const bf16_t* Vg, bf16_t* Kbuf, bf16_t* Vbuf,
                    const bf16x8 (&qf)[4], int qt, int tq, unsigned long long mymask, int r, int h, int tid, int ax = 0) {
#define AT_QK(SREG, T, SLOT) do { const int _t = (T); const bool _edge = (_t == qt) || (BR == 2 && _t == qt - 8); \
        const int _pm = (BR == 1) ? ((int)((mymask >> _t) & 1ull) - 1) : 0; int _d0 = tq - 64 * _t - 4 * h; asm volatile("" : "+v"(_d0)); \
        qk_tile(SREG, Kbuf + (SLOT) * KSLOT, qf, r, h, _edge, _d0, BR == 2 ? 511 : 0x3fffffff, _pm); } while (0)
    int t0 = seq.pop(), t1 = seq.pop(), t2 = seq.pop();
    KVRegs R0;
    kv_load(R0, Kg + (size_t)t0 * 64 * 64, Vg + t0 * 64, 4096, tid); kv_store(R0, Kbuf, Vbuf, tid);
    if (t1 >= 0) { kv_load(R0, Kg + (size_t)t1 * 64 * 64, Vg + t1 * 64, 4096, tid); kv_store(R0, Kbuf + KSLOT, Vbuf + VSLOT, tid); }
    __syncthreads();
    f32x16 Sc[2], Sn[2];
    AT_QK(Sc, t0, 0);
    int sl = 0;
    while (true) {
        const int s1 = sl == 2 ? 0 : sl + 1, s2 = s1 == 2 ? 0 : s1 + 1;
        if (t2 >= 0 && ax != 3 && ax < 7) kv_load(R0, Kg + (size_t)t2 * 64 * 64, Vg + t2 * 64, 4096, tid);
        if (ax == 7) { lsum += (float)t0; }
        else if (ax == 8) { if (t1 >= 0) AT_QK(Sn, t1, s1); lsum += Sn[0][0] + Sn[1][5]; }
        else if (ax == 9) { softmax_tile(Sc, lsum, 0); pv_tile(O, Sc, Vbuf + sl * VSLOT, r, h); Sn[0] = Sc[0]; Sn[1] = Sc[1]; }
        else {
        if (t1 >= 0) AT_QK(Sn, t1, s1);
        softmax_tile(Sc, lsum, ax);
        if (ax != 2) pv_tile(O, Sc, Vbuf + sl * VSLOT, r, h);
        else { O[0][0] += Sc[0][3] + Sc[1][7]; }
        }
        if (t2 >= 0 && ax < 7) kv_store(R0, Kbuf + s2 * KSLOT, Vbuf + s2 * VSLOT, tid);
        if (ax != 5 && ax < 7) __syncthreads();
        if (t1 < 0) break;
#pragma unroll
        for (int kh = 0; kh < 2; ++kh) Sc[kh] = Sn[kh];
        t0 = t1; t1 = t2; t2 = seq.pop(); sl = s1;
    }
#undef AT_QK
}

DI void attn_unit(const Params& P, unsigned char* lds_raw, int a, int tid, bool dry = false, int ax = 0) {
    unsigned char* ws = P.ws;
    const int qt = 63 - (a >> 3), bg = a & 7, b = bg >> 1, g = bg & 1;
    const int lane = tid & 63, w = tid >> 6, r = lane & 31, h = lane >> 5;
    const int hh = w >> 1, th = w & 1;
    const int t0 = qt * 64;
    const int tql = 32 * th + r;
    const int tq = t0 + tql;
    const size_t tqg = (size_t)b * 4096 + tq;
    bf16_t* Kbuf = (bf16_t*)(lds_raw + AT_KBUF);
    bf16_t* Vbuf = (bf16_t*)(lds_raw + AT_VBUF);
    float* imp = (float*)(lds_raw + AT_IMP);
    unsigned long long* selm = (unsigned long long*)(lds_raw + AT_MASK);
    float* invl = (float*)(lds_raw + AT_INVL);

    bf16x8 qf[4];
    {
        const bf16_t* qp = (const bf16_t*)(ws + OFF_QN) + tqg * 512 + g * 256 + hh * 64 + 8 * h;
#pragma unroll
        for (int s = 0; s < 4; ++s) qf[s] = *(const bf16x8*)(qp + 16 * s);
    }
    const float* gp = (const float*)(ws + OFF_GATES) + tqg * 24 + g * 12 + hh * 3;
    const float gate_c = gp[0], gate_s = gp[1], gate_w = gp[2];

    __syncthreads();
    float* impw = imp + ((hh * 64 + 32 * th) * 64);
    for (int i = lane; i < 32 * 64; i += 64) impw[i] = 0.f;

    const bf16_t* Kc = (const bf16_t*)(ws + OFF_KCMP) + (size_t)bg * 256 * 64;
    const bf16_t* Vc = (const bf16_t*)(ws + OFF_VCMPT) + (size_t)bg * 64 * 256;
    int ncmp = (4 * qt + 2) / 64 + 1; if (ncmp > 4) ncmp = 4;
    f32x16 O[2];
#pragma unroll
    for (int dh = 0; dh < 2; ++dh)
#pragma unroll
        for (int i = 0; i < 16; ++i) O[dh][i] = 0.f;
    float inv_c;
    {
        float lsum = 0.f;
        bf16_t* Kcl = (bf16_t*)(lds_raw + AT_CK); bf16_t* Vcl = (bf16_t*)(lds_raw + AT_CV);
        {
            u32x4 kq[4], vq[4];
#pragma unroll
            for (int i = 0; i < 4; ++i) if (i < ncmp) {
                kq[i] = *(const u32x4*)(Kc + (size_t)(64 * i + (tid >> 3)) * 64 + (tid & 7) * 8);
                vq[i] = *(const u32x4*)(Vc + (size_t)(tid >> 3) * 256 + 64 * i + (tid & 7) * 8);
            }
#pragma unroll
            for (int i = 0; i < 4; ++i) if (i < ncmp) {
                *(u32x4*)(Kcl + (64 * i + (tid >> 3)) * KSTR + (tid & 7) * 8) = kq[i];
                bf16_t* vd = Vcl + (tid >> 3) * VCSTR + 64 * i + (tid & 7) * 8;
                u32x2 t; t.x = vq[i].x; t.y = vq[i].y; *(u32x2*)vd = t; t.x = vq[i].z; t.y = vq[i].w; *(u32x2*)(vd + 4) = t;
            }
        }
        __syncthreads();
        int jmax = tq >= 31 ? ((tq - 31) >> 4) : -1; jmax = jmax < 254 ? jmax : 254;
        for (int kt = 0; kt < ncmp; ++kt) {
            f32x16 S[2];
            qk_tile(S, Kcl + kt * 64 * KSTR, qf, r, h, true, jmax - 64 * kt - 4 * h, 0x3fffffff, 0);
            softmax_tile(S, lsum);
            float* ir = impw + r * 64 + 16 * kt + h;
#pragma unroll
            for (int kh = 0; kh < 2; ++kh)
#pragma unroll
                for (int gq = 0; gq < 4; ++gq)
                    ir[8 * kh + 2 * gq] += (S[kh][4 * gq] + S[kh][4 * gq + 1]) + (S[kh][4 * gq + 2] + S[kh][4 * gq + 3]);
            asm volatile("s_waitcnt lgkmcnt(0)" ::: "memory");
#pragma unroll
            for (int kh = 0; kh < 2; ++kh)
#pragma unroll
                for (int gq = 0; gq < 4; ++gq) {
                    const int sl = 8 * kh + 2 * gq + 1;
                    if (16 * kt + h + sl < 64) ir[sl] += S[kh][4 * gq + 3];
                }
            asm volatile("s_waitcnt lgkmcnt(0)" ::: "memory");
            pv_tile_c(O, S, Vcl, kt, r, h);
        }
        lsum += __shfl_xor(lsum, 32);
        inv_c = lsum > 0.f ? 1.f / lsum : 0.f;
        if (h == 0) invl[hh * 64 + tql] = inv_c;
    }
    __syncthreads();
    {
        const int cur = qt;
#pragma unroll 1
        for (int i = 0; i < 8; ++i) {
            const int tl = w * 8 + i;
            const float v = (imp[(0 * 64 + tl) * 64 + lane] * invl[tl] + imp[(1 * 64 + tl) * 64 + lane] * invl[64 + tl]) + (imp[(2 * 64 + tl) * 64 + lane] * invl[128 + tl] + imp[(3 * 64 + tl) * 64 + lane] * invl[192 + tl]);
            const bool forced = (lane == 0) || (lane == cur) || (lane == cur - 1);
            const bool valid = lane <= cur;
            const unsigned key = forced ? 0xFFFFFFFFu : (valid ? __builtin_bit_cast(unsigned, v) : 0u);
            unsigned thr = 0u;
#pragma unroll 1
            for (int bit = 31; bit >= 0; --bit) {
                const unsigned cand = thr | (1u << bit);
                if (__popcll(__ballot(key >= cand)) >= 16) thr = cand;
            }
            const unsigned long long gtm = __ballot(key > thr), eqm = __ballot(key == thr);
            const int need = 16 - __popcll(gtm);
            const bool sel = (key > thr) || ((key == thr) && (__popcll(eqm & ((1ull << lane) - 1ull)) < need));
            const unsigned long long mask = __ballot(sel);
            if (lane == 0) selm[tl] = mask;
        }
    }
    __syncthreads();
    float* accw = imp + (w * 32) * 64 + lane;
    {
        const float g_cmp = gate_c * inv_c;
#pragma unroll
        for (int dh = 0; dh < 2; ++dh)
#pragma unroll
            for (int i = 0; i < 16; ++i) accw[(dh * 16 + i) * 64] = g_cmp * O[dh][i];
    }
    const unsigned long long mymask = selm[tql];
    unsigned long long ormask = selm[lane];
#pragma unroll
    for (int o = 1; o < 64; o <<= 1) ormask |= __shfl_xor(ormask, o);
    ormask &= (qt >= 63) ? ~0ull : ((1ull << (qt + 1)) - 1ull);
    ormask |= 1ull;
    {
        const bf16_t* Ks = (const bf16_t*)(ws + OFF_KSN) + (size_t)bg * 4096 * 64;
        const bf16_t* Vs = (const bf16_t*)(ws + OFF_VST) + (size_t)bg * 64 * 4096;
#pragma unroll
        for (int dh = 0; dh < 2; ++dh)
#pragma unroll
            for (int i = 0; i < 16; ++i) O[dh][i] = 0.f;
        float l = 0.f;
        if (ax != 4) attn_stream<1>(O, l, SeqBits{ormask}, Ks, Vs, Kbuf, Vbuf, qf, qt, tq, mymask, r, h, tid, ax); else l = 1.f;
        l += __shfl_xor(l, 32);
        const float sc = gate_s / l;
#pragma unroll
        for (int dh = 0; dh < 2; ++dh)
#pragma unroll
            for (int i = 0; i < 16; ++i) accw[(dh * 16 + i) * 64] += sc * O[dh][i];
    }
    {
        const bf16_t* Kw = (const bf16_t*)(ws + OFF_KWN) + (size_t)bg * 4096 * 64;
        const bf16_t* Vw = (const bf16_t*)(ws + OFF_VWT) + (size_t)bg * 64 * 4096;
#pragma unroll
        for (int dh = 0; dh < 2; ++dh)
#pragma unroll
            for (int i = 0; i < 16; ++i) O[dh][i] = 0.f;
        float l = 0.f;
        if (ax != 4) attn_stream<2>(O, l, SeqDown{qt, qt >= 8 ? qt - 8 : 0}, Kw, Vw, Kbuf, Vbuf, qf, qt, tq, 0ull, r, h, tid, ax); else l = 1.f;
        l += __shfl_xor(l, 32);
        const float sc = gate_w / l;
        bf16_t* dst = (bf16_t*)(ws + OFF_XN) + tqg * 1024 + 512 + g * 256 + hh * 64;
        float sq = 0.f;
#pragma unroll
        for (int dh = 0; dh < 2; ++dh)
#pragma unroll
            for (int gq = 0; gq < 4; ++gq) {
                const float o0 = accw[(dh * 16 + 4 * gq + 0) * 64] + sc * O[dh][4 * gq + 0];
                const float o1 = accw[(dh * 16 + 4 * gq + 1) * 64] + sc * O[dh][4 * gq + 1];
                const float o2 = accw[(dh * 16 + 4 * gq + 2) * 64] + sc * O[dh][4 * gq + 2];
                const float o3 = accw[(dh * 16 + 4 * gq + 3) * 64] + sc * O[dh][4 * gq + 3];
                u32x2 o; o.x = pk2(o0, o1); o.y = pk2(o2, o3);
                if (ax == 0 || o.x == 0x12345678u) *(u32x2*)(dst + 32 * dh + 8 * gq + 4 * h) = o;
                sq += (o0 * o0 + o1 * o1) + (o2 * o2 + o3 * o3);
            }
        sq += __shfl_xor(sq, 32);
        if (h == 0 && !dry) __hip_atomic_fetch_add((float*)(ws + OFF_SSQ) + tqg * 2 + 1, sq, __ATOMIC_RELAXED, __HIP_MEMORY_SCOPE_AGENT);
    }
}
DI void phase4(const Params& P, unsigned char* lds_raw, int tid, int xmode = 0) {
    for (int b = blockIdx.x; b < 256; b += gridDim.x) {
        if (xmode == 2) break;
        attn_unit(P, lds_raw, b, tid, xmode != 0, xmode >= 10 ? xmode - 10 : 0);
        attn_unit(P, lds_raw, 504 - 8 * (b >> 3) + (b & 7), tid, xmode != 0, xmode >= 10 ? xmode - 10 : 0);
    }
    if (xmode != 1 && xmode < 10) for (int u = vbid(); u < 256; u += gridDim.x) s5_main_unit(P, lds_raw, u, tid);
    __syncthreads();
}

DI void phase5(const Params& P, unsigned char* lds_raw, int tid) {
    bf16_t* lds = (bf16_t*)lds_raw; float* Ct = (float*)lds_raw;
    unsigned char* ws = P.ws;
    const bf16_t* y1 = (const bf16_t*)(ws + OFF_Y1);
    for (int u = vbid(); u < 256; u += gridDim.x) {
        const int mt = u >> 2, nt = u & 3, m0 = mt * 256, n0 = nt * 128;
        f32x16 acc[2][2]; zero_acc(acc);
        const ASrc As = make_a(y1, 512, nullptr, T, m0, tid);
        const BSrcBf bs = make_bbf((const bf16_t*)(ws + OFF_WGLUT), 512, 512, n0, tid);
        __syncthreads();
        gemm_mainloop(acc, As, bs, 512, lds, tid);
        dump_acc(acc, Ct, tid);
        __syncthreads();
        const float* bglu = P.in[12];
        bf16_t* mix = (bf16_t*)(ws + OFF_XN);
        for (int it = tid; it < 256 * 32; it += NTHREADS) {
            const int row = it >> 5, c4 = it & 31, n = n0 + c4 * 4;
            const f32x4 v = *(const f32x4*)(Ct + row * CT_STRIDE + c4 * 4);
            const f32x4 bb = *(const f32x4*)(bglu + n);
            const u32x2 yy = *(const u32x2*)(y1 + (size_t)(m0 + row) * 512 + n);
            const float y0 = bf2f(yy.x & 0xffffu), y1v = bf2f(yy.x >> 16), y2 = bf2f(yy.y & 0xffffu), y3 = bf2f(yy.y >> 16);
            const float o0 = y0 * sigmoidf(v.x + bb.x), o1 = y1v * sigmoidf(v.y + bb.y), o2 = y2 * sigmoidf(v.z + bb.z), o3 = y3 * sigmoidf(v.w + bb.w);
            u32x2 o; o.x = pk2(o0, o1); o.y = pk2(o2, o3);
            *(u32x2*)(mix + (size_t)(m0 + row) * 1024 + n) = o;
            float sq = (o0 * o0 + o1 * o1) + (o2 * o2 + o3 * o3);
            sq += __shfl_xor(sq, 1); sq += __shfl_xor(sq, 2); sq += __shfl_xor(sq, 4); sq += __shfl_xor(sq, 8); sq += __shfl_xor(sq, 16);
            if ((tid & 31) == 0) __hip_atomic_fetch_add((float*)(ws + OFF_SSQ) + (size_t)(m0 + row) * 2, sq, __ATOMIC_RELAXED, __HIP_MEMORY_SCOPE_AGENT);
        }
    }
    __syncthreads();
}
DI void phase6(const Params& P, int tid, bool dry = false) {
    const int lane = tid & 63, wv = tid >> 6;
    bf16_t* mix = (bf16_t*)(P.ws + OFF_XN);
    for (int row = blockIdx.x * 8 + wv; row < T; row += gridDim.x * 8) {
#pragma unroll
        for (int seg = 0; seg < 2; ++seg) {
            bf16_t* p = mix + (size_t)row * 1024 + seg * 512 + lane * 8;
            const u32x4 v = *(const u32x4*)p;
            float f[8] = {bf2f(v.x & 0xffffu), bf2f(v.x >> 16), bf2f(v.y & 0xffffu), bf2f(v.y >> 16), bf2f(v.z & 0xffffu), bf2f(v.z >> 16), bf2f(v.w & 0xffffu), bf2f(v.w >> 16)};
            float s = 0.f;
#pragma unroll
            for (int i = 0; i < 8; ++i) s += f[i] * f[i];
            s = wave_sum(s);
            const float rs = rsqrtf(s * (1.f / 512.f) + EPS);
            const float* gw = P.in[seg ? 24 : 23] + lane * 8;
            const f32x4 g0 = *(const f32x4*)gw, g1 = *(const f32x4*)(gw + 4);
            u32x4 o; o.x = pk2(f[0] * rs * g0.x, f[1] * rs * g0.y); o.y = pk2(f[2] * rs * g0.z, f[3] * rs * g0.w);
            o.z = pk2(f[4] * rs * g1.x, f[5] * rs * g1.y); o.w = pk2(f[6] * rs * g1.z, f[7] * rs * g1.w);
            if (dry) o = v;
            *(u32x4*)p = o;
        }
    }
}
DI void phase7(const Params& P, unsigned char* lds_raw, int tid, int xmode = 0) {
    bf16_t* lds = (bf16_t*)lds_raw; float* Ct = (float*)lds_raw;
    const bf16_t* mix = (const bf16_t*)(P.ws + OFF_XN);
    const float* x = P.in[0];
    for (int u = vbid(); u < 256; u += gridDim.x) {
        const int mt = u >> 2, nt2 = u & 3, m0 = mt * 256;
        f32x16 acc[2][4]; zero_acc2(acc);
        const ASrc As = make_a(mix, 1024, nullptr, T, m0, tid);
        const BSrc2 bs = make_b2((const bf16_t*)(P.ws + OFF_WOUTT), 1024, 1024, nt2 * 256, tid);
        __syncthreads();
        float sc[8];
        {
            const float* ssq = (const float*)(P.ws + OFF_SSQ);
#pragma unroll
            for (int i = 0; i < 4; ++i) {
                const int row = m0 + (tid >> 3) + 64 * i;
                sc[i] = rsqrtf(ssq[(size_t)row * 2] * (1.f / 512.f) + EPS);
                sc[4 + i] = rsqrtf(ssq[(size_t)row * 2 + 1] * (1.f / 512.f) + EPS);
            }
        }
        if (xmode != 4) gemm_mainloop2s(acc, As, bs, 1024, lds, tid, sc);
        float* outp = xmode ? (float*)(P.ws + OFF_U) : P.out;
#pragma unroll 1
        for (int half = 0; half < 2; ++half) {
            const int n0 = nt2 * 256 + half * 128;
            if (xmode == 3) { if (tid == 0) outp[(size_t)m0 * 1024 + n0] = acc[0][0][0] + acc[1][3][5]; continue; }
            dump_acc2(acc, Ct, tid, half);
            __syncthreads();
            for (int it = tid; it < 256 * 32; it += NTHREADS) {
                const int row = it >> 5, c4 = it & 31;
                const size_t o = (size_t)(m0 + row) * 1024 + n0 + c4 * 4;
                const f32x4 v = *(const f32x4*)(Ct + row * CT_STRIDE + c4 * 4);
                const f32x4 xv = *(const f32x4*)(x + o);
                *(f32x4*)(outp + o) = xv + v;
            }
            __syncthreads();
        }
    }
    __syncthreads();
}
constexpr int RSTR = 264;
constexpr int R_AHI = 0, R_ALO = 64 * RSTR * 2, R_WHI = 2 * 64 * RSTR * 2, R_WLO = R_WHI + 40 * RSTR * 2, R_END = R_WLO + 40 * RSTR * 2;
struct RtRegs { f32x4 x[8]; u32x4 w[5]; };
DI void rt_load(RtRegs& R, const float* x1, const bf16_t* WrT, int m0, int c, int tid) {
    const int lane = tid & 63, w = tid >> 6;
#pragma unroll
    for (int i = 0; i < 8; ++i) R.x[i] = *(const f32x4*)(x1 + (size_t)(m0 + w * 8 + i) * 1024 + c * 256 + lane * 4);
#pragma unroll
    for (int i = 0; i < 5; ++i) { const int ch = tid + 512 * i, rw = ch >> 5, c16 = ch & 31;
        R.w[i] = *(const u32x4*)(WrT + (size_t)rw * 1024 + c * 256 + c16 * 8); }
}
DI void phase8(const Params& P, unsigned char* lds_raw, int tid, bool dry = false) {
    unsigned char* ws = P.ws;
    const float* x1 = P.out; const float* g2 = P.in[26];
    bf16_t* xg = (bf16_t*)(ws + (dry ? OFF_XN : OFF_H2HI));
    const bf16_t* WrT = (const bf16_t*)(ws + OFF_WRT);
    float* rs2 = (float*)(ws + OFF_RS2);
    unsigned* cnt = (unsigned*)(ws + OFF_CTL) + CW_CNT + (dry ? 64 * CNT_STRIDE : 0);
    int* list = (int*)(ws + (dry ? OFF_ACT : OFF_LIST)); float* listw = (float*)(ws + (dry ? OFF_ACT + (size_t)64 * T * 4 : OFF_LISTW));
    bf16_t* Ahi = (bf16_t*)(lds_raw + R_AHI); bf16_t* Alo = (bf16_t*)(lds_raw + R_ALO);
    bf16_t* Whi = (bf16_t*)(lds_raw + R_WHI);
    float* part = (float*)lds_raw;
    float* ssqp = (float*)(lds_raw + R_END);
    unsigned* hist = (unsigned*)(lds_raw + R_END + 256);
    unsigned* lbase = hist + 64;
    const int lane = tid & 63, w = tid >> 6, r = lane & 31, h = lane >> 5, mh = w & 1, ks = w >> 1;
    const int n0 = r, n1 = 32 + r < 40 ? 32 + r : 39;
    for (int u = blockIdx.x; u < 256; u += gridDim.x) {
        const int m0 = u * 64;
        f32x16 acc0, acc1;
#pragma unroll
        for (int i = 0; i < 16; ++i) { acc0[i] = 0.f; acc1[i] = 0.f; }
        float ssq[8];
#pragma unroll
        for (int i = 0; i < 8; ++i) ssq[i] = 0.f;
        RtRegs R;
        rt_load(R, x1, WrT, m0, 0, tid);
        __syncthreads();
#pragma unroll 1
        for (int c = 0; c < 4; ++c) {
            {
                const f32x4 g = *(const f32x4*)(g2 + c * 256 + lane * 4);
#pragma unroll
                for (int i = 0; i < 8; ++i) {
                    f32x4 v = R.x[i];
                    ssq[i] += (v.x * v.x + v.y * v.y) + (v.z * v.z + v.w * v.w);
                    v = v * g;
                    u32x2 hv; hv.x = pk2(v.x, v.y); hv.y = pk2(v.z, v.w);
                    u32x2 lv; lv.x = pk2(v.x - bf2f(hv.x & 0xffffu), v.y - bf2f(hv.x >> 16)); lv.y = pk2(v.z - bf2f(hv.y & 0xffffu), v.w - bf2f(hv.y >> 16));
                    const int row = w * 8 + i;
                    *(u32x2*)(Ahi + row * RSTR + lane * 4) = hv;
                    *(u32x2*)(Alo + row * RSTR + lane * 4) = lv;
                    *(u32x2*)(xg + (size_t)(m0 + row) * 1024 + c * 256 + lane * 4) = hv;
                }
#pragma unroll
                for (int i = 0; i < 5; ++i) { const int ch = tid + 512 * i, rw = ch >> 5, c16 = ch & 31; *(u32x4*)(Whi + rw * RSTR + c16 * 8) = R.w[i]; }
            }
            if (c < 3) rt_load(R, x1, WrT, m0, c + 1, tid);
            __syncthreads();
#pragma unroll 2
            for (int s4 = 0; s4 < 4; ++s4) {
                const int ko = (ks * 4 + s4) * 16 + 8 * h;
                const bf16x8 ah = *(const bf16x8*)(Ahi + (32 * mh + r) * RSTR + ko), al = *(const bf16x8*)(Alo + (32 * mh + r) * RSTR + ko);
                const bf16x8 wh0 = *(const bf16x8*)(Whi + n0 * RSTR + ko), wh1 = *(const bf16x8*)(Whi + n1 * RSTR + ko);
                const bf16x8 wl0 = *(const bf16x8*)(Whi + (40 + n0) * RSTR + ko), wl1 = *(const bf16x8*)(Whi + (40 + n1) * RSTR + ko);
                acc0 = MFMA32(ah, wh0, acc0); acc1 = MFMA32(ah, wh1, acc1);
                acc0 = MFMA32(ah, wl0, acc0); acc1 = MFMA32(ah, wl1, acc1);
                acc0 = MFMA32(al, wh0, acc0); acc1 = MFMA32(al, wh1, acc1);
            }
            __syncthreads();
        }
#pragma unroll
        for (int i = 0; i < 16; ++i) {
            float* d = part + ((ks * 64) + 32 * mh + crow(i, h)) * 64 + r;
            d[0] = acc0[i]; d[32] = acc1[i];
        }
#pragma unroll
        for (int i = 0; i < 8; ++i) { const float sv = wave_sum(ssq[i]); if (lane == 0) ssqp[w * 8 + i] = sv; }
        if (tid < 64) hist[tid] = 0u;
        __syncthreads();
        int vl0 = 0, vl1 = 0; unsigned lr0 = 0, lr1 = 0; float w0 = 0.f, w1 = 0.f;
        if (tid < 64) {
            const int t = tid, grow = m0 + t;
            const float rs = rsqrtf(ssqp[t] * (1.f / 1024.f) + EPS);
            const float* b_grp = P.in[28]; const float* b_exp = P.in[30];
            float gl[4]; int gsel = 0; float gmax = -3e38f;
#pragma unroll
            for (int j = 0; j < 4; ++j) {
                gl[j] = rs * ((part[t * 64 + j] + part[(64 + t) * 64 + j]) + (part[(128 + t) * 64 + j] + part[(192 + t) * 64 + j])) + b_grp[j];
                if (gl[j] > gmax) { gmax = gl[j]; gsel = j; }
            }
            float gsum = 0.f;
#pragma unroll
            for (int j = 0; j < 4; ++j) gsum += __expf(gl[j] - gmax);
            const float gprob = 1.f / gsum;
            float el[8]; float emax = -3e38f;
#pragma unroll
            for (int j = 0; j < 8; ++j) {
                const int cc = 4 + gsel * 8 + j;
                el[j] = rs * ((part[t * 64 + cc] + part[(64 + t) * 64 + cc]) + (part[(128 + t) * 64 + cc] + part[(192 + t) * 64 + cc])) + b_exp[gsel * 8 + j];
                emax = fmaxf(emax, el[j]);
            }
            int i0 = 0; float v0 = -3e38f;
#pragma unroll
            for (int j = 0; j < 8; ++j) if (el[j] > v0) { v0 = el[j]; i0 = j; }
            int i1 = 0; float v1 = -3e38f;
#pragma unroll
            for (int j = 0; j < 8; ++j) if (j != i0 && el[j] > v1) { v1 = el[j]; i1 = j; }
            const float p0 = __expf(v0 - emax), p1 = __expf(v1 - emax);
            w0 = p0 / (p0 + p1) * gprob; w1 = p1 / (p0 + p1) * gprob;
            vl0 = gsel * 8 + i0; vl1 = 32 + gsel * 8 + i1;
            if (!dry) rs2[grow] = rs;
            lr0 = atomicAdd(&hist[vl0], 1u);
            lr1 = atomicAdd(&hist[vl1], 1u);
        }
        __syncthreads();
        if (tid < 64) { const unsigned hc = hist[tid]; lbase[tid] = hc ? atomicAdd(&cnt[tid * CNT_STRIDE], hc) : 0u; }
        __syncthreads();
        if (tid < 64) {
            const int grow = m0 + tid;
            const unsigned q0 = lbase[vl0] + lr0, q1 = lbase[vl1] + lr1;
            list[(size_t)vl0 * T + q0] = grow; listw[(size_t)vl0 * T + q0] = w0;
            list[(size_t)vl1 * T + q1] = grow; listw[(size_t)vl1 * T + q1] = w1;
        }
    }
    __syncthreads();
}
DI bool moe_unit(const unsigned* cnt, int u, int ntn, int vlo, int vhi, int& v, int& mt, int& nt, int& base, int& M) {
    int acc = 0, b = 0;
    for (int vv = 0; vv < vhi; ++vv) {
        const int c = (int)cnt[vv * CNT_STRIDE];
        if (vv >= vlo) {
            const int nu = ((c + 255) >> 8) * ntn;
            if (u < acc + nu) { const int loc = u - acc; v = vv; mt = loc / ntn; nt = loc - mt * ntn; base = b; M = c; return true; }
            acc += nu;
        }
        b += c;
    }
    return false;
}
DI void phase9(const Params& P, unsigned char* lds_raw, int tid) {
    asm volatile("" : "+v"(tid));
    bf16_t* lds = (bf16_t*)lds_raw; float* Ct = (float*)lds_raw;
    unsigned char* ws = P.ws;
    unsigned* ctl = (unsigned*)(ws + OFF_CTL);
    const unsigned* cnt = ctl + CW_CNT;
    const bf16_t* hi = (const bf16_t*)(ws + OFF_H2HI);
    const int* list = (const int*)(ws + OFF_LIST); const float* listw = (const float*)(ws + OFF_LISTW);
    const float* rs2 = (const float*)(ws + OFF_RS2);
    bf16_t* act = (bf16_t*)(ws + OFF_ACT);
    bf16_t* Y0 = (bf16_t*)(ws + OFF_XN);
    int total1 = 0, total2a = 0, total2b = 0;
    for (int vv = 0; vv < 64; ++vv) { const int mtv = ((int)cnt[vv * CNT_STRIDE] + 255) >> 8; total1 += mtv * 2; if (vv < 32) total2a += mtv * 4; else total2b += mtv * 4; }
    const int total = total1 + total2a + total2b;
    volatile unsigned* wq = (volatile unsigned*)(lds_raw + LDS_BYTES - 64) + 8;
    int u = vbid();
    while (u < total) {
        unsigned nxt = 0;
        if (tid == 0) nxt = gridDim.x + __hip_atomic_fetch_add(ctl + CW_WQ, 1u, __ATOMIC_RELAXED, __HIP_MEMORY_SCOPE_AGENT);
        int v, mt, nt, base, M;
        if (u < total1) {
            if (!moe_unit(cnt, u, 2, 0, 64, v, mt, nt, base, M)) break;
            const int e = v & 31;
            const int m0 = mt * 256;
            const int* rows = list + (size_t)v * T;
            f32x16 acc[2][4]; zero_acc2(acc);
            const ASrc As = make_a(hi, 1024, rows, M, m0, tid);
            const BSrc2 bs = make_b2((const bf16_t*)(ws + OFF_WGUT) + (size_t)e * 512 * 1024, 1024, 512, nt * 256, tid);
            __syncthreads();
            gemm_mainloop2(acc, As, bs, 1024, lds, tid);
#pragma unroll 1
            for (int half = 0; half < 2; ++half) {
                const int nq = nt * 2 + half;
                dump_acc2(acc, Ct, tid, half);
                __syncthreads();
                for (int it = tid; it < 256 * 16; it += NTHREADS) {
                    const int row = it >> 4, q = it & 15, wn_ = q >> 3, c = (q & 7) * 4;
                    if (m0 + row < M) {
                        const float rs = rs2[rows[m0 + row]];
                        const f32x4 gt = *(const f32x4*)(Ct + row * CT_STRIDE + wn_ * 64 + c) * rs;
                        const f32x4 up = *(const f32x4*)(Ct + row * CT_STRIDE + wn_ * 64 + 32 + c) * rs;
                        u32x2 o; o.x = pk2(gt.x * sigmoidf(gt.x) * up.x, gt.y * sigmoidf(gt.y) * up.y); o.y = pk2(gt.z * sigmoidf(gt.z) * up.z, gt.w * sigmoidf(gt.w) * up.w);
                        st_wt8(act + (size_t)(base + m0 + row) * 256 + nq * 64 + wn_ * 32 + c, o);
                    }
                }
                __syncthreads();
            }
            unit_signal(ctl + CW_DONE + v * 64 + mt, tid);
        } else {
            const bool slot1 = u >= total1 + total2a;
            if (!moe_unit(cnt, slot1 ? u - total1 - total2a : u - total1, 4, slot1 ? 32 : 0, slot1 ? 64 : 32, v, mt, nt, base, M)) break;
            const int e = v & 31;
            const int m0 = mt * 256;
            const bf16_t* A = act + (size_t)base * 256;
            f32x16 acc[2][4]; zero_acc2(acc);
            const ASrc As = make_a(A, 256, nullptr, M, m0, tid);
            const BSrc2 bs = make_b2((const bf16_t*)(ws + OFF_WDT) + (size_t)e * 1024 * 256, 256, 1024, nt * 256, tid);
            unit_wait2(ctl + CW_DONE + v * 64 + mt, 2u, slot1 ? ctl + CW_S0DONE : nullptr, (unsigned)total2a, tid);
            gemm_mainloop2(acc, As, bs, 256, lds, tid);
#pragma unroll 1
            for (int half = 0; half < 2; ++half) {
                const int n0 = nt * 256 + half * 128;
                dump_acc2(acc, Ct, tid, half);
                __syncthreads();
                for (int it = tid; it < 256 * 32; it += NTHREADS) {
                    const int row = it >> 5, c4 = it & 31;
                    if (m0 + row < M) {
                        const int tok = list[(size_t)v * T + m0 + row];
                        const float wgt = listw[(size_t)v * T + m0 + row];
                        const f32x4 cv = *(const f32x4*)(Ct + row * CT_STRIDE + c4 * 4) * wgt;
                        bf16_t* yp = Y0 + (size_t)tok * 1024 + n0 + c4 * 4;
                        if (!slot1) {
                            u32x2 o; o.x = pk2(cv.x, cv.y); o.y = pk2(cv.z, cv.w);
                            st_wt8(yp, o);
                        } else {
                            float* o = P.out + (size_t)tok * 1024 + n0 + c4 * 4;
                            const u32x2 yy = *(const u32x2*)yp;
                            f32x4 nv = *(const f32x4*)o + cv;
                            nv.x += bf2f(yy.x & 0xffffu); nv.y += bf2f(yy.x >> 16); nv.z += bf2f(yy.y & 0xffffu); nv.w += bf2f(yy.y >> 16);
                            *(f32x4*)o = nv;
                        }
                    }
                }
                __syncthreads();
            }
            if (!slot1) unit_signal(ctl + CW_S0DONE, tid);
        }
        if (tid == 0) wq[0] = nxt;
        __syncthreads();
        u = __builtin_amdgcn_readfirstlane((int)wq[0]);
    }
    __syncthreads();
}

constexpr int NPHASES = 10;
__global__ void __launch_bounds__(NTHREADS, 2) mk(Params P) {
    extern __shared__ __attribute__((aligned(16))) unsigned char lds_raw[];
    const int tid = threadIdx.x;
    volatile unsigned* misc = (volatile unsigned*)(lds_raw + LDS_BYTES - 64);
    if (tid < 2) misc[tid] = 0u;
    __syncthreads();
    XcdBarrier bar; bar.bar = nullptr; bar.x = 0; bar.st = nullptr;
    const bool multi = (P.ph_hi - P.ph_lo) > 1;
    if (multi) bar = xcd_barrier_post((unsigned*)(P.ws + OFF_CTL) + CW_BAR, misc);
    const int lo = P.ph_lo, hi = P.ph_hi;
#define IN(k) (lo <= (k) && (k) < hi)
#define SEAM(k) do { if (IN(k) && IN((k) + 1)) xcd_barrier(bar); } while (0)
#ifndef PROBE_PHASE
#define PROBE_PHASE -1
#endif
#ifndef PROBE_XMODE
#define PROBE_XMODE 0
#endif
#define RUN(k, call, calldry) do { if (IN(k)) { call; if (PROBE_PHASE == (k) || PROBE_PHASE == 100 + (k) / 4) { xcd_barrier(bar); calldry; } } } while (0)
    RUN(0, phase0(P, lds_raw, tid), phase0(P, lds_raw, tid, PROBE_XMODE));
    SEAM(0);
    RUN(1, phase1(P, lds_raw, tid), phase1(P, lds_raw, tid, PROBE_XMODE));
    SEAM(1);
    RUN(2, phase2(P, lds_raw, tid), phase2(P, lds_raw, tid));
    SEAM(2);
    RUN(4, phase4(P, lds_raw, tid), phase4(P, lds_raw, tid, PROBE_XMODE ? PROBE_XMODE : 3));
    SEAM(4);
    RUN(5, phase5(P, lds_raw, tid), phase5(P, lds_raw, tid));
    SEAM(5);
    RUN(7, phase7(P, lds_raw, tid), phase7(P, lds_raw, tid, PROBE_XMODE));
    SEAM(7);
    if (IN(8)) {
        if (PROBE_PHASE == 8) {
            phase8(P, lds_raw, tid); xcd_barrier(bar);
            if (blockIdx.x == 0 && tid < 64) ((unsigned*)(P.ws + OFF_CTL))[CW_CNT + tid * CNT_STRIDE] = 0u;
            xcd_barrier(bar);
        }
        phase8(P, lds_raw, tid);
    }
    SEAM(8);
    if (IN(9)) phase9(P, lds_raw, tid);
#undef RUN
#undef IN
#undef SEAM
}

extern "C" void kernel_launch(void* const* d_in, const int* in_sizes, int n_in, void* d_out, int out_size, void* d_ws, size_t ws_size, hipStream_t stream) {
    static int grid = 0;
    if (grid == 0) {
        if (n_in != 34 || out_size != T * DM || ws_size < WS_END) {
            fprintf(stderr, "kernel_launch: unexpected shapes: n_in %d out %d ws %zu (need %zu)\n", n_in, out_size, ws_size, (size_t)WS_END);
            grid = -1; return;
        }
        int dev = 0, cus = 0;
        hipGetDevice(&dev);
        hipDeviceGetAttribute(&cus, hipDeviceAttributeMultiprocessorCount, dev);
        hipFuncSetAttribute((const void*)mk, hipFuncAttributeMaxDynamicSharedMemorySize, LDS_BYTES);
        int per_cu = 0;
        hipOccupancyMaxActiveBlocksPerMultiprocessor(&per_cu, (const void*)mk, NTHREADS, LDS_BYTES);
        (void)hipGetLastError();
        if (per_cu < 1) fprintf(stderr, "kernel_launch: occupancy query says %d blocks/CU\n", per_cu);
        grid = cus > 0 ? cus : 256;
    }
    if (grid < 0) return;
    hipMemsetAsync((char*)d_ws + OFF_CTL, 0, CTL_BYTES, stream);
    Params p{};
    for (int i = 0; i < 34; ++i) p.in[i] = (const float*)d_in[i];
    p.out = (float*)d_out; p.ws = (unsigned char*)d_ws;
#ifndef MK_ONE_LAUNCH
    for (int ph = 0; ph < NPHASES; ++ph) {
        p.ph_lo = ph; p.ph_hi = ph + 1;
        hipLaunchKernelGGL(mk, dim3(grid), dim3(NTHREADS), LDS_BYTES, stream, p);
    }
#else
    p.ph_lo = 0; p.ph_hi = NPHASES;
    hipLaunchKernelGGL(mk, dim3(grid), dim3(NTHREADS), LDS_BYTES, stream, p);
#endif
}
```

```cpp
#define MK_ONE_LAUNCH 1
#include <hip/hip_runtime.h>
#include <stdint.h>
#include <cstdio>

#define DI __device__ __forceinline__
typedef unsigned short bf16_t;
typedef short bf16x8 __attribute__((ext_vector_type(8)));
typedef short s16x4 __attribute__((ext_vector_type(4)));
typedef float f32x16 __attribute__((ext_vector_type(16)));
typedef float f32x4 __attribute__((ext_vector_type(4)));
typedef unsigned u32x4 __attribute__((ext_vector_type(4)));
typedef unsigned u32x2 __attribute__((ext_vector_type(2)));

constexpr int T = 16384, SEQ = 4096, NBATCH = 4, DM = 1024, DIN = 1816;
constexpr int NTHREADS = 512;
constexpr float EPS = 1e-6f;

constexpr size_t al256(size_t x) { return (x + 255) & ~(size_t)255; }
constexpr size_t OFF_CTL   = 0;
constexpr size_t CTL_BYTES = 65536;
constexpr size_t OFF_XN    = OFF_CTL + CTL_BYTES;
constexpr size_t OFF_U     = OFF_XN + (size_t)T * 1024 * 2;
constexpr size_t OFF_QN    = OFF_U + (size_t)T * 512 * 2;
constexpr size_t KV_BYTES  = (size_t)8 * 4096 * 64 * 2;
constexpr size_t OFF_KC    = OFF_QN + (size_t)T * 512 * 2;
constexpr size_t OFF_VC    = OFF_KC + KV_BYTES;
constexpr size_t OFF_KSN   = OFF_VC + KV_BYTES;
constexpr size_t OFF_KWN   = OFF_KSN + KV_BYTES;
constexpr size_t OFF_VST   = OFF_KWN + KV_BYTES;
constexpr size_t OFF_VWT   = OFF_VST + KV_BYTES;
constexpr size_t OFF_GATES = OFF_VWT + KV_BYTES;
constexpr size_t OFF_TGT   = OFF_GATES + (size_t)T * 24 * 4;
constexpr size_t OFF_EGT   = OFF_TGT + (size_t)32 * 512 * 512 * 2;
constexpr size_t OFF_FGT   = OFF_EGT + (size_t)32 * 128 * 512 * 2;
constexpr size_t OFF_LAM32 = OFF_FGT + (size_t)32 * 512 * 128 * 2;
constexpr size_t OFF_BIASP = OFF_LAM32 + 32 * 64 * 2 * 4;
constexpr size_t OFF_Z     = OFF_BIASP + 2 * 16 * 256 * 4;
constexpr size_t OFF_SIN   = OFF_Z + (size_t)32 * 512 * 128 * 4;
constexpr size_t OFF_P     = OFF_SIN + (size_t)32 * 512 * 128 * 2;
constexpr size_t OFF_KCMP  = OFF_P + (size_t)2 * 8 * 2 * 256 * 256 * 4;
constexpr size_t OFF_VCMPT = OFF_KCMP + 8 * 256 * 64 * 2;
constexpr size_t OFF_Y1    = OFF_VCMPT + 8 * 64 * 256 * 2;
constexpr size_t OFF_H2HI  = OFF_U;
constexpr size_t OFF_H2LO  = OFF_TGT;
constexpr size_t OFF_ACT   = OFF_Y1;
constexpr size_t OFF_LIST  = OFF_Y1 + (size_t)T * 512 * 2;
constexpr size_t OFF_LISTW = OFF_LIST + (size_t)64 * T * 4;
constexpr size_t OFF_RS2   = OFF_LISTW + (size_t)64 * T * 4;
constexpr size_t OFF_SSQ   = OFF_RS2 + (size_t)T * 4;
constexpr size_t OFF_WINT  = OFF_SSQ + (size_t)T * 2 * 4;
constexpr size_t OFF_WGLUT = OFF_WINT + (size_t)1816 * 1024 * 2;
constexpr size_t OFF_WC1T  = OFF_WGLUT + (size_t)512 * 512 * 2;
constexpr size_t OFF_WOUTT = OFF_WC1T + (size_t)4 * 256 * 1024 * 2;
constexpr size_t OFF_WRT   = OFF_WOUTT + (size_t)1024 * 1024 * 2;
constexpr size_t OFF_WGUT  = OFF_WRT + (size_t)2 * 40 * 1024 * 2;
constexpr size_t OFF_WDT   = OFF_WGUT + (size_t)32 * 512 * 1024 * 2;
constexpr size_t WS_END    = OFF_WDT + (size_t)32 * 1024 * 256 * 2;
static_assert(OFF_H2HI + (size_t)T * 1024 * 2 <= OFF_KC, "h2hi overlay");
static_assert(OFF_H2LO + (size_t)T * 1024 * 2 <= OFF_SIN, "h2lo overlay");
static_assert(WS_END <= (size_t)256 * 1024 * 1024, "workspace");

constexpr int CW_CNT = 8192;
constexpr int CNT_STRIDE = 32;
constexpr int CW_WQ = 4736;
constexpr int CW_S0DONE = 4608;
constexpr int CW_DONE = 12288;
constexpr int CW_PDONE = 4864;
constexpr int CW_BAR = 1024;

constexpr int LDS_BYTES = 151552;
constexpr int BM = 256, BN = 128, BK = 64;
constexpr int LSTR = 72;
constexpr int A_TILE = BM * LSTR;
constexpr int B_TILE = BN * LSTR;
constexpr int STAGE_ELEMS = A_TILE + B_TILE;
constexpr int CT_STRIDE = 132;
constexpr int STAGE2_ELEMS = (BM + 256) * LSTR;

struct Params {
    const float* in[34];
    float* out;
    unsigned char* ws;
    int ph_lo, ph_hi;
};

DI unsigned f2bf(float f) { unsigned u = __builtin_bit_cast(unsigned, f); return (u + 0x7fffu + ((u >> 16) & 1u)) >> 16; }
DI float bf2f(unsigned b) { return __builtin_bit_cast(float, b << 16); }
typedef float f32x2 __attribute__((ext_vector_type(2)));
typedef __bf16 bf16x2_t __attribute__((ext_vector_type(2)));
DI unsigned pk2(float lo, float hi) { f32x2 v = {lo, hi}; bf16x2_t b = __builtin_convertvector(v, bf16x2_t); return __builtin_bit_cast(unsigned, b); }
DI float wave_sum(float v) {
#pragma unroll
    for (int o = 1; o < 64; o <<= 1) v += __shfl_xor(v, o);
    return v;
}
DI float gelu_tanh(float x) {
    const float k0 = 0.7978845608028654f, k1 = 0.044715f;
    float u = k0 * (x + k1 * x * x * x);
    float e = __expf(2.f * u);
    float th = 1.f - 2.f / (e + 1.f);
    return 0.5f * x * (1.f + th);
}
DI float sigmoidf(float x) { return 1.f / (1.f + __expf(-x)); }
DI int vbid() { const int G = gridDim.x, b = blockIdx.x; return (G & 7) == 0 ? (b & 7) * (G >> 3) + (b >> 3) : b; }
DI int crow(int reg, int h) { return (reg & 3) + 8 * (reg >> 2) + 4 * h; }
#define MFMA32(a, b, c) __builtin_amdgcn_mfma_f32_32x32x16_bf16((a), (b), (c), 0, 0, 0)

#define XB_TMO      128
#define XB_XCNT(j)  (256  + 64 * (j))
#define XB_XSUB(j)  (1280 + 64 * (j))
#define XB_XGEN(j)  (2304 + 64 * (j))
#define XB_TOP      3328
#define XB_TOPGEN   3392
#define XCD_BAR_WORDS 3456
#define XB_SPIN_CAP (1u << 22)
DI unsigned xb_ld(unsigned* p)              { return __hip_atomic_load(p, __ATOMIC_RELAXED, __HIP_MEMORY_SCOPE_AGENT); }
DI unsigned xb_add(unsigned* p, unsigned v) { return __hip_atomic_fetch_add(p, v, __ATOMIC_RELAXED, __HIP_MEMORY_SCOPE_AGENT); }
DI unsigned xb_xcc_id() { return (unsigned)__builtin_amdgcn_s_getreg((3 << 11) | 20) & 0xFu; }
#define XB_SPIN(cond, bar) do { unsigned _sp = 0; while (cond) { __builtin_amdgcn_s_sleep(1); \
    if ((++_sp & 255u) == 0u) { if (xb_ld(&(bar)[XB_TMO])) break; if (_sp > XB_SPIN_CAP) { atomicAdd(&(bar)[XB_TMO], 1u); break; } } } } while (0)
struct XcdBarrier { unsigned* bar; unsigned x; volatile unsigned* st; };
DI XcdBarrier xcd_barrier_post(unsigned* bar, volatile unsigned* st) {
    XcdBarrier b; b.bar = bar; b.x = xb_xcc_id(); b.st = st;
    if (threadIdx.x == 0) (void)xb_add(&bar[XB_XCNT(b.x)], 1u);
    return b;
}
DI void xcd_barrier_complete(unsigned* bar, unsigned x, unsigned& nloc, unsigned& nx) {
    const unsigned G = gridDim.x;
    unsigned sum, cnt, mine, sp = 0u;
    for (;;) {
        sum = 0u; cnt = 0u; mine = 0u;
#pragma unroll
        for (unsigned j = 0; j < 16; ++j) { const unsigned c = xb_ld(&bar[XB_XCNT(j)]); sum += c; cnt += (c > 0u) ? 1u : 0u; mine = (j == x) ? c : mine; }
        if (sum == G) break;
        __builtin_amdgcn_s_sleep(1);
        if ((++sp & 255u) == 0u) { if (xb_ld(&bar[XB_TMO])) break; if (sp > XB_SPIN_CAP) { atomicAdd(&bar[XB_TMO], 1u); break; } }
    }
    nloc = mine > 0u ? mine : 1u; nx = cnt > 0u ? cnt : 1u;
}
DI void xcd_barrier(const XcdBarrier& b) {
    asm volatile("s_waitcnt vmcnt(0)" ::: "memory");
    __syncthreads();
    if (threadIdx.x == 0) {
        unsigned* bar = b.bar;
        __builtin_amdgcn_s_waitcnt(0);
        unsigned nloc = b.st[0], nx = b.st[1];
        if (nloc == 0u) { xcd_barrier_complete(bar, b.x, nloc, nx); b.st[0] = nloc; b.st[1] = nx; }
        const unsigned old = xb_add(&bar[XB_XSUB(b.x)], 1u);
        const unsigned gen = old / nloc;
        if (old + 1u == (gen + 1u) * nloc) {
            __builtin_amdgcn_fence(__ATOMIC_RELEASE, "agent");
            asm volatile("s_waitcnt vmcnt(0)" ::: "memory");
            const unsigned og = xb_add(&bar[XB_TOP], 1u);
            const unsigned tg = og / nx;
            if (og + 1u == (tg + 1u) * nx) xb_add(&bar[XB_TOPGEN], 1u);
            else XB_SPIN(xb_ld(&bar[XB_TOPGEN]) == tg, bar);
            __builtin_amdgcn_fence(__ATOMIC_ACQUIRE, "agent");
            xb_add(&bar[XB_XGEN(b.x)], 1u);
            asm volatile("s_waitcnt vmcnt(0)" ::: "memory");
        } else {
            XB_SPIN(xb_ld(&bar[XB_XGEN(b.x)]) == gen, bar);
            __builtin_amdgcn_fence(__ATOMIC_ACQUIRE, "agent");
            asm volatile("s_waitcnt vmcnt(0)" ::: "memory");
        }
    }
    __syncthreads();
}

struct BSrcBf { const bf16_t* p0; const bf16_t* p1; };
struct GRegs { u32x4 a0, a1, a2, a3, b0, b1; };
struct ASrc { const bf16_t* a0; const bf16_t* a1; const bf16_t* a2; const bf16_t* a3; };
DI void g_load(GRegs& r, const ASrc& A, const BSrcBf& B, int kb) {
    const int ko = kb * BK;
    r.a0 = *(const u32x4*)(A.a0 + ko); r.a1 = *(const u32x4*)(A.a1 + ko); r.a2 = *(const u32x4*)(A.a2 + ko); r.a3 = *(const u32x4*)(A.a3 + ko);
    r.b0 = *(const u32x4*)(B.p0 + ko); r.b1 = *(const u32x4*)(B.p1 + ko);
}
DI void g_store(const GRegs& r, bf16_t* st, int tid) {
    const int off = (tid >> 3) * LSTR + (tid & 7) * 8;
    *(u32x4*)(st + off) = r.a0; *(u32x4*)(st + off + 64 * LSTR) = r.a1; *(u32x4*)(st + off + 128 * LSTR) = r.a2; *(u32x4*)(st + off + 192 * LSTR) = r.a3;
    *(u32x4*)(st + A_TILE + off) = r.b0; *(u32x4*)(st + A_TILE + off + 64 * LSTR) = r.b1;
}
DI void g_compute(f32x16 (&acc)[2][2], const bf16_t* st, int wm, int wn, int r, int h) {
    const bf16_t* ab = st + (wm * 64 + r) * LSTR + h * 8;
    const bf16_t* bb = st + A_TILE + (wn * 64 + r) * LSTR + h * 8;
#pragma unroll
    for (int s = 0; s < 4; ++s) {
        const bf16x8 af0 = *(const bf16x8*)(ab + s * 16);
        const bf16x8 af1 = *(const bf16x8*)(ab + 32 * LSTR + s * 16);
        const bf16x8 bf0 = *(const bf16x8*)(bb + s * 16);
        const bf16x8 bf1 = *(const bf16x8*)(bb + 32 * LSTR + s * 16);
        acc[0][0] = MFMA32(af0, bf0, acc[0][0]);
        acc[0][1] = MFMA32(af0, bf1, acc[0][1]);
        acc[1][0] = MFMA32(af1, bf0, acc[1][0]);
        acc[1][1] = MFMA32(af1, bf1, acc[1][1]);
    }
}
DI void gemm_mainloop(f32x16 (&acc)[2][2], const ASrc& A, const BSrcBf& B, int K, bf16_t* lds, int tid, int xmode = 0) {
    const int lane = tid & 63, w = tid >> 6, r = lane & 31, h = lane >> 5;
    const int wm = w >> 1, wn = w & 1;
    const int nk = K / BK;
    GRegs RA, RB;
    g_load(RA, A, B, 0);
    g_store(RA, lds, tid);
    if (nk > 1) g_load(RA, A, B, 1);
    if (nk > 2) g_load(RB, A, B, 2);
    __syncthreads();
    for (int kb = 0; kb < nk; kb += 2) {
        if (xmode != 2) g_compute(acc, lds, wm, wn, r, h);
        if (kb + 1 < nk) g_store(RA, lds + STAGE_ELEMS, tid);
        if (kb + 3 < nk) g_load(RA, A, B, xmode == 1 ? 0 : kb + 3);
        __syncthreads();
        if (kb + 1 >= nk) break;
        if (xmode != 2) g_compute(acc, lds + STAGE_ELEMS, wm, wn, r, h);
        if (kb + 2 < nk) g_store(RB, lds, tid);
        if (kb + 4 < nk) g_load(RB, A, B, xmode == 1 ? 1 : kb + 4);
        __syncthreads();
    }
}

DI void zero_acc(f32x16 (&acc)[2][2]) {
#pragma unroll
    for (int a = 0; a < 2; ++a)
#pragma unroll
        for (int b = 0; b < 2; ++b)
#pragma unroll
            for (int i = 0; i < 16; ++i) acc[a][b][i] = 0.f;
}
DI void dump_acc(const f32x16 (&acc)[2][2], float* Ct, int tid) {
    const int lane = tid & 63, w = tid >> 6, r = lane & 31, h = lane >> 5;
    const int wm = w >> 1, wn = w & 1;
#pragma unroll
    for (int tm = 0; tm < 2; ++tm)
#pragma unroll
        for (int tn = 0; tn < 2; ++tn)
#pragma unroll
            for (int i = 0; i < 16; ++i)
                Ct[(wm * 64 + tm * 32 + crow(i, h)) * CT_STRIDE + wn * 64 + tn * 32 + r] = acc[tm][tn][i];
}
struct BSrc2 { const bf16_t* p0; const bf16_t* p1; const bf16_t* p2; const bf16_t* p3; };
struct GRegs2 { u32x4 a0, a1, a2, a3, b0, b1, b2, b3; };
DI void g2_load(GRegs2& r, const ASrc& A, const BSrc2& B, int kb) {
    const int ko = kb * BK;
    r.a0 = *(const u32x4*)(A.a0 + ko); r.a1 = *(const u32x4*)(A.a1 + ko); r.a2 = *(const u32x4*)(A.a2 + ko); r.a3 = *(const u32x4*)(A.a3 + ko);
    r.b0 = *(const u32x4*)(B.p0 + ko); r.b1 = *(const u32x4*)(B.p1 + ko); r.b2 = *(const u32x4*)(B.p2 + ko); r.b3 = *(const u32x4*)(B.p3 + ko);
}
DI void g2_store(const GRegs2& r, bf16_t* st, int tid) {
    const int off = (tid >> 3) * LSTR + (tid & 7) * 8;
    *(u32x4*)(st + off) = r.a0; *(u32x4*)(st + off + 64 * LSTR) = r.a1; *(u32x4*)(st + off + 128 * LSTR) = r.a2; *(u32x4*)(st + off + 192 * LSTR) = r.a3;
    bf16_t* sb = st + A_TILE;
    *(u32x4*)(sb + off) = r.b0; *(u32x4*)(sb + off + 64 * LSTR) = r.b1; *(u32x4*)(sb + off + 128 * LSTR) = r.b2; *(u32x4*)(sb + off + 192 * LSTR) = r.b3;
}
DI void g2_compute(f32x16 (&acc)[2][4], const bf16_t* st, int wm, int wn, int r, int h) {
    const bf16_t* ab = st + (wm * 64 + r) * LSTR + h * 8;
    const bf16_t* bb = st + A_TILE + (wn * 128 + r) * LSTR + h * 8;
#pragma unroll
    for (int s = 0; s < 4; ++s) {
        const bf16x8 af0 = *(const bf16x8*)(ab + s * 16);
        const bf16x8 af1 = *(const bf16x8*)(ab + 32 * LSTR + s * 16);
#pragma unroll
        for (int tn = 0; tn < 4; ++tn) {
            const bf16x8 bf = *(const bf16x8*)(bb + tn * 32 * LSTR + s * 16);
            acc[0][tn] = MFMA32(af0, bf, acc[0][tn]);
            acc[1][tn] = MFMA32(af1, bf, acc[1][tn]);
        }
    }
}
DI void gemm_mainloop2(f32x16 (&acc)[2][4], const ASrc& A, const BSrc2& B, int K, bf16_t* lds, int tid) {
    const int lane = tid & 63, w = tid >> 6, r = lane & 31, h = lane >> 5;
    const int wm = w >> 1, wn = w & 1;
    const int nk = K / BK;
    GRegs2 RA;
    g2_load(RA, A, B, 0);
    g2_store(RA, lds, tid);
    if (nk > 1) g2_load(RA, A, B, 1);
    __syncthreads();
    for (int kb = 0; kb < nk; ++kb) {
        g2_compute(acc, lds + (kb & 1) * STAGE2_ELEMS, wm, wn, r, h);
        if (kb + 1 < nk) g2_store(RA, lds + ((kb + 1) & 1) * STAGE2_ELEMS, tid);
        if (kb + 2 < nk) g2_load(RA, A, B, kb + 2);
        __syncthreads();
    }
}
DI u32x4 scale8(u32x4 v, float sc) {
    u32x4 o;
    o.x = pk2(__builtin_bit_cast(float, v.x << 16) * sc, __builtin_bit_cast(float, v.x & 0xffff0000u) * sc);
    o.y = pk2(__builtin_bit_cast(float, v.y << 16) * sc, __builtin_bit_cast(float, v.y & 0xffff0000u) * sc);
    o.z = pk2(__builtin_bit_cast(float, v.z << 16) * sc, __builtin_bit_cast(float, v.z & 0xffff0000u) * sc);
    o.w = pk2(__builtin_bit_cast(float, v.w << 16) * sc, __builtin_bit_cast(float, v.w & 0xffff0000u) * sc);
    return o;
}
DI void gemm_mainloop2s(f32x16 (&acc)[2][4], const ASrc& A, const BSrc2& B, int K, bf16_t* lds, int tid, const float (&sc)[8]) {
    const int lane = tid & 63, w = tid >> 6, r = lane & 31, h = lane >> 5;
    const int wm = w >> 1, wn = w & 1;
    const int nk = K / BK;
    GRegs2 RA;
    g2_load(RA, A, B, 0);
    { RA.a0 = scale8(RA.a0, sc[0]); RA.a1 = scale8(RA.a1, sc[1]); RA.a2 = scale8(RA.a2, sc[2]); RA.a3 = scale8(RA.a3, sc[3]); }
    g2_store(RA, lds, tid);
    if (nk > 1) g2_load(RA, A, B, 1);
    __syncthreads();
    for (int kb = 0; kb < nk; ++kb) {
        g2_compute(acc, lds + (kb & 1) * STAGE2_ELEMS, wm, wn, r, h);
        if (kb + 1 < nk) {
            const int o = ((kb + 1) * BK < 512) ? 0 : 4;
            RA.a0 = scale8(RA.a0, sc[o]); RA.a1 = scale8(RA.a1, sc[o + 1]); RA.a2 = scale8(RA.a2, sc[o + 2]); RA.a3 = scale8(RA.a3, sc[o + 3]);
            g2_store(RA, lds + ((kb + 1) & 1) * STAGE2_ELEMS, tid);
        }
        if (kb + 2 < nk) g2_load(RA, A, B, kb + 2);
        __syncthreads();
    }
}
DI void zero_acc2(f32x16 (&acc)[2][4]) {
#pragma unroll
    for (int a = 0; a < 2; ++a)
#pragma unroll
        for (int b = 0; b < 4; ++b)
#pragma unroll
            for (int i = 0; i < 16; ++i) acc[a][b][i] = 0.f;
}
DI void dump_acc2(const f32x16 (&acc)[2][4], float* Ct, int tid, int half) {
    const int lane = tid & 63, w = tid >> 6, r = lane & 31, h = lane >> 5;
    const int wm = w >> 1, wn = w & 1;
    if (wn == half) {
#pragma unroll
        for (int tm = 0; tm < 2; ++tm)
#pragma unroll
            for (int tn = 0; tn < 4; ++tn)
#pragma unroll
                for (int i = 0; i < 16; ++i)
                    Ct[(wm * 64 + tm * 32 + crow(i, h)) * CT_STRIDE + tn * 32 + r] = acc[tm][tn][i];
    }
}
DI BSrc2 make_b2(const bf16_t* Bt, long ldb, int N, int n0, int tid) {
    BSrc2 s; const int c = (tid & 7) * 8;
    int n = n0 + (tid >> 3);
    int q0 = n < N ? n : N - 1, q1 = n + 64 < N ? n + 64 : N - 1, q2 = n + 128 < N ? n + 128 : N - 1, q3 = n + 192 < N ? n + 192 : N - 1;
    s.p0 = Bt + (long)q0 * ldb + c; s.p1 = Bt + (long)q1 * ldb + c; s.p2 = Bt + (long)q2 * ldb + c; s.p3 = Bt + (long)q3 * ldb + c; return s;
}
DI const bf16_t* a_ptr(const bf16_t* base, long lda, const int* rows, int M, int m0, int i, int tid) {
    int gm = m0 + (tid >> 3) + 64 * i;
    gm = gm < M ? gm : M - 1;
    const long src = rows ? (long)rows[gm] : (long)gm;
    return base + src * lda + (tid & 7) * 8;
}
DI ASrc make_a(const bf16_t* base, long lda, const int* rows, int M, int m0, int tid) {
    ASrc A; A.a0 = a_ptr(base, lda, rows, M, m0, 0, tid); A.a1 = a_ptr(base, lda, rows, M, m0, 1, tid);
    A.a2 = a_ptr(base, lda, rows, M, m0, 2, tid); A.a3 = a_ptr(base, lda, rows, M, m0, 3, tid); return A;
}
DI BSrcBf make_bbf(const bf16_t* Bt, long ldb, int N, int n0, int tid) {
    int n = n0 + (tid >> 3); int n1 = n + 64;
    n = n < N ? n : N - 1; n1 = n1 < N ? n1 : N - 1;
    BSrcBf s; s.p0 = Bt + (long)n * ldb + (tid & 7) * 8; s.p1 = Bt + (long)n1 * ldb + (tid & 7) * 8; return s;
}
template <class RM>
DI void tconv(const float* src, long sbatch, long sld, int K, int N, bf16_t* dst, long dbatch, long ldd, int nbatch, RM rm, int lo, long gtid, long gstride,
              const float* ks0 = nullptr, const float* ks1 = nullptr) {
    const long per = (long)N * (K >> 5), total = per * nbatch;
    for (long i = gtid; i < total; i += gstride) {
        const int bi = (int)(i / per); const long rem = i - (long)bi * per;
        const int k32 = (int)(rem / N), n = (int)(rem - (long)k32 * N);
        const float* sp = src + bi * sbatch + (long)(k32 * 32) * sld + n;
        float f[32];
#pragma unroll
        for (int j = 0; j < 32; ++j) f[j] = sp[(long)j * sld];
        if (lo) {
#pragma unroll
            for (int j = 0; j < 32; ++j) f[j] = f[j] - bf2f(f2bf(f[j]));
        }
        if (ks0) {
            const float* kp = (k32 * 32 < 512) ? ks0 + k32 * 32 : ks1 + k32 * 32 - 512;
#pragma unroll
            for (int j = 0; j < 32; ++j) f[j] *= kp[j];
        }
        bf16_t* dp = dst + bi * dbatch + (long)rm(n) * ldd + k32 * 32;
#pragma unroll
        for (int q = 0; q < 4; ++q) {
            u32x4 o; o.x = pk2(f[8 * q], f[8 * q + 1]); o.y = pk2(f[8 * q + 2], f[8 * q + 3]); o.z = pk2(f[8 * q + 4], f[8 * q + 5]); o.w = pk2(f[8 * q + 6], f[8 * q + 7]);
            *(u32x4*)(dp + 8 * q) = o;
        }
    }
}
struct RowId { DI int operator()(int n) const { return n; } };
struct RowGU { int tn; DI int operator()(int n) const { return (n >> 6) * 128 + ((n >> 5) & 1) * 64 + tn * 32 + (n & 31); } };
struct RowOff { int off; DI int operator()(int n) const { return n + off; } };

DI void cpow(float lr, float li, float step, int tau, float& re, float& im) {
    const float mag = expf(lr * step * (float)tau);
    const double ang = (double)li * (double)step * (double)tau;
    const double k = rint(ang * 0.15915494309189535);
    const float red = (float)(ang - k * 6.283185307179586);
    float sn, cs; sn = sinf(red); cs = cosf(red);
    re = mag * cs; im = mag * sn;
}
DI void phase0(const Params& P, unsigned char* lds_raw, int tid, int xmode = 0) {
    unsigned char* ws = P.ws;
    const int lane = tid & 63, wv = tid >> 6;
    const int G = gridDim.x, bid = blockIdx.x;
    if (xmode == 0 || xmode == 1) {
        const float* x = P.in[0]; const float* g1 = P.in[1];
        bf16_t* xn = (bf16_t*)(ws + OFF_XN);
        for (int row0 = (bid * 8 + wv) * 2; row0 < T; row0 += G * 16) {
            f32x4 v[2][4]; float s0 = 0.f, s1 = 0.f;
#pragma unroll
            for (int q = 0; q < 2; ++q) {
                const f32x4* xr = (const f32x4*)(x + (size_t)(row0 + q) * 1024) + lane;
#pragma unroll
                for (int j = 0; j < 4; ++j) v[q][j] = xr[64 * j];
            }
#pragma unroll
            for (int j = 0; j < 4; ++j) {
                s0 += v[0][j].x * v[0][j].x + v[0][j].y * v[0][j].y + v[0][j].z * v[0][j].z + v[0][j].w * v[0][j].w;
                s1 += v[1][j].x * v[1][j].x + v[1][j].y * v[1][j].y + v[1][j].z * v[1][j].z + v[1][j].w * v[1][j].w;
            }
            s0 = wave_sum(s0); s1 = wave_sum(s1);
            const float rs0 = rsqrtf(s0 * (1.f / 1024.f) + EPS), rs1 = rsqrtf(s1 * (1.f / 1024.f) + EPS);
#pragma unroll
            for (int j = 0; j < 4; ++j) {
                const f32x4 g = ((const f32x4*)g1)[lane + 64 * j];
                u32x2 o; o.x = pk2(v[0][j].x * rs0 * g.x, v[0][j].y * rs0 * g.y); o.y = pk2(v[0][j].z * rs0 * g.z, v[0][j].w * rs0 * g.w);
                *(u32x2*)(xn + (size_t)row0 * 1024 + lane * 4 + 256 * j) = o;
                o.x = pk2(v[1][j].x * rs1 * g.x, v[1][j].y * rs1 * g.y); o.y = pk2(v[1][j].z * rs1 * g.z, v[1][j].w * rs1 * g.w);
                *(u32x2*)(xn + (size_t)(row0 + 1) * 1024 + lane * 4 + 256 * j) = o;
            }
        }
    }
    if (xmode == 0 || xmode == 2) {
        const float* lam_re = P.in[3]; const float* lam_im = P.in[4]; const float* log_step = P.in[5];
        const float* b_re = P.in[6]; const float* b_im = P.in[7]; const float* c_re = P.in[8]; const float* c_im = P.in[9];
        float* pw_re = (float*)lds_raw;
        float* pw_im = pw_re + 64 * 33;
        float* bb_re = pw_im + 64 * 33;
        float* bb_im = bb_re + 1024;
        float* cc_re = bb_im + 1024;
        float* cc_im = cc_re + 64;
        float* Km = cc_im + 64;
        bf16_t* TgT = (bf16_t*)(ws + OFF_TGT); bf16_t* EgT = (bf16_t*)(ws + OFF_EGT); bf16_t* FgT = (bf16_t*)(ws + OFF_FGT);
        float* lam32 = (float*)(ws + OFF_LAM32);
        for (int u = bid; u < 512; u += G) {
            const int g = u >> 4, h = u & 15;
            const float step = expf(log_step[g]);
            __syncthreads();
            if (tid < 64) {
                const int p = tid;
                float ar, ai; cpow(lam_re[g * 64 + p], lam_im[g * 64 + p], step, 1, ar, ai);
                float zr = 1.f, zi = 0.f;
                for (int tau = 0; tau <= 32; ++tau) {
                    pw_re[p * 33 + tau] = zr; pw_im[p * 33 + tau] = zi;
                    const float nr = zr * ar - zi * ai, ni = zr * ai + zi * ar; zr = nr; zi = ni;
                }
                cc_re[tid] = c_re[(g * 16 + h) * 64 + tid]; cc_im[tid] = c_im[(g * 16 + h) * 64 + tid];
            }
            __syncthreads();
            for (int idx = tid; idx < 1024; idx += NTHREADS) {
                const int p = idx >> 4, hp = idx & 15;
                const float lr = lam_re[g * 64 + p], li = lam_im[g * 64 + p];
                const float re = pw_re[p * 33 + 1], im = pw_im[p * 33 + 1];
                const float nr = re - 1.f, ni = im, den = lr * lr + li * li;
                const float qr = (nr * lr + ni * li) / den, qi = (ni * lr - nr * li) / den;
                const float br = b_re[(g * 64 + p) * 16 + hp], bi = b_im[(g * 64 + p) * 16 + hp];
                bb_re[idx] = qr * br - qi * bi; bb_im[idx] = qr * bi + qi * br;
            }
            __syncthreads();
            {
                const int tau = tid >> 4, hp = tid & 15;
                float s = 0.f;
                for (int p = 0; p < 64; ++p) {
                    const float zr = cc_re[p] * pw_re[p * 33 + tau] - cc_im[p] * pw_im[p * 33 + tau];
                    const float zi = cc_re[p] * pw_im[p * 33 + tau] + cc_im[p] * pw_re[p * 33 + tau];
                    s += zr * bb_re[p * 16 + hp] - zi * bb_im[p * 16 + hp];
                }
                Km[tid] = s;
            }
            __syncthreads();
            for (int it = tid; it < 2048; it += NTHREADS) {
                const int t = it >> 6, q = it & 63, k = q >> 1, hp0 = (q & 1) * 8;
                u32x4 o = {0u, 0u, 0u, 0u};
                if (t >= k) { const float* km = Km + (t - k) * 16 + hp0; o.x = pk2(km[0], km[1]); o.y = pk2(km[2], km[3]); o.z = pk2(km[4], km[5]); o.w = pk2(km[6], km[7]); }
                *(u32x4*)(TgT + ((size_t)g * 512 + t * 16 + h) * 512 + q * 8) = o;
            }
            {
                const int t = tid >> 4, c = tid & 15;
                float f[8];
#pragma unroll
                for (int j = 0; j < 4; ++j) {
                    const int p = 4 * c + j;
                    const float zr = cc_re[p] * pw_re[p * 33 + t + 1] - cc_im[p] * pw_im[p * 33 + t + 1];
                    const float zi = cc_re[p] * pw_im[p * 33 + t + 1] + cc_im[p] * pw_re[p * 33 + t + 1];
                    f[2 * j] = zr; f[2 * j + 1] = -zi;
                }
                u32x4 o; o.x = pk2(f[0], f[1]); o.y = pk2(f[2], f[3]); o.z = pk2(f[4], f[5]); o.w = pk2(f[6], f[7]);
                *(u32x4*)(FgT + ((size_t)g * 512 + t * 16 + h) * 128 + c * 8) = o;
            }
            {
                const int nl = tid >> 6, q = tid & 63, p = 4 * h + (nl >> 1), ri = nl & 1, k = q >> 1, hp0 = (q & 1) * 8;
                const float ar = pw_re[p * 33 + 31 - k], ai = pw_im[p * 33 + 31 - k];
                float f[8];
#pragma unroll
                for (int j = 0; j < 8; ++j) {
                    const float br = bb_re[p * 16 + hp0 + j], bi = bb_im[p * 16 + hp0 + j];
                    f[j] = ri ? (ar * bi + ai * br) : (ar * br - ai * bi);
                }
                u32x4 o; o.x = pk2(f[0], f[1]); o.y = pk2(f[2], f[3]); o.z = pk2(f[4], f[5]); o.w = pk2(f[6], f[7]);
                *(u32x4*)(EgT + ((size_t)g * 128 + 2 * p + ri) * 512 + q * 8) = o;
            }
            if (h == 0 && tid < 64) { lam32[(g * 64 + tid) * 2] = pw_re[tid * 33 + 32]; lam32[(g * 64 + tid) * 2 + 1] = pw_im[tid * 33 + 32]; }
        }
        __syncthreads();
    }
    if (xmode == 0 || xmode == 3) {
        float* red = (float*)lds_raw;
        float* biasp = (float*)(ws + OFF_BIASP);
        for (int u = bid; u < 32; u += G) {
            const int kv = u >> 4, part = u & 15;
            const float* pos = P.in[kv ? 18 : 17]; const float* w1 = P.in[kv ? 21 : 19];
            const int n = tid & 255, half = tid >> 8;
            float s = 0.f;
            const int k0 = part * 128 + half * 64;
            for (int kk = k0; kk < k0 + 64; ++kk) s += pos[kk] * w1[(size_t)kk * 256 + n];
            __syncthreads();
            red[tid] = s;
            __syncthreads();
            if (tid < 256) biasp[(kv * 16 + part) * 256 + tid] = red[tid] + red[tid + 256];
        }
        __syncthreads();
    }
    if (xmode == 0 || xmode == 4) {
        const long gt = (long)bid * NTHREADS + tid, gs = (long)G * NTHREADS;
        tconv(P.in[2], 0, 1816, 1024, 1816, (bf16_t*)(ws + OFF_WINT), 0, 1024, 1, RowId(), 0, gt, gs);
        tconv(P.in[11], 0, 512, 512, 512, (bf16_t*)(ws + OFF_WGLUT), 0, 512, 1, RowId(), 0, gt, gs);
        tconv(P.in[19], (long)1024 * 256, 256, 1024, 256, (bf16_t*)(ws + OFF_WC1T), (long)256 * 1024, 1024, 2, RowId(), 0, gt, gs);
        tconv(P.in[21], (long)1024 * 256, 256, 1024, 256, (bf16_t*)(ws + OFF_WC1T) + (size_t)2 * 256 * 1024, (long)256 * 1024, 1024, 2, RowId(), 0, gt, gs);
        tconv(P.in[25], 0, 1024, 1024, 1024, (bf16_t*)(ws + OFF_WOUTT), 0, 1024, 1, RowId(), 0, gt, gs, P.in[23], P.in[24]);
        { float* ssq = (float*)(ws + OFF_SSQ); for (long i = gt; i < (long)T * 2; i += gs) ssq[i] = 0.f; }
        tconv(P.in[27], 0, 4, 1024, 4, (bf16_t*)(ws + OFF_WRT), 0, 1024, 1, RowId(), 0, gt, gs);
        tconv(P.in[29], 0, 32, 1024, 32, (bf16_t*)(ws + OFF_WRT), 0, 1024, 1, RowOff{4}, 0, gt, gs);
        tconv(P.in[27], 0, 4, 1024, 4, (bf16_t*)(ws + OFF_WRT) + 40 * 1024, 0, 1024, 1, RowId(), 1, gt, gs);
        tconv(P.in[29], 0, 32, 1024, 32, (bf16_t*)(ws + OFF_WRT) + 40 * 1024, 0, 1024, 1, RowOff{4}, 1, gt, gs);
    }
}

DI void epi_inproj(const Params& P, const float* Ct, int m0, int nt, int tid) {
    unsigned char* ws = P.ws;
    const int n0 = nt * 128;
    if (n0 < 512) {
        bf16_t* U = (bf16_t*)(ws + OFF_U);
        for (int it = tid; it < 2048; it += NTHREADS) {
            const int row = it >> 3, gi = it & 7;
            const float* s = Ct + row * CT_STRIDE + gi * 16;
            u32x4 o0, o1;
            o0.x = pk2(s[0], s[1]); o0.y = pk2(s[2], s[3]); o0.z = pk2(s[4], s[5]); o0.w = pk2(s[6], s[7]);
            o1.x = pk2(s[8], s[9]); o1.y = pk2(s[10], s[11]); o1.z = pk2(s[12], s[13]); o1.w = pk2(s[14], s[15]);
            bf16_t* d = U + ((size_t)((n0 >> 4) + gi) * T + m0 + row) * 16;
            *(u32x4*)d = o0; *(u32x4*)(d + 8) = o1;
        }
    } else if (n0 < 1792) {
        const int row = tid & 255, seg = tid >> 8;
        const int grow = m0 + row, b = grow >> 12, l = grow & 4095;
        const float* s = Ct + row * CT_STRIDE + seg * 64;
        const int kind = n0 < 1024 ? 0 : 1 + ((n0 - 1024) >> 7);
        if (kind == 4 || kind == 6) {
            bf16_t* dst = (bf16_t*)(ws + (kind == 4 ? OFF_VST : OFF_VWT));
            const int rl = tid & 63, cq = tid >> 6;
#pragma unroll 1
            for (int rr = 0; rr < 4; ++rr) {
                const int r2 = rl + 64 * rr, gr = m0 + r2, b2 = gr >> 12, l2 = gr & 4095;
#pragma unroll
                for (int cc = 0; cc < 16; ++cc) {
                    const int col = cq * 16 + cc, g = col >> 6, d = col & 63;
                    dst[((size_t)((b2 * 2 + g) * 64 + d)) * 4096 + l2] = (bf16_t)f2bf(Ct[r2 * CT_STRIDE + col]);
                }
            }
        } else {
            float scale = 1.f; const float* gw = nullptr; bf16_t* dst;
            if (kind == 0) { gw = P.in[13]; dst = (bf16_t*)(ws + OFF_QN) + (size_t)grow * 512 + (n0 - 512) + seg * 64; scale = 0.125f * 1.4426950408889634f; }
            else {
                const size_t off = kind == 1 ? OFF_KC : kind == 2 ? OFF_VC : kind == 3 ? OFF_KSN : OFF_KWN;
                dst = (bf16_t*)(ws + off) + ((size_t)((b * 2 + seg) * 4096 + l)) * 64;
                if (kind == 3) gw = P.in[15]; else if (kind == 5) gw = P.in[16];
            }
            float rs = 1.f;
            if (gw) {
                float ss = 0.f;
#pragma unroll
                for (int c4 = 0; c4 < 16; ++c4) { const f32x4 v = *(const f32x4*)(s + c4 * 4); ss += v.x * v.x + v.y * v.y + v.z * v.z + v.w * v.w; }
                rs = rsqrtf(ss * (1.f / 64.f) + EPS) * scale;
            }
#pragma unroll
            for (int c8 = 0; c8 < 8; ++c8) {
                f32x4 v0 = *(const f32x4*)(s + c8 * 8), v1 = *(const f32x4*)(s + c8 * 8 + 4);
                if (gw) {
                    const f32x4 g0 = *(const f32x4*)(gw + c8 * 8), g1 = *(const f32x4*)(gw + c8 * 8 + 4);
                    v0 = v0 * g0 * rs; v1 = v1 * g1 * rs;
                }
                u32x4 o; o.x = pk2(v0.x, v0.y); o.y = pk2(v0.z, v0.w); o.z = pk2(v1.x, v1.y); o.w = pk2(v1.z, v1.w);
                *(u32x4*)(dst + c8 * 8) = o;
            }
        }
    } else {
        if (tid < 256) {
            float* gates = (float*)(ws + OFF_GATES) + (size_t)(m0 + tid) * 24;
            const float* s = Ct + tid * CT_STRIDE;
#pragma unroll
            for (int c = 0; c < 24; ++c) gates[c] = sigmoidf(s[c]);
        }
    }
}
DI void phase1(const Params& P, unsigned char* lds_raw, int tid, int xmode = 0) {
    bf16_t* lds = (bf16_t*)lds_raw; float* Ct = (float*)lds_raw;
    const bf16_t* xn = (const bf16_t*)(P.ws + OFF_XN);
    const bf16_t* WinT = (const bf16_t*)(P.ws + OFF_WINT);
    for (int u = vbid(); u < 64 * 8; u += gridDim.x) {
        const int mt = u >> 3, nt2 = u & 7, m0 = mt * 256;
        f32x16 acc[2][4]; zero_acc2(acc);
        const ASrc A = make_a(xn, 1024, nullptr, T, m0, tid);
        const BSrc2 bs = make_b2(WinT, 1024, DIN, nt2 * 256, tid);
        __syncthreads();
        if (xmode != 4) gemm_mainloop2(acc, A, bs, 1024, lds, tid);
#pragma unroll 1
        for (int half = 0; half < 2; ++half) {
            const int nt = nt2 * 2 + half;
            if (nt * 128 >= DIN) break;
            if (xmode == 5) { if (tid == 0 && acc[0][0][0] + acc[1][3][5] + acc[0][1][1] + acc[1][2][7] + acc[0][2][3] + acc[0][3][9] + acc[1][0][4] + acc[1][1][2] == 12345.f) ((float*)P.ws)[1] = 1.f; continue; }
            dump_acc2(acc, Ct, tid, half);
            __syncthreads();
            epi_inproj(P, Ct, m0, nt, tid);
            __syncthreads();
        }
    }
    __syncthreads();
}

DI void st_wt8(void* p, u32x2 v) { asm volatile("global_store_dwordx2 %0, %1, off sc1\n\ts_nop 1" :: "v"(p), "v"(v) : "memory"); }
DI void st_wt16f(void* p, f32x4 v) { asm volatile("global_store_dwordx4 %0, %1, off sc1\n\ts_nop 1" :: "v"(p), "v"(v) : "memory"); }
DI void unit_signal(unsigned* ctr, int tid) {
    asm volatile("s_waitcnt vmcnt(0)" ::: "memory");
    __syncthreads();
    if (tid == 0) __hip_atomic_fetch_add(ctr, 1u, __ATOMIC_RELAXED, __HIP_MEMORY_SCOPE_AGENT);
}
DI void unit_wait2(unsigned* ctr, unsigned target, unsigned* ctr2, unsigned target2, int tid) {
    if (tid == 0) {
        unsigned sp = 0;
        while (__hip_atomic_load(ctr, __ATOMIC_RELAXED, __HIP_MEMORY_SCOPE_AGENT) < target) { __builtin_amdgcn_s_sleep(4); if (++sp > (1u << 22)) break; }
        if (ctr2) { sp = 0; while (__hip_atomic_load(ctr2, __ATOMIC_RELAXED, __HIP_MEMORY_SCOPE_AGENT) < target2) { __builtin_amdgcn_s_sleep(4); if (++sp > (1u << 22)) break; } }
        __builtin_amdgcn_fence(__ATOMIC_ACQUIRE, "agent");
        asm volatile("s_waitcnt vmcnt(0)" ::: "memory");
    }
    __syncthreads();
}
DI void unit_wait(unsigned* ctr, unsigned target, int tid) {
    if (tid == 0) {
        unsigned sp = 0;
        while (__hip_atomic_load(ctr, __ATOMIC_RELAXED, __HIP_MEMORY_SCOPE_AGENT) < target) { __builtin_amdgcn_s_sleep(4); if (++sp > (1u << 22)) break; }
        __builtin_amdgcn_fence(__ATOMIC_ACQUIRE, "agent");
        asm volatile("s_waitcnt vmcnt(0)" ::: "memory");
    }
    __syncthreads();
}
DI void mlp2_unit(const Params& P, unsigned char* lds_raw, int u, int tid) {
    unsigned char* ws = P.ws;
    {
        unit_wait((unsigned*)(ws + OFF_CTL) + CW_PDONE + (u >> 3), 4u, tid);
            const int idx = u, rc = idx & 7, bg = (idx >> 3) & 7, kv = idx >> 6;
            float* Hs = (float*)lds_raw;
            const float* Pt = (const float*)(ws + OFF_P) + ((size_t)((kv * 8 + bg) * 2 + 0) * 256) * 256;
            const float* Pb = (const float*)(ws + OFF_P) + ((size_t)((kv * 8 + bg) * 2 + 1) * 256) * 256;
            const float* biasp = (const float*)(ws + OFF_BIASP) + kv * 16 * 256;
            const int n = tid & 255;
            float bias = 0.f;
#pragma unroll
            for (int pp = 0; pp < 16; ++pp) bias += biasp[pp * 256 + n];
            for (int it = tid; it < 8192; it += NTHREADS) {
                const int rr = it >> 8, j = rc * 32 + rr;
                float hv = 0.f;
                if (j < 255) hv = gelu_tanh(Pt[j * 256 + n] + Pb[(j + 1) * 256 + n] + bias);
                Hs[rr * 256 + n] = hv;
            }
            __syncthreads();
            const int rr = tid >> 4, dq = tid & 15, j = rc * 32 + rr;
            const float* w2 = P.in[kv ? 22 : 20];
            f32x4 a = {0.f, 0.f, 0.f, 0.f};
            for (int k = 0; k < 256; ++k) {
                const float hv = Hs[rr * 256 + k];
                const f32x4 w = *(const f32x4*)(w2 + k * 64 + dq * 4);
                a = a + w * hv;
            }
            if (kv == 0) {
                float ss = a.x * a.x + a.y * a.y + a.z * a.z + a.w * a.w;
                ss += __shfl_xor(ss, 1); ss += __shfl_xor(ss, 2); ss += __shfl_xor(ss, 4); ss += __shfl_xor(ss, 8);
                const float rs = rsqrtf(ss * (1.f / 64.f) + EPS);
                const f32x4 g = *(const f32x4*)(P.in[14] + dq * 4);
                u32x2 o; o.x = pk2(a.x * rs * g.x, a.y * rs * g.y); o.y = pk2(a.z * rs * g.z, a.w * rs * g.w);
                if (j == 255) { o.x = 0u; o.y = 0u; }
                *(u32x2*)((bf16_t*)(ws + OFF_KCMP) + ((size_t)bg * 256 + j) * 64 + dq * 4) = o;
            } else {
                bf16_t* vt = (bf16_t*)(ws + OFF_VCMPT) + (size_t)bg * 64 * 256;
                if (j == 255) a = (f32x4){0.f, 0.f, 0.f, 0.f};
                vt[(dq * 4 + 0) * 256 + j] = (bf16_t)f2bf(a.x); vt[(dq * 4 + 1) * 256 + j] = (bf16_t)f2bf(a.y);
                vt[(dq * 4 + 2) * 256 + j] = (bf16_t)f2bf(a.z); vt[(dq * 4 + 3) * 256 + j] = (bf16_t)f2bf(a.w);
            }
    }
    __syncthreads();
}
DI void phase2(const Params& P, unsigned char* lds_raw, int tid) {
    bf16_t* lds = (bf16_t*)lds_raw; float* Ct = (float*)lds_raw;
    unsigned char* ws = P.ws;
    {
        const int G = gridDim.x, nh = G > 128 ? G - 128 : G, hid = G > 128 ? vbid() - 128 : vbid();
        if (hid >= 0) {
            const long gt = (long)hid * NTHREADS + tid, gs = (long)nh * NTHREADS;
            tconv(P.in[31], (long)1024 * 256, 256, 1024, 256, (bf16_t*)(ws + OFF_WGUT), (long)512 * 1024, 1024, 32, RowGU{0}, 0, gt, gs);
            tconv(P.in[32], (long)1024 * 256, 256, 1024, 256, (bf16_t*)(ws + OFF_WGUT), (long)512 * 1024, 1024, 32, RowGU{1}, 0, gt, gs);
            tconv(P.in[33], (long)256 * 1024, 1024, 256, 1024, (bf16_t*)(ws + OFF_WDT), (long)1024 * 256, 256, 32, RowId(), 0, gt, gs);
        }
    }
    for (int u = vbid(); u < 128; u += gridDim.x) {
        f32x16 acc[2][2]; zero_acc(acc);
        if (u < 64) {
            const int g = u >> 1, mt = u & 1, m0 = mt * 256;
            const bf16_t* A = (const bf16_t*)(ws + OFF_U) + (size_t)g * T * 16;
            const ASrc As = make_a(A, 512, nullptr, 512, m0, tid);
            const BSrcBf bs = make_bbf((const bf16_t*)(ws + OFF_EGT) + (size_t)g * 128 * 512, 512, 128, 0, tid);
            __syncthreads();
            gemm_mainloop(acc, As, bs, 512, lds, tid);
            dump_acc(acc, Ct, tid);
            __syncthreads();
            if (tid < 128) {
                const int bb = tid >> 6, p = tid & 63;
                const float* lam32 = (const float*)(ws + OFF_LAM32) + (g * 64 + p) * 2;
                const float ar = lam32[0], ai = lam32[1];
                float sr = 0.f, si = 0.f;
                float* zp = Ct + (bb * 128) * CT_STRIDE + 2 * p;
                for (int c = 0; c < 128; ++c) {
                    const float zr = zp[c * CT_STRIDE], zi = zp[c * CT_STRIDE + 1];
                    zp[c * CT_STRIDE] = sr; zp[c * CT_STRIDE + 1] = si;
                    const float nr = ar * sr - ai * si + zr, ni = ar * si + ai * sr + zi;
                    sr = nr; si = ni;
                }
            }
            __syncthreads();
            bf16_t* Sin = (bf16_t*)(ws + OFF_SIN) + ((size_t)g * 512 + m0) * 128;
            for (int it = tid; it < 256 * 16; it += NTHREADS) {
                const int row = it >> 4, c8 = it & 15;
                const float* sp = Ct + row * CT_STRIDE + c8 * 8;
                u32x4 o; o.x = pk2(sp[0], sp[1]); o.y = pk2(sp[2], sp[3]); o.z = pk2(sp[4], sp[5]); o.w = pk2(sp[6], sp[7]);
                *(u32x4*)(Sin + row * 128 + c8 * 8) = o;
            }
        } else {
            const int idx = u - 64, nt = idx & 1, part = (idx >> 1) & 1, bg = (idx >> 2) & 7, kv = idx >> 5;
            const bf16_t* A = (const bf16_t*)(ws + (kv ? OFF_VC : OFF_KC)) + (size_t)bg * 4096 * 64;
            const ASrc As = make_a(A, 1024, nullptr, 256, 0, tid);
            const BSrcBf bs = make_bbf((const bf16_t*)(ws + OFF_WC1T) + (size_t)(kv * 2 + part) * 256 * 1024, 1024, 256, nt * 128, tid);
            __syncthreads();
            gemm_mainloop(acc, As, bs, 1024, lds, tid);
            dump_acc(acc, Ct, tid);
            __syncthreads();
            float* Pp = (float*)(ws + OFF_P) + ((size_t)((kv * 8 + bg) * 2 + part) * 256) * 256 + nt * 128;
            for (int it = tid; it < 256 * 32; it += NTHREADS) {
                const int row = it >> 5, c4 = it & 31;
                st_wt16f(Pp + row * 256 + c4 * 4, *(const f32x4*)(Ct + row * CT_STRIDE + c4 * 4));
            }
            unit_signal((unsigned*)(ws + OFF_CTL) + CW_PDONE + kv * 8 + bg, tid);
        }
    }
    for (int u = vbid(); u < 128; u += gridDim.x) mlp2_unit(P, lds_raw, u, tid);
    __syncthreads();
}

DI void s5_main_unit(const Params& P, unsigned char* lds_raw, int u, int tid) {
    bf16_t* lds = (bf16_t*)lds_raw; float* Ct = (float*)lds_raw;
    unsigned char* ws = P.ws;
    const int nt = u & 3, mt = (u >> 2) & 1, g = u >> 3, m0 = mt * 256, n0 = nt * 128;
    f32x16 acc[2][2]; zero_acc(acc);
    const bf16_t* Ug = (const bf16_t*)(ws + OFF_U) + (size_t)g * T * 16;
    {
        const ASrc As = make_a(Ug, 512, nullptr, 512, m0, tid);
        const BSrcBf bs = make_bbf((const bf16_t*)(ws + OFF_TGT) + (size_t)g * 512 * 512, 512, 512, n0, tid);
        __syncthreads();
        gemm_mainloop(acc, As, bs, 512, lds, tid);
    }
    {
        const bf16_t* S = (const bf16_t*)(ws + OFF_SIN) + (size_t)g * 512 * 128;
        const ASrc As = make_a(S, 128, nullptr, 512, m0, tid);
        const BSrcBf bs = make_bbf((const bf16_t*)(ws + OFF_FGT) + (size_t)g * 512 * 128, 128, 512, n0, tid);
        gemm_mainloop(acc, As, bs, 128, lds, tid);
    }
    dump_acc(acc, Ct, tid);
    __syncthreads();
    const float* dsk = P.in[10] + g * 16;
    bf16_t* y1 = (bf16_t*)(ws + OFF_Y1);
    for (int it = tid; it < 2048; it += NTHREADS) {
        const int row = it >> 3, tt = it & 7;
        const int token = 32 * (m0 + row) + (n0 >> 4) + tt;
        const float* s = Ct + row * CT_STRIDE + tt * 16;
        const u32x4 u0 = *(const u32x4*)(Ug + (size_t)token * 16), u1 = *(const u32x4*)(Ug + (size_t)token * 16 + 8);
        const unsigned uw[8] = {u0.x, u0.y, u0.z, u0.w, u1.x, u1.y, u1.z, u1.w};
        unsigned ow[8];
#pragma unroll
        for (int q = 0; q < 8; ++q) {
            const float ua = bf2f(uw[q] & 0xffffu), ub = bf2f(uw[q] >> 16);
            const float ya = gelu_tanh(s[2 * q] + dsk[2 * q] * ua), yb = gelu_tanh(s[2 * q + 1] + dsk[2 * q + 1] * ub);
            ow[q] = pk2(ya, yb);
        }
        bf16_t* d = y1 + (size_t)token * 512 + g * 16;
        *(u32x4*)d = (u32x4){ow[0], ow[1], ow[2], ow[3]}; *(u32x4*)(d + 8) = (u32x4){ow[4], ow[5], ow[6], ow[7]};
    }
}

constexpr int KSTR = 72, VSTR = 68;
constexpr int KSLOT = 64 * KSTR, VSLOT = 64 * VSTR;
constexpr int AT_KBUF = 0;
constexpr int AT_VBUF = AT_KBUF + 3 * KSLOT * 2;
constexpr int VCSTR = 260;
constexpr int AT_CK   = 0;
constexpr int AT_CV   = AT_CK + 256 * KSTR * 2;
constexpr int AT_RING_END = AT_VBUF + 3 * VSLOT * 2;
constexpr int AT_CEND = AT_CV + 64 * VCSTR * 2;
constexpr int AT_IMP  = (AT_CEND > AT_RING_END ? AT_CEND : AT_RING_END);
constexpr int AT_MASK = AT_IMP + 4 * 64 * 64 * 4;
constexpr int AT_INVL = AT_MASK + 64 * 8;
constexpr int AT_END  = AT_INVL + 256 * 4;

struct KVRegs { u32x4 k; u32x4 v; };
DI void kv_load(KVRegs& r, const bf16_t* Kt, const bf16_t* Vt, long ldv, int tid) {
    r.k = *(const u32x4*)(Kt + (tid >> 3) * 64 + (tid & 7) * 8);
    r.v = *(const u32x4*)(Vt + (long)(tid >> 3) * ldv + (tid & 7) * 8);
}
DI void kv_store(const KVRegs& r, bf16_t* Kb, bf16_t* Vb, int tid) {
    *(u32x4*)(Kb + (tid >> 3) * KSTR + (tid & 7) * 8) = r.k;
    u32x2 lo, hi; lo.x = r.v.x; lo.y = r.v.y; hi.x = r.v.z; hi.y = r.v.w;
    *(u32x2*)(Vb + (tid >> 3) * VSTR + (tid & 7) * 8) = lo;
    *(u32x2*)(Vb + (tid >> 3) * VSTR + (tid & 7) * 8 + 4) = hi;
}
DI bf16x8 pack8(const f32x16& x, int s) {
    u32x4 p;
    p.x = pk2(x[8 * s], x[8 * s + 1]); p.y = pk2(x[8 * s + 2], x[8 * s + 3]); p.z = pk2(x[8 * s + 4], x[8 * s + 5]); p.w = pk2(x[8 * s + 6], x[8 * s + 7]);
    return __builtin_bit_cast(bf16x8, p);
}
DI void qk_tile(f32x16 (&S)[2], const bf16_t* Kb, const bf16x8 (&qf)[4], int r, int h, bool edge, int d0, int dmax, int pm) {
    const int NEGB = __builtin_bit_cast(int, -1e30f);
    if (edge) {
#pragma unroll
        for (int kh = 0; kh < 2; ++kh)
#pragma unroll
            for (int i = 0; i < 16; ++i) {
                const int d = d0 - (32 * kh + (i & 3) + 8 * (i >> 2));
                const int m = (d >> 31) | ((dmax - d) >> 31) | pm;
                S[kh][i] = __builtin_bit_cast(float, m & NEGB);
            }
    } else {
        const float iv = __builtin_bit_cast(float, pm & NEGB);
#pragma unroll
        for (int kh = 0; kh < 2; ++kh)
#pragma unroll
            for (int i = 0; i < 16; ++i) S[kh][i] = iv;
    }
    bf16x8 kf[2][4];
#pragma unroll
    for (int kh = 0; kh < 2; ++kh)
#pragma unroll
        for (int s = 0; s < 4; ++s) kf[kh][s] = *(const bf16x8*)(Kb + (32 * kh + r) * KSTR + 16 * s + 8 * h);
    asm volatile("" ::: "memory");
#pragma unroll
    for (int s = 0; s < 4; ++s)
#pragma unroll
        for (int kh = 0; kh < 2; ++kh) S[kh] = MFMA32(kf[kh][s], qf[s], S[kh]);
}
#ifndef AT_X
#define AT_X 0
#endif
DI void softmax_tile(f32x16 (&S)[2], float& lsum, int ax = 0) {
    float ls = 0.f;
#pragma unroll
    for (int kh = 0; kh < 2; ++kh)
#pragma unroll
        for (int i = 0; i < 16; ++i) { const float p = (ax == 1) ? S[kh][i] * 0.001f : __builtin_amdgcn_exp2f(S[kh][i]); S[kh][i] = p; ls += p; }
    lsum += ls;
}
DI void pv_tile(f32x16 (&O)[2], const f32x16 (&Pm)[2], const bf16_t* Vb, int r, int h) {
    bf16x8 vf[2][2][2];
#pragma unroll
    for (int kh = 0; kh < 2; ++kh)
#pragma unroll
        for (int sp = 0; sp < 2; ++sp)
#pragma unroll
            for (int dh = 0; dh < 2; ++dh) {
                const bf16_t* vp = Vb + (32 * dh + r) * VSTR + 32 * kh + 16 * sp + 4 * h;
                const s16x4 lo = *(const s16x4*)vp, hi = *(const s16x4*)(vp + 8);
                vf[kh][sp][dh] = __builtin_shufflevector(lo, hi, 0, 1, 2, 3, 4, 5, 6, 7);
            }
    asm volatile("" ::: "memory");
#pragma unroll
    for (int kh = 0; kh < 2; ++kh)
#pragma unroll
        for (int sp = 0; sp < 2; ++sp) {
            const bf16x8 pf = pack8(Pm[kh], sp);
#pragma unroll
            for (int dh = 0; dh < 2; ++dh) O[dh] = MFMA32(vf[kh][sp][dh], pf, O[dh]);
        }
}
DI void pv_tile_c(f32x16 (&O)[2], const f32x16 (&Pm)[2], const bf16_t* Vc, int kt, int r, int h) {
    bf16x8 vf[2][2][2];
#pragma unroll
    for (int kh = 0; kh < 2; ++kh)
#pragma unroll
        for (int sp = 0; sp < 2; ++sp)
#pragma unroll
            for (int dh = 0; dh < 2; ++dh) {
                const bf16_t* vp = Vc + (32 * dh + r) * VCSTR + 64 * kt + 32 * kh + 16 * sp + 4 * h;
                const s16x4 lo = *(const s16x4*)vp, hi = *(const s16x4*)(vp + 8);
                vf[kh][sp][dh] = __builtin_shufflevector(lo, hi, 0, 1, 2, 3, 4, 5, 6, 7);
            }
    asm volatile("" ::: "memory");
#pragma unroll
    for (int kh = 0; kh < 2; ++kh)
#pragma unroll
        for (int sp = 0; sp < 2; ++sp) {
            const bf16x8 pf = pack8(Pm[kh], sp);
#pragma unroll
            for (int dh = 0; dh < 2; ++dh) O[dh] = MFMA32(vf[kh][sp][dh], pf, O[dh]);
        }
}
struct SeqBits { unsigned long long rem; DI int pop() { if (rem == 0ull) return -1; const int k = __builtin_ctzll(rem); rem &= rem - 1; return k; } };
struct SeqDown { int cur, lo; DI int pop() { if (cur < lo) return -1; return cur--; } };
template <int BR, class Seq>
DI void attn_stream(f32x16 (&O)[2], float& lsum, Seq seq, const bf16_t* Kg, const bf16_t* Vg, bf16_t* Kbuf, bf16_t* Vbuf,
                    const bf16x8 (&qf)[4], int qt, int tq, unsigned long long mymask, int r, int h, int tid, int ax = 0) {
#define AT_QK(SREG, T, SLOT) do { const int _t = (T); const bool _edge = (_t == qt) || (BR == 2 && _t == qt - 8); \
        const int _pm = (BR == 1) ? ((int)((mymask >> _t) & 1ull) - 1) : 0; int _d0 = tq - 64 * _t - 4 * h; asm volatile("" : "+v"(_d0)); \
        qk_tile(SREG, Kbuf + (SLOT) * KSLOT, qf, r, h, _edge, _d0, BR == 2 ? 511 : 0x3fffffff, _pm); } while (0)
    int t0 = seq.pop(), t1 = seq.pop(), t2 = seq.pop();
    KVRegs R0;
    kv_load(R0, Kg + (size_t)t0 * 64 * 64, Vg + t0 * 64, 4096, tid); kv_store(R0, Kbuf, Vbuf, tid);
    if (t1 >= 0) { kv_load(R0, Kg + (size_t)t1 * 64 * 64, Vg + t1 * 64, 4096, tid); kv_store(R0, Kbuf + KSLOT, Vbuf + VSLOT, tid); }
    __syncthreads();
    f32x16 Sc[2], Sn[2];
    AT_QK(Sc, t0, 0);
    int sl = 0;
    while (true) {
        const int s1 = sl == 2 ? 0 : sl + 1, s2 = s1 == 2 ? 0 : s1 + 1;
        if (t2 >= 0 && ax != 3 && ax < 7) kv_load(R0, Kg + (size_t)t2 * 64 * 64, Vg + t2 * 64, 4096, tid);
        if (ax == 7) { lsum += (float)t0; }
        else if (ax == 8) { if (t1 >= 0) AT_QK(Sn, t1, s1); lsum += Sn[0][0] + Sn[1][5]; }
        else if (ax == 9) { softmax_tile(Sc, lsum, 0); pv_tile(O, Sc, Vbuf + sl * VSLOT, r, h); Sn[0] = Sc[0]; Sn[1] = Sc[1]; }
        else {
        if (t1 >= 0) AT_QK(Sn, t1, s1);
        softmax_tile(Sc, lsum, ax);
        if (ax != 2) pv_tile(O, Sc, Vbuf + sl * VSLOT, r, h);
        else { O[0][0] += Sc[0][3] + Sc[1][7]; }
        }
        if (t2 >= 0 && ax < 7) kv_store(R0, Kbuf + s2 * KSLOT, Vbuf + s2 * VSLOT, tid);
        if (ax != 5 && ax < 7) __syncthreads();
        if (t1 < 0) break;
#pragma unroll
        for (int kh = 0; kh < 2; ++kh) Sc[kh] = Sn[kh];
        t0 = t1; t1 = t2; t2 = seq.pop(); sl = s1;
    }
#undef AT_QK
}

DI void attn_unit(const Params& P, unsigned char* lds_raw, int a, int tid, bool dry = false, int ax = 0) {
    unsigned char* ws = P.ws;
    const int qt = 63 - (a >> 3), bg = a & 7, b = bg >> 1, g = bg & 1;
    const int lane = tid & 63, w = tid >> 6, r = lane & 31, h = lane >> 5;
    const int hh = w >> 1, th = w & 1;
    const int t0 = qt * 64;
    const int tql = 32 * th + r;
    const int tq = t0 + tql;
    const size_t tqg = (size_t)b * 4096 + tq;
    bf16_t* Kbuf = (bf16_t*)(lds_raw + AT_KBUF);
    bf16_t* Vbuf = (bf16_t*)(lds_raw + AT_VBUF);
    float* imp = (float*)(lds_raw + AT_IMP);
    unsigned long long* selm = (unsigned long long*)(lds_raw + AT_MASK);
    float* invl = (float*)(lds_raw + AT_INVL);

    bf16x8 qf[4];
    {
        const bf16_t* qp = (const bf16_t*)(ws + OFF_QN) + tqg * 512 + g * 256 + hh * 64 + 8 * h;
#pragma unroll
        for (int s = 0; s < 4; ++s) qf[s] = *(const bf16x8*)(qp + 16 * s);
    }
    const float* gp = (const float*)(ws + OFF_GATES) + tqg * 24 + g * 12 + hh * 3;
    const float gate_c = gp[0], gate_s = gp[1], gate_w = gp[2];

    __syncthreads();
    float* impw = imp + ((hh * 64 + 32 * th) * 64);
    for (int i = lane; i < 32 * 64; i += 64) impw[i] = 0.f;

    const bf16_t* Kc = (const bf16_t*)(ws + OFF_KCMP) + (size_t)bg * 256 * 64;
    const bf16_t* Vc = (const bf16_t*)(ws + OFF_VCMPT) + (size_t)bg * 64 * 256;
    int ncmp = (4 * qt + 2) / 64 + 1; if (ncmp > 4) ncmp = 4;
    f32x16 O[2];
#pragma unroll
    for (int dh = 0; dh < 2; ++dh)
#pragma unroll
        for (int i = 0; i < 16; ++i) O[dh][i] = 0.f;
    float inv_c;
    {
        float lsum = 0.f;
        bf16_t* Kcl = (bf16_t*)(lds_raw + AT_CK); bf16_t* Vcl = (bf16_t*)(lds_raw + AT_CV);
        {
            u32x4 kq[4], vq[4];
#pragma unroll
            for (int i = 0; i < 4; ++i) if (i < ncmp) {
                kq[i] = *(const u32x4*)(Kc + (size_t)(64 * i + (tid >> 3)) * 64 + (tid & 7) * 8);
                vq[i] = *(const u32x4*)(Vc + (size_t)(tid >> 3) * 256 + 64 * i + (tid & 7) * 8);
            }
#pragma unroll
            for (int i = 0; i < 4; ++i) if (i < ncmp) {
                *(u32x4*)(Kcl + (64 * i + (tid >> 3)) * KSTR + (tid & 7) * 8) = kq[i];
                bf16_t* vd = Vcl + (tid >> 3) * VCSTR + 64 * i + (tid & 7) * 8;
                u32x2 t; t.x = vq[i].x; t.y = vq[i].y; *(u32x2*)vd = t; t.x = vq[i].z; t.y = vq[i].w; *(u32x2*)(vd + 4) = t;
            }
        }
        __syncthreads();
        int jmax = tq >= 31 ? ((tq - 31) >> 4) : -1; jmax = jmax < 254 ? jmax : 254;
        for (int kt = 0; kt < ncmp; ++kt) {
            f32x16 S[2];
            qk_tile(S, Kcl + kt * 64 * KSTR, qf, r, h, true, jmax - 64 * kt - 4 * h, 0x3fffffff, 0);
            softmax_tile(S, lsum);
            float* ir = impw + r * 64 + 16 * kt + h;
#pragma unroll
            for (int kh = 0; kh < 2; ++kh)
#pragma unroll
                for (int gq = 0; gq < 4; ++gq)
                    ir[8 * kh + 2 * gq] += (S[kh][4 * gq] + S[kh][4 * gq + 1]) + (S[kh][4 * gq + 2] + S[kh][4 * gq + 3]);
            asm volatile("s_waitcnt lgkmcnt(0)" ::: "memory");
#pragma unroll
            for (int kh = 0; kh < 2; ++kh)
#pragma unroll
                for (int gq = 0; gq < 4; ++gq) {
                    const int sl = 8 * kh + 2 * gq + 1;
                    if (16 * kt + h + sl < 64) ir[sl] += S[kh][4 * gq + 3];
                }
            asm volatile("s_waitcnt lgkmcnt(0)" ::: "memory");
            pv_tile_c(O, S, Vcl, kt, r, h);
        }
        lsum += __shfl_xor(lsum, 32);
        inv_c = lsum > 0.f ? 1.f / lsum : 0.f;
        if (h == 0) invl[hh * 64 + tql] = inv_c;
    }
    __syncthreads();
    {
        const int cur = qt;
#pragma unroll 1
        for (int i = 0; i < 8; ++i) {
            const int tl = w * 8 + i;
            const float v = (imp[(0 * 64 + tl) * 64 + lane] * invl[tl] + imp[(1 * 64 + tl) * 64 + lane] * invl[64 + tl]) + (imp[(2 * 64 + tl) * 64 + lane] * invl[128 + tl] + imp[(3 * 64 + tl) * 64 + lane] * invl[192 + tl]);
            const bool forced = (lane == 0) || (lane == cur) || (lane == cur - 1);
            const bool valid = lane <= cur;
            const unsigned key = forced ? 0xFFFFFFFFu : (valid ? __builtin_bit_cast(unsigned, v) : 0u);
            unsigned thr = 0u;
#pragma unroll 1
            for (int bit = 31; bit >= 0; --bit) {
                const unsigned cand = thr | (1u << bit);
                if (__popcll(__ballot(key >= cand)) >= 16) thr = cand;
            }
            const unsigned long long gtm = __ballot(key > thr), eqm = __ballot(key == thr);
            const int need = 16 - __popcll(gtm);
            const bool sel = (key > thr) || ((key == thr) && (__popcll(eqm & ((1ull << lane) - 1ull)) < need));
            const unsigned long long mask = __ballot(sel);
            if (lane == 0) selm[tl] = mask;
        }
    }
    __syncthreads();
    float* accw = imp + (w * 32) * 64 + lane;
    {
        const float g_cmp = gate_c * inv_c;
#pragma unroll
        for (int dh = 0; dh < 2; ++dh)
#pragma unroll
            for (int i = 0; i < 16; ++i) accw[(dh * 16 + i) * 64] = g_cmp * O[dh][i];
    }
    const unsigned long long mymask = selm[tql];
    unsigned long long ormask = selm[lane];
#pragma unroll
    for (int o = 1; o < 64; o <<= 1) ormask |= __shfl_xor(ormask, o);
    ormask &= (qt >= 63) ? ~0ull : ((1ull << (qt + 1)) - 1ull);
    ormask |= 1ull;
    {
        const bf16_t* Ks = (const bf16_t*)(ws + OFF_KSN) + (size_t)bg * 4096 * 64;
        const bf16_t* Vs = (const bf16_t*)(ws + OFF_VST) + (size_t)bg * 64 * 4096;
#pragma unroll
        for (int dh = 0; dh < 2; ++dh)
#pragma unroll
            for (int i = 0; i < 16; ++i) O[dh][i] = 0.f;
        float l = 0.f;
        if (ax != 4) attn_stream<1>(O, l, SeqBits{ormask}, Ks, Vs, Kbuf, Vbuf, qf, qt, tq, mymask, r, h, tid, ax); else l = 1.f;
        l += __shfl_xor(l, 32);
        const float sc = gate_s / l;
#pragma unroll
        for (int dh = 0; dh < 2; ++dh)
#pragma unroll
            for (int i = 0; i < 16; ++i) accw[(dh * 16 + i) * 64] += sc * O[dh][i];
    }
    {
        const bf16_t* Kw = (const bf16_t*)(ws + OFF_KWN) + (size_t)bg * 4096 * 64;
        const bf16_t* Vw = (const bf16_t*)(ws + OFF_VWT) + (size_t)bg * 64 * 4096;
#pragma unroll
        for (int dh = 0; dh < 2; ++dh)
#pragma unroll
            for (int i = 0; i < 16; ++i) O[dh][i] = 0.f;
        float l = 0.f;
        if (ax != 4) attn_stream<2>(O, l, SeqDown{qt, qt >= 8 ? qt - 8 : 0}, Kw, Vw, Kbuf, Vbuf, qf, qt, tq, 0ull, r, h, tid, ax); else l = 1.f;
        l += __shfl_xor(l, 32);
        const float sc = gate_w / l;
        bf16_t* dst = (bf16_t*)(ws + OFF_XN) + tqg * 1024 + 512 + g * 256 + hh * 64;
        float sq = 0.f;
#pragma unroll
        for (int dh = 0; dh < 2; ++dh)
#pragma unroll
            for (int gq = 0; gq < 4; ++gq) {
                const float o0 = accw[(dh * 16 + 4 * gq + 0) * 64] + sc * O[dh][4 * gq + 0];
                const float o1 = accw[(dh * 16 + 4 * gq + 1) * 64] + sc * O[dh][4 * gq + 1];
                const float o2 = accw[(dh * 16 + 4 * gq + 2) * 64] + sc * O[dh][4 * gq + 2];
                const float o3 = accw[(dh * 16 + 4 * gq + 3) * 64] + sc * O[dh][4 * gq + 3];
                u32x2 o; o.x = pk2(o0, o1); o.y = pk2(o2, o3);
                if (ax == 0 || o.x == 0x12345678u) *(u32x2*)(dst + 32 * dh + 8 * gq + 4 * h) = o;
                sq += (o0 * o0 + o1 * o1) + (o2 * o2 + o3 * o3);
            }
        sq += __shfl_xor(sq, 32);
        if (h == 0 && !dry) __hip_atomic_fetch_add((float*)(ws + OFF_SSQ) + tqg * 2 + 1, sq, __ATOMIC_RELAXED, __HIP_MEMORY_SCOPE_AGENT);
    }
}
DI void phase4(const Params& P, unsigned char* lds_raw, int tid, int xmode = 0) {
    for (int b = blockIdx.x; b < 256; b += gridDim.x) {
        if (xmode == 2) break;
        attn_unit(P, lds_raw, b, tid, xmode != 0, xmode >= 10 ? xmode - 10 : 0);
        attn_unit(P, lds_raw, 504 - 8 * (b >> 3) + (b & 7), tid, xmode != 0, xmode >= 10 ? xmode - 10 : 0);
    }
    if (xmode != 1 && xmode < 10) for (int u = vbid(); u < 256; u += gridDim.x) s5_main_unit(P, lds_raw, u, tid);
    __syncthreads();
}

DI void phase5(const Params& P, unsigned char* lds_raw, int tid) {
    bf16_t* lds = (bf16_t*)lds_raw; float* Ct = (float*)lds_raw;
    unsigned char* ws = P.ws;
    const bf16_t* y1 = (const bf16_t*)(ws + OFF_Y1);
    for (int u = vbid(); u < 256; u += gridDim.x) {
        const int mt = u >> 2, nt = u & 3, m0 = mt * 256, n0 = nt * 128;
        f32x16 acc[2][2]; zero_acc(acc);
        const ASrc As = make_a(y1, 512, nullptr, T, m0, tid);
        const BSrcBf bs = make_bbf((const bf16_t*)(ws + OFF_WGLUT), 512, 512, n0, tid);
        __syncthreads();
        gemm_mainloop(acc, As, bs, 512, lds, tid);
        dump_acc(acc, Ct, tid);
        __syncthreads();
        const float* bglu = P.in[12];
        bf16_t* mix = (bf16_t*)(ws + OFF_XN);
        for (int it = tid; it < 256 * 32; it += NTHREADS) {
            const int row = it >> 5, c4 = it & 31, n = n0 + c4 * 4;
            const f32x4 v = *(const f32x4*)(Ct + row * CT_STRIDE + c4 * 4);
            const f32x4 bb = *(const f32x4*)(bglu + n);
            const u32x2 yy = *(const u32x2*)(y1 + (size_t)(m0 + row) * 512 + n);
            const float y0 = bf2f(yy.x & 0xffffu), y1v = bf2f(yy.x >> 16), y2 = bf2f(yy.y & 0xffffu), y3 = bf2f(yy.y >> 16);
            const float o0 = y0 * sigmoidf(v.x + bb.x), o1 = y1v * sigmoidf(v.y + bb.y), o2 = y2 * sigmoidf(v.z + bb.z), o3 = y3 * sigmoidf(v.w + bb.w);
            u32x2 o; o.x = pk2(o0, o1); o.y = pk2(o2, o3);
            *(u32x2*)(mix + (size_t)(m0 + row) * 1024 + n) = o;
            float sq = (o0 * o0 + o1 * o1) + (o2 * o2 + o3 * o3);
            sq += __shfl_xor(sq, 1); sq += __shfl_xor(sq, 2); sq += __shfl_xor(sq, 4); sq += __shfl_xor(sq, 8); sq += __shfl_xor(sq, 16);
            if ((tid & 31) == 0) __hip_atomic_fetch_add((float*)(ws + OFF_SSQ) + (size_t)(m0 + row) * 2, sq, __ATOMIC_RELAXED, __HIP_MEMORY_SCOPE_AGENT);
        }
    }
    __syncthreads();
}
DI void phase6(const Params& P, int tid, bool dry = false) {
    const int lane = tid & 63, wv = tid >> 6;
    bf16_t* mix = (bf16_t*)(P.ws + OFF_XN);
    for (int row = blockIdx.x * 8 + wv; row < T; row += gridDim.x * 8) {
#pragma unroll
        for (int seg = 0; seg < 2; ++seg) {
            bf16_t* p = mix + (size_t)row * 1024 + seg * 512 + lane * 8;
            const u32x4 v = *(const u32x4*)p;
            float f[8] = {bf2f(v.x & 0xffffu), bf2f(v.x >> 16), bf2f(v.y & 0xffffu), bf2f(v.y >> 16), bf2f(v.z & 0xffffu), bf2f(v.z >> 16), bf2f(v.w & 0xffffu), bf2f(v.w >> 16)};
            float s = 0.f;
#pragma unroll
            for (int i = 0; i < 8; ++i) s += f[i] * f[i];
            s = wave_sum(s);
            const float rs = rsqrtf(s * (1.f / 512.f) + EPS);
            const float* gw = P.in[seg ? 24 : 23] + lane * 8;
            const f32x4 g0 = *(const f32x4*)gw, g1 = *(const f32x4*)(gw + 4);
            u32x4 o; o.x = pk2(f[0] * rs * g0.x, f[1] * rs * g0.y); o.y = pk2(f[2] * rs * g0.z, f[3] * rs * g0.w);
            o.z = pk2(f[4] * rs * g1.x, f[5] * rs * g1.y); o.w = pk2(f[6] * rs * g1.z, f[7] * rs * g1.w);
            if (dry) o = v;
            *(u32x4*)p = o;
        }
    }
}
DI void phase7(const Params& P, unsigned char* lds_raw, int tid, int xmode = 0) {
    bf16_t* lds = (bf16_t*)lds_raw; float* Ct = (float*)lds_raw;
    const bf16_t* mix = (const bf16_t*)(P.ws + OFF_XN);
    const float* x = P.in[0];
    for (int u = vbid(); u < 256; u += gridDim.x) {
        const int mt = u >> 2, nt2 = u & 3, m0 = mt * 256;
        f32x16 acc[2][4]; zero_acc2(acc);
        const ASrc As = make_a(mix, 1024, nullptr, T, m0, tid);
        const BSrc2 bs = make_b2((const bf16_t*)(P.ws + OFF_WOUTT), 1024, 1024, nt2 * 256, tid);
        __syncthreads();
        float sc[8];
        {
            const float* ssq = (const float*)(P.ws + OFF_SSQ);
#pragma unroll
            for (int i = 0; i < 4; ++i) {
                const int row = m0 + (tid >> 3) + 64 * i;
                sc[i] = rsqrtf(ssq[(size_t)row * 2] * (1.f / 512.f) + EPS);
                sc[4 + i] = rsqrtf(ssq[(size_t)row * 2 + 1] * (1.f / 512.f) + EPS);
            }
        }
        if (xmode != 4) gemm_mainloop2s(acc, As, bs, 1024, lds, tid, sc);
        float* outp = xmode ? (float*)(P.ws + OFF_U) : P.out;
#pragma unroll 1
        for (int half = 0; half < 2; ++half) {
            const int n0 = nt2 * 256 + half * 128;
            if (xmode == 3) { if (tid == 0) outp[(size_t)m0 * 1024 + n0] = acc[0][0][0] + acc[1][3][5]; continue; }
            dump_acc2(acc, Ct, tid, half);
            __syncthreads();
            {
                const int c4 = tid & 31, r0 = tid >> 5;
#pragma unroll 1
                for (int jb = 0; jb < 16; jb += 4) {
                    f32x4 xv[4];
#pragma unroll
                    for (int j = 0; j < 4; ++j) xv[j] = *(const f32x4*)(x + (size_t)(m0 + r0 + 16 * (jb + j)) * 1024 + n0 + c4 * 4);
#pragma unroll
                    for (int j = 0; j < 4; ++j) {
                        const int row = r0 + 16 * (jb + j);
                        const f32x4 v = *(const f32x4*)(Ct + row * CT_STRIDE + c4 * 4);
                        *(f32x4*)(outp + (size_t)(m0 + row) * 1024 + n0 + c4 * 4) = xv[j] + v;
                    }
                }
            }
            __syncthreads();
        }
    }
    __syncthreads();
}
constexpr int RSTR = 264;
constexpr int R_AHI = 0, R_ALO = 64 * RSTR * 2, R_WHI = 2 * 64 * RSTR * 2, R_WLO = R_WHI + 40 * RSTR * 2, R_END = R_WLO + 40 * RSTR * 2;
struct RtRegs { f32x4 x[8]; u32x4 w[5]; };
DI void rt_load(RtRegs& R, const float* x1, const bf16_t* WrT, int m0, int c, int tid) {
    const int lane = tid & 63, w = tid >> 6;
#pragma unroll
    for (int i = 0; i < 8; ++i) R.x[i] = *(const f32x4*)(x1 + (size_t)(m0 + w * 8 + i) * 1024 + c * 256 + lane * 4);
#pragma unroll
    for (int i = 0; i < 5; ++i) { const int ch = tid + 512 * i, rw = ch >> 5, c16 = ch & 31;
        R.w[i] = *(const u32x4*)(WrT + (size_t)rw * 1024 + c * 256 + c16 * 8); }
}
DI void phase8(const Params& P, unsigned char* lds_raw, int tid, bool dry = false) {
    unsigned char* ws = P.ws;
    const float* x1 = P.out; const float* g2 = P.in[26];
    bf16_t* xg = (bf16_t*)(ws + (dry ? OFF_XN : OFF_H2HI));
    const bf16_t* WrT = (const bf16_t*)(ws + OFF_WRT);
    float* rs2 = (float*)(ws + OFF_RS2);
    unsigned* cnt = (unsigned*)(ws + OFF_CTL) + CW_CNT + (dry ? 64 * CNT_STRIDE : 0);
    int* list = (int*)(ws + (dry ? OFF_ACT : OFF_LIST)); float* listw = (float*)(ws + (dry ? OFF_ACT + (size_t)64 * T * 4 : OFF_LISTW));
    bf16_t* Ahi = (bf16_t*)(lds_raw + R_AHI); bf16_t* Alo = (bf16_t*)(lds_raw + R_ALO);
    bf16_t* Whi = (bf16_t*)(lds_raw + R_WHI);
    float* part = (float*)lds_raw;
    float* ssqp = (float*)(lds_raw + R_END);
    unsigned* hist = (unsigned*)(lds_raw + R_END + 256);
    unsigned* lbase = hist + 64;
    const int lane = tid & 63, w = tid >> 6, r = lane & 31, h = lane >> 5, mh = w & 1, ks = w >> 1;
    const int n0 = r, n1 = 32 + r < 40 ? 32 + r : 39;
    for (int u = blockIdx.x; u < 256; u += gridDim.x) {
        const int m0 = u * 64;
        f32x16 acc0, acc1;
#pragma unroll
        for (int i = 0; i < 16; ++i) { acc0[i] = 0.f; acc1[i] = 0.f; }
        float ssq[8];
#pragma unroll
        for (int i = 0; i < 8; ++i) ssq[i] = 0.f;
        RtRegs R;
        rt_load(R, x1, WrT, m0, 0, tid);
        __syncthreads();
#pragma unroll 1
        for (int c = 0; c < 4; ++c) {
            {
                const f32x4 g = *(const f32x4*)(g2 + c * 256 + lane * 4);
#pragma unroll
                for (int i = 0; i < 8; ++i) {
                    f32x4 v = R.x[i];
                    ssq[i] += (v.x * v.x + v.y * v.y) + (v.z * v.z + v.w * v.w);
                    v = v * g;
                    u32x2 hv; hv.x = pk2(v.x, v.y); hv.y = pk2(v.z, v.w);
                    u32x2 lv; lv.x = pk2(v.x - bf2f(hv.x & 0xffffu), v.y - bf2f(hv.x >> 16)); lv.y = pk2(v.z - bf2f(hv.y & 0xffffu), v.w - bf2f(hv.y >> 16));
                    const int row = w * 8 + i;
                    *(u32x2*)(Ahi + row * RSTR + lane * 4) = hv;
                    *(u32x2*)(Alo + row * RSTR + lane * 4) = lv;
                    *(u32x2*)(xg + (size_t)(m0 + row) * 1024 + c * 256 + lane * 4) = hv;
                }
#pragma unroll
                for (int i = 0; i < 5; ++i) { const int ch = tid + 512 * i, rw = ch >> 5, c16 = ch & 31; *(u32x4*)(Whi + rw * RSTR + c16 * 8) = R.w[i]; }
            }
            if (c < 3) rt_load(R, x1, WrT, m0, c + 1, tid);
            __syncthreads();
#pragma unroll 2
            for (int s4 = 0; s4 < 4; ++s4) {
                const int ko = (ks * 4 + s4) * 16 + 8 * h;
                const bf16x8 ah = *(const bf16x8*)(Ahi + (32 * mh + r) * RSTR + ko), al = *(const bf16x8*)(Alo + (32 * mh + r) * RSTR + ko);
                const bf16x8 wh0 = *(const bf16x8*)(Whi + n0 * RSTR + ko), wh1 = *(const bf16x8*)(Whi + n1 * RSTR + ko);
                const bf16x8 wl0 = *(const bf16x8*)(Whi + (40 + n0) * RSTR + ko), wl1 = *(const bf16x8*)(Whi + (40 + n1) * RSTR + ko);
                acc0 = MFMA32(ah, wh0, acc0); acc1 = MFMA32(ah, wh1, acc1);
                acc0 = MFMA32(ah, wl0, acc0); acc1 = MFMA32(ah, wl1, acc1);
                acc0 = MFMA32(al, wh0, acc0); acc1 = MFMA32(al, wh1, acc1);
            }
            __syncthreads();
        }
#pragma unroll
        for (int i = 0; i < 16; ++i) {
            float* d = part + ((ks * 64) + 32 * mh + crow(i, h)) * 64 + r;
            d[0] = acc0[i]; d[32] = acc1[i];
        }
#pragma unroll
        for (int i = 0; i < 8; ++i) { const float sv = wave_sum(ssq[i]); if (lane == 0) ssqp[w * 8 + i] = sv; }
        if (tid < 64) hist[tid] = 0u;
        __syncthreads();
        int vl0 = 0, vl1 = 0; unsigned lr0 = 0, lr1 = 0; float w0 = 0.f, w1 = 0.f;
        if (tid < 64) {
            const int t = tid, grow = m0 + t;
            const float rs = rsqrtf(ssqp[t] * (1.f / 1024.f) + EPS);
            const float* b_grp = P.in[28]; const float* b_exp = P.in[30];
            float gl[4]; int gsel = 0; float gmax = -3e38f;
#pragma unroll
            for (int j = 0; j < 4; ++j) {
                gl[j] = rs * ((part[t * 64 + j] + part[(64 + t) * 64 + j]) + (part[(128 + t) * 64 + j] + part[(192 + t) * 64 + j])) + b_grp[j];
                if (gl[j] > gmax) { gmax = gl[j]; gsel = j; }
            }
            float gsum = 0.f;
#pragma unroll
            for (int j = 0; j < 4; ++j) gsum += __expf(gl[j] - gmax);
            const float gprob = 1.f / gsum;
            float el[8]; float emax = -3e38f;
#pragma unroll
            for (int j = 0; j < 8; ++j) {
                const int cc = 4 + gsel * 8 + j;
                el[j] = rs * ((part[t * 64 + cc] + part[(64 + t) * 64 + cc]) + (part[(128 + t) * 64 + cc] + part[(192 + t) * 64 + cc])) + b_exp[gsel * 8 + j];
                emax = fmaxf(emax, el[j]);
            }
            int i0 = 0; float v0 = -3e38f;
#pragma unroll
            for (int j = 0; j < 8; ++j) if (el[j] > v0) { v0 = el[j]; i0 = j; }
            int i1 = 0; float v1 = -3e38f;
#pragma unroll
            for (int j = 0; j < 8; ++j) if (j != i0 && el[j] > v1) { v1 = el[j]; i1 = j; }
            const float p0 = __expf(v0 - emax), p1 = __expf(v1 - emax);
            w0 = p0 / (p0 + p1) * gprob; w1 = p1 / (p0 + p1) * gprob;
            vl0 = gsel * 8 + i0; vl1 = 32 + gsel * 8 + i1;
            if (!dry) rs2[grow] = rs;
            lr0 = atomicAdd(&hist[vl0], 1u);
            lr1 = atomicAdd(&hist[vl1], 1u);
        }
        __syncthreads();
        if (tid < 64) { const unsigned hc = hist[tid]; lbase[tid] = hc ? atomicAdd(&cnt[tid * CNT_STRIDE], hc) : 0u; }
        __syncthreads();
        if (tid < 64) {
            const int grow = m0 + tid;
            const unsigned q0 = lbase[vl0] + lr0, q1 = lbase[vl1] + lr1;
            list[(size_t)vl0 * T + q0] = grow; listw[(size_t)vl0 * T + q0] = w0;
            list[(size_t)vl1 * T + q1] = grow; listw[(size_t)vl1 * T + q1] = w1;
        }
    }
    __syncthreads();
}
DI bool moe_unit(const unsigned* cnt, int u, int ntn, int vlo, int vhi, int& v, int& mt, int& nt, int& base, int& M) {
    int acc = 0, b = 0;
    for (int vv = 0; vv < vhi; ++vv) {
        const int c = (int)cnt[vv * CNT_STRIDE];
        if (vv >= vlo) {
            const int nu = ((c + 255) >> 8) * ntn;
            if (u < acc + nu) { const int loc = u - acc; v = vv; mt = loc / ntn; nt = loc - mt * ntn; base = b; M = c; return true; }
            acc += nu;
        }
        b += c;
    }
    return false;
}
DI void phase9(const Params& P, unsigned char* lds_raw, int tid, float* outp, int mode = 0) {
    asm volatile("" : "+v"(tid));
    bf16_t* lds = (bf16_t*)lds_raw; float* Ct = (float*)lds_raw;
    unsigned char* ws = P.ws;
    unsigned* ctl = (unsigned*)(ws + OFF_CTL);
    const unsigned* cnt = ctl + CW_CNT;
    const bf16_t* hi = (const bf16_t*)(ws + OFF_H2HI);
    const int* list = (const int*)(ws + OFF_LIST); const float* listw = (const float*)(ws + OFF_LISTW);
    const float* rs2 = (const float*)(ws + OFF_RS2);
    bf16_t* act = (bf16_t*)(ws + OFF_ACT);
    float* rowf = (float*)(lds_raw + 147456);
    int* rowi = (int*)(lds_raw + 147456 + 1024);
    bf16_t* Y0 = (bf16_t*)(ws + OFF_XN);
    int total1 = 0, total2a = 0, total2b = 0;
    for (int vv = 0; vv < 64; ++vv) { const int mtv = ((int)cnt[vv * CNT_STRIDE] + 255) >> 8; total1 += mtv * 2; if (vv < 32) total2a += mtv * 4; else total2b += mtv * 4; }
    const int total = total1 + total2a + total2b;
    volatile unsigned* wq = (volatile unsigned*)(lds_raw + LDS_BYTES - 64) + 8;
    int u = vbid();
    while (u < total) {
        unsigned nxt = 0;
        if (tid == 0) nxt = gridDim.x + __hip_atomic_fetch_add(ctl + CW_WQ, 1u, __ATOMIC_RELAXED, __HIP_MEMORY_SCOPE_AGENT);
        int v, mt, nt, base, M;
        if ((mode == 2 && u >= total1) || (mode == 3 && u < total1)) {
        } else if (u < total1) {
            if (!moe_unit(cnt, u, 2, 0, 64, v, mt, nt, base, M)) break;
            const int e = v & 31;
            const int m0 = mt * 256;
            const int* rows = list + (size_t)v * T;
            f32x16 acc[2][4]; zero_acc2(acc);
            const ASrc As = make_a(hi, 1024, rows, M, m0, tid);
            const BSrc2 bs = make_b2((const bf16_t*)(ws + OFF_WGUT) + (size_t)e * 512 * 1024, 1024, 512, nt * 256, tid);
            float rsr = 0.f;
            if (tid < 256 && m0 + tid < M) rsr = rs2[rows[m0 + tid]];
            __syncthreads();
            gemm_mainloop2(acc, As, bs, 1024, lds, tid);
            if (tid < 256) rowf[tid] = rsr;
#pragma unroll 1
            for (int half = 0; half < 2; ++half) {
                const int nq = nt * 2 + half;
                dump_acc2(acc, Ct, tid, half);
                __syncthreads();
                for (int it = tid; it < 256 * 16; it += NTHREADS) {
                    const int row = it >> 4, q = it & 15, wn_ = q >> 3, c = (q & 7) * 4;
                    if (m0 + row < M) {
                        const float rs = rowf[row];
                        const f32x4 gt = *(const f32x4*)(Ct + row * CT_STRIDE + wn_ * 64 + c) * rs;
                        const f32x4 up = *(const f32x4*)(Ct + row * CT_STRIDE + wn_ * 64 + 32 + c) * rs;
                        u32x2 o; o.x = pk2(gt.x * sigmoidf(gt.x) * up.x, gt.y * sigmoidf(gt.y) * up.y); o.y = pk2(gt.z * sigmoidf(gt.z) * up.z, gt.w * sigmoidf(gt.w) * up.w);
                        st_wt8(act + (size_t)(base + m0 + row) * 256 + nq * 64 + wn_ * 32 + c, o);
                    }
                }
                __syncthreads();
            }
            unit_signal(ctl + CW_DONE + v * 64 + mt, tid);
        } else {
            const bool slot1 = u >= total1 + total2a;
            if (!moe_unit(cnt, slot1 ? u - total1 - total2a : u - total1, 4, slot1 ? 32 : 0, slot1 ? 64 : 32, v, mt, nt, base, M)) break;
            const int e = v & 31;
            const int m0 = mt * 256;
            const bf16_t* A = act + (size_t)base * 256;
            f32x16 acc[2][4]; zero_acc2(acc);
            const ASrc As = make_a(A, 256, nullptr, M, m0, tid);
            const BSrc2 bs = make_b2((const bf16_t*)(ws + OFF_WDT) + (size_t)e * 1024 * 256, 256, 1024, nt * 256, tid);
            int tokr = 0; float wgtr = 0.f;
            if (tid < 256) { const int rr = m0 + tid < M ? m0 + tid : M - 1; tokr = list[(size_t)v * T + rr]; wgtr = listw[(size_t)v * T + rr]; }
            unit_wait2(ctl + CW_DONE + v * 64 + mt, 2u, slot1 ? ctl + CW_S0DONE : nullptr, (unsigned)total2a, tid);
            gemm_mainloop2(acc, As, bs, 256, lds, tid);
            if (tid < 256) { rowi[tid] = tokr; rowf[tid] = wgtr; }
#pragma unroll 1
            for (int half = 0; half < 2; ++half) {
                const int n0 = nt * 256 + half * 128;
                dump_acc2(acc, Ct, tid, half);
                __syncthreads();
                {
                    const int c4 = tid & 31, r0 = tid >> 5;
                    if (!slot1) {
#pragma unroll 4
                        for (int j = 0; j < 16; ++j) {
                            const int row = r0 + 16 * j;
                            if (m0 + row < M) {
                                const f32x4 cv = *(const f32x4*)(Ct + row * CT_STRIDE + c4 * 4) * rowf[row];
                                u32x2 o; o.x = pk2(cv.x, cv.y); o.y = pk2(cv.z, cv.w);
                                st_wt8(Y0 + (size_t)rowi[row] * 1024 + n0 + c4 * 4, o);
                            }
                        }
                    } else {
#pragma unroll 1
                        for (int jb = 0; jb < 16; jb += 8) {
                            f32x4 ov[8]; u32x2 yv[8];
#pragma unroll
                            for (int j = 0; j < 8; ++j) {
                                const size_t o = (size_t)rowi[r0 + 16 * (jb + j)] * 1024 + n0 + c4 * 4;
                                ov[j] = *(const f32x4*)(outp + o);
                                yv[j] = *(const u32x2*)(Y0 + o);
                            }
#pragma unroll
                            for (int j = 0; j < 8; ++j) {
                                const int row = r0 + 16 * (jb + j);
                                if (m0 + row < M) {
                                    const f32x4 cv = *(const f32x4*)(Ct + row * CT_STRIDE + c4 * 4) * rowf[row];
                                    f32x4 nv = ov[j] + cv;
                                    nv.x += bf2f(yv[j].x & 0xffffu); nv.y += bf2f(yv[j].x >> 16); nv.z += bf2f(yv[j].y & 0xffffu); nv.w += bf2f(yv[j].y >> 16);
                                    *(f32x4*)(outp + (size_t)rowi[row] * 1024 + n0 + c4 * 4) = nv;
                                }
                            }
                        }
                    }
                }
                __syncthreads();
            }
            if (!slot1) unit_signal(ctl + CW_S0DONE, tid);
        }
        if (tid == 0) wq[0] = nxt;
        __syncthreads();
        u = __builtin_amdgcn_readfirstlane((int)wq[0]);
    }
    __syncthreads();
}

constexpr int NPHASES = 10;
__global__ void __launch_bounds__(NTHREADS, 2) mk(Params P) {
    extern __shared__ __attribute__((aligned(16))) unsigned char lds_raw[];
    const int tid = threadIdx.x;
    volatile unsigned* misc = (volatile unsigned*)(lds_raw + LDS_BYTES - 64);
    if (tid < 2) misc[tid] = 0u;
    __syncthreads();
    XcdBarrier bar; bar.bar = nullptr; bar.x = 0; bar.st = nullptr;
    const bool multi = (P.ph_hi - P.ph_lo) > 1;
    if (multi) bar = xcd_barrier_post((unsigned*)(P.ws + OFF_CTL) + CW_BAR, misc);
    const int lo = P.ph_lo, hi = P.ph_hi;
#define IN(k) (lo <= (k) && (k) < hi)
#define SEAM(k) do { if (IN(k) && IN((k) + 1)) xcd_barrier(bar); } while (0)
#ifndef PROBE_PHASE
#define PROBE_PHASE -1
#endif
#ifndef PROBE_XMODE
#define PROBE_XMODE 0
#endif
#define RUN(k, call, calldry) do { if (IN(k)) { call; if (PROBE_PHASE == (k) || PROBE_PHASE == 100 + (k) / 4) { xcd_barrier(bar); calldry; } } } while (0)
    RUN(0, phase0(P, lds_raw, tid), phase0(P, lds_raw, tid, PROBE_XMODE));
    SEAM(0);
    RUN(1, phase1(P, lds_raw, tid), phase1(P, lds_raw, tid, PROBE_XMODE));
    SEAM(1);
    RUN(2, phase2(P, lds_raw, tid), phase2(P, lds_raw, tid));
    SEAM(2);
    RUN(4, phase4(P, lds_raw, tid), phase4(P, lds_raw, tid, PROBE_XMODE ? PROBE_XMODE : 3));
    SEAM(4);
    RUN(5, phase5(P, lds_raw, tid), phase5(P, lds_raw, tid));
    SEAM(5);
    RUN(7, phase7(P, lds_raw, tid), phase7(P, lds_raw, tid, PROBE_XMODE));
    SEAM(7);
    if (IN(8)) {
        if (PROBE_PHASE == 8) {
            phase8(P, lds_raw, tid); xcd_barrier(bar);
            if (blockIdx.x == 0 && tid < 64) ((unsigned*)(P.ws + OFF_CTL))[CW_CNT + tid * CNT_STRIDE] = 0u;
            xcd_barrier(bar);
        }
        phase8(P, lds_raw, tid);
    }
    SEAM(8);
    if (IN(9)) {
        if (PROBE_PHASE == 9) {
            unsigned* ctl = (unsigned*)(P.ws + OFF_CTL);
            phase9(P, lds_raw, tid, PROBE_XMODE == 0 ? (float*)(P.ws + OFF_KC) : P.out);
            xcd_barrier(bar);
            if (blockIdx.x == 0) {
                if (PROBE_XMODE == 0) { for (int i = tid; i < 4096; i += NTHREADS) ctl[CW_DONE + i] = 0u; if (tid == 0) ctl[CW_S0DONE] = 0u; }
                if (tid == 0) ctl[CW_WQ] = 0u;
            }
            xcd_barrier(bar);
            phase9(P, lds_raw, tid, PROBE_XMODE == 0 ? P.out : (float*)(P.ws + OFF_KC), PROBE_XMODE >= 2 ? PROBE_XMODE : 0);
        } else phase9(P, lds_raw, tid, P.out);
    }
#undef RUN
#undef IN
#undef SEAM
}

extern "C" void kernel_launch(void* const* d_in, const int* in_sizes, int n_in, void* d_out, int out_size, void* d_ws, size_t ws_size, hipStream_t stream) {
    static int grid = 0;
    if (grid == 0) {
        if (n_in != 34 || out_size != T * DM || ws_size < WS_END) {
            fprintf(stderr, "kernel_launch: unexpected shapes: n_in %d out %d ws %zu (need %zu)\n", n_in, out_size, ws_size, (size_t)WS_END);
            grid = -1; return;
        }
        int dev = 0, cus = 0;
        hipGetDevice(&dev);
        hipDeviceGetAttribute(&cus, hipDeviceAttributeMultiprocessorCount, dev);
        hipFuncSetAttribute((const void*)mk, hipFuncAttributeMaxDynamicSharedMemorySize, LDS_BYTES);
        int per_cu = 0;
        hipOccupancyMaxActiveBlocksPerMultiprocessor(&per_cu, (const void*)mk, NTHREADS, LDS_BYTES);
        (void)hipGetLastError();
        if (per_cu < 1) fprintf(stderr, "kernel_launch: occupancy query says %d blocks/CU\n", per_cu);
        grid = cus > 0 ? cus : 256;
    }
    if (grid < 0) return;
    hipMemsetAsync((char*)d_ws + OFF_CTL, 0, CTL_BYTES, stream);
    Params p{};
    for (int i = 0; i < 34; ++i) p.in[i] = (const float*)d_in[i];
    p.out = (float*)d_out; p.ws = (unsigned char*)d_ws;
#ifndef MK_ONE_LAUNCH
    for (int ph = 0; ph < NPHASES; ++ph) {
        p.ph_lo = ph; p.ph_hi = ph + 1;
        hipLaunchKernelGGL(mk, dim3(grid), dim3(NTHREADS), LDS_BYTES, stream, p);
    }
#else
    p.ph_lo = 0; p.ph_hi = NPHASES;
    hipLaunchKernelGGL(mk, dim3(grid), dim3(NTHREADS), LDS_BYTES, stream, p);
#endif
}
```

```cpp
#define MK_ONE_LAUNCH 1
#include <hip/hip_runtime.h>
#include <stdint.h>
#include <cstdio>

#define DI __device__ __forceinline__
typedef unsigned short bf16_t;
typedef short bf16x8 __attribute__((ext_vector_type(8)));
typedef short s16x4 __attribute__((ext_vector_type(4)));
typedef float f32x16 __attribute__((ext_vector_type(16)));
typedef float f32x4 __attribute__((ext_vector_type(4)));
typedef unsigned u32x4 __attribute__((ext_vector_type(4)));
typedef unsigned u32x2 __attribute__((ext_vector_type(2)));

constexpr int T = 16384, SEQ = 4096, NBATCH = 4, DM = 1024, DIN = 1816;
constexpr int NTHREADS = 512;
constexpr float EPS = 1e-6f;

constexpr size_t al256(size_t x) { return (x + 255) & ~(size_t)255; }
constexpr size_t OFF_CTL   = 0;
constexpr size_t CTL_BYTES = 65536;
constexpr size_t OFF_XN    = OFF_CTL + CTL_BYTES;
constexpr size_t OFF_U     = OFF_XN + (size_t)T * 1024 * 2;
constexpr size_t OFF_QN    = OFF_U + (size_t)T * 512 * 2;
constexpr size_t KV_BYTES  = (size_t)8 * 4096 * 64 * 2;
constexpr size_t OFF_KC    = OFF_QN + (size_t)T * 512 * 2;
constexpr size_t OFF_VC    = OFF_KC + KV_BYTES;
constexpr size_t OFF_KSN   = OFF_VC + KV_BYTES;
constexpr size_t OFF_KWN   = OFF_KSN + KV_BYTES;
constexpr size_t OFF_VST   = OFF_KWN + KV_BYTES;
constexpr size_t OFF_VWT   = OFF_VST + KV_BYTES;
constexpr size_t OFF_GATES = OFF_VWT + KV_BYTES;
constexpr size_t OFF_TGT   = OFF_GATES + (size_t)T * 24 * 4;
constexpr size_t OFF_EGT   = OFF_TGT + (size_t)32 * 512 * 512 * 2;
constexpr size_t OFF_FGT   = OFF_EGT + (size_t)32 * 128 * 512 * 2;
constexpr size_t OFF_LAM32 = OFF_FGT + (size_t)32 * 512 * 128 * 2;
constexpr size_t OFF_BIASP = OFF_LAM32 + 32 * 64 * 2 * 4;
constexpr size_t OFF_Z     = OFF_BIASP + 2 * 16 * 256 * 4;
constexpr size_t OFF_SIN   = OFF_Z + (size_t)32 * 512 * 128 * 4;
constexpr size_t OFF_P     = OFF_SIN + (size_t)32 * 512 * 128 * 2;
constexpr size_t OFF_KCMP  = OFF_P + (size_t)2 * 8 * 2 * 256 * 256 * 4;
constexpr size_t OFF_VCMPT = OFF_KCMP + 8 * 256 * 64 * 2;
constexpr size_t OFF_Y1    = OFF_VCMPT + 8 * 64 * 256 * 2;
constexpr size_t OFF_H2HI  = OFF_U;
constexpr size_t OFF_H2LO  = OFF_TGT;
constexpr size_t OFF_ACT   = OFF_Y1;
constexpr size_t OFF_LIST  = OFF_Y1 + (size_t)T * 512 * 2;
constexpr size_t OFF_LISTW = OFF_LIST + (size_t)64 * T * 4;
constexpr size_t OFF_RS2   = OFF_LISTW + (size_t)64 * T * 4;
constexpr size_t OFF_SSQ   = OFF_RS2 + (size_t)T * 4;
constexpr size_t OFF_WINT  = OFF_SSQ + (size_t)T * 2 * 4;
constexpr size_t OFF_WGLUT = OFF_WINT + (size_t)1816 * 1024 * 2;
constexpr size_t OFF_WC1T  = OFF_WGLUT + (size_t)512 * 512 * 2;
constexpr size_t OFF_WOUTT = OFF_WC1T + (size_t)4 * 256 * 1024 * 2;
constexpr size_t OFF_WRT   = OFF_WOUTT + (size_t)1024 * 1024 * 2;
constexpr size_t OFF_WGUT  = OFF_WRT + (size_t)2 * 40 * 1024 * 2;
constexpr size_t OFF_WDT   = OFF_WGUT + (size_t)32 * 512 * 1024 * 2;
constexpr size_t WS_END    = OFF_WDT + (size_t)32 * 1024 * 256 * 2;
static_assert(OFF_H2HI + (size_t)T * 1024 * 2 <= OFF_KC, "h2hi overlay");
static_assert(OFF_H2LO + (size_t)T * 1024 * 2 <= OFF_SIN, "h2lo overlay");
static_assert(WS_END <= (size_t)256 * 1024 * 1024, "workspace");

constexpr int CW_CNT = 8192;
constexpr int CNT_STRIDE = 32;
constexpr int CW_WQ = 4736;
constexpr int CW_S0DONE = 4608;
constexpr int CW_DONE = 12288;
constexpr int CW_PDONE = 4864;
constexpr int CW_BAR = 1024;

constexpr int LDS_BYTES = 151552;
constexpr int BM = 256, BN = 128, BK = 64;
constexpr int LSTR = 72;
constexpr int A_TILE = BM * LSTR;
constexpr int B_TILE = BN * LSTR;
constexpr int STAGE_ELEMS = A_TILE + B_TILE;
constexpr int CT_STRIDE = 132;
constexpr int STAGE2_ELEMS = (BM + 256) * LSTR;

struct Params {
    const float* in[34];
    float* out;
    unsigned char* ws;
    int ph_lo, ph_hi;
};

DI unsigned f2bf(float f) { unsigned u = __builtin_bit_cast(unsigned, f); return (u + 0x7fffu + ((u >> 16) & 1u)) >> 16; }
DI float bf2f(unsigned b) { return __builtin_bit_cast(float, b << 16); }
typedef float f32x2 __attribute__((ext_vector_type(2)));
typedef __bf16 bf16x2_t __attribute__((ext_vector_type(2)));
DI unsigned pk2(float lo, float hi) { f32x2 v = {lo, hi}; bf16x2_t b = __builtin_convertvector(v, bf16x2_t); return __builtin_bit_cast(unsigned, b); }
DI float wave_sum(float v) {
#pragma unroll
    for (int o = 1; o < 64; o <<= 1) v += __shfl_xor(v, o);
    return v;
}
DI float gelu_tanh(float x) {
    const float k0 = 0.7978845608028654f, k1 = 0.044715f;
    float u = k0 * (x + k1 * x * x * x);
    float e = __expf(2.f * u);
    float th = 1.f - 2.f / (e + 1.f);
    return 0.5f * x * (1.f + th);
}
DI float sigmoidf(float x) { return 1.f / (1.f + __expf(-x)); }
DI int vbid() { const int G = gridDim.x, b = blockIdx.x; return (G & 7) == 0 ? (b & 7) * (G >> 3) + (b >> 3) : b; }
DI int crow(int reg, int h) { return (reg & 3) + 8 * (reg >> 2) + 4 * h; }
#define MFMA32(a, b, c) __builtin_amdgcn_mfma_f32_32x32x16_bf16((a), (b), (c), 0, 0, 0)

#define XB_TMO      128
#define XB_XCNT(j)  (256  + 64 * (j))
#define XB_XSUB(j)  (1280 + 64 * (j))
#define XB_XGEN(j)  (2304 + 64 * (j))
#define XB_TOP      3328
#define XB_TOPGEN   3392
#define XCD_BAR_WORDS 3456
#define XB_SPIN_CAP (1u << 22)
DI unsigned xb_ld(unsigned* p)              { return __hip_atomic_load(p, __ATOMIC_RELAXED, __HIP_MEMORY_SCOPE_AGENT); }
DI unsigned xb_add(unsigned* p, unsigned v) { return __hip_atomic_fetch_add(p, v, __ATOMIC_RELAXED, __HIP_MEMORY_SCOPE_AGENT); }
DI unsigned xb_xcc_id() { return (unsigned)__builtin_amdgcn_s_getreg((3 << 11) | 20) & 0xFu; }
#define XB_SPIN(cond, bar) do { unsigned _sp = 0; while (cond) { __builtin_amdgcn_s_sleep(1); \
    if ((++_sp & 255u) == 0u) { if (xb_ld(&(bar)[XB_TMO])) break; if (_sp > XB_SPIN_CAP) { atomicAdd(&(bar)[XB_TMO], 1u); break; } } } } while (0)
struct XcdBarrier { unsigned* bar; unsigned x; volatile unsigned* st; };
DI XcdBarrier xcd_barrier_post(unsigned* bar, volatile unsigned* st) {
    XcdBarrier b; b.bar = bar; b.x = xb_xcc_id(); b.st = st;
    if (threadIdx.x == 0) (void)xb_add(&bar[XB_XCNT(b.x)], 1u);
    return b;
}
DI void xcd_barrier_complete(unsigned* bar, unsigned x, unsigned& nloc, unsigned& nx) {
    const unsigned G = gridDim.x;
    unsigned sum, cnt, mine, sp = 0u;
    for (;;) {
        sum = 0u; cnt = 0u; mine = 0u;
#pragma unroll
        for (unsigned j = 0; j < 16; ++j) { const unsigned c = xb_ld(&bar[XB_XCNT(j)]); sum += c; cnt += (c > 0u) ? 1u : 0u; mine = (j == x) ? c : mine; }
        if (sum == G) break;
        __builtin_amdgcn_s_sleep(1);
        if ((++sp & 255u) == 0u) { if (xb_ld(&bar[XB_TMO])) break; if (sp > XB_SPIN_CAP) { atomicAdd(&bar[XB_TMO], 1u); break; } }
    }
    nloc = mine > 0u ? mine : 1u; nx = cnt > 0u ? cnt : 1u;
}
DI void xcd_barrier(const XcdBarrier& b) {
    asm volatile("s_waitcnt vmcnt(0)" ::: "memory");
    __syncthreads();
    if (threadIdx.x == 0) {
        unsigned* bar = b.bar;
        __builtin_amdgcn_s_waitcnt(0);
        unsigned nloc = b.st[0], nx = b.st[1];
        if (nloc == 0u) { xcd_barrier_complete(bar, b.x, nloc, nx); b.st[0] = nloc; b.st[1] = nx; }
        const unsigned old = xb_add(&bar[XB_XSUB(b.x)], 1u);
        const unsigned gen = old / nloc;
        if (old + 1u == (gen + 1u) * nloc) {
            __builtin_amdgcn_fence(__ATOMIC_RELEASE, "agent");
            asm volatile("s_waitcnt vmcnt(0)" ::: "memory");
            const unsigned og = xb_add(&bar[XB_TOP], 1u);
            const unsigned tg = og / nx;
            if (og + 1u == (tg + 1u) * nx) xb_add(&bar[XB_TOPGEN], 1u);
            else XB_SPIN(xb_ld(&bar[XB_TOPGEN]) == tg, bar);
            __builtin_amdgcn_fence(__ATOMIC_ACQUIRE, "agent");
            xb_add(&bar[XB_XGEN(b.x)], 1u);
            asm volatile("s_waitcnt vmcnt(0)" ::: "memory");
        } else {
            XB_SPIN(xb_ld(&bar[XB_XGEN(b.x)]) == gen, bar);
            __builtin_amdgcn_fence(__ATOMIC_ACQUIRE, "agent");
            asm volatile("s_waitcnt vmcnt(0)" ::: "memory");
        }
    }
    __syncthreads();
}

struct BSrcBf { const bf16_t* p0; const bf16_t* p1; };
struct GRegs { u32x4 a0, a1, a2, a3, b0, b1; };
struct ASrc { const bf16_t* a0; const bf16_t* a1; const bf16_t* a2; const bf16_t* a3; };
DI void g_load(GRegs& r, const ASrc& A, const BSrcBf& B, int kb) {
    const int ko = kb * BK;
    r.a0 = *(const u32x4*)(A.a0 + ko); r.a1 = *(const u32x4*)(A.a1 + ko); r.a2 = *(const u32x4*)(A.a2 + ko); r.a3 = *(const u32x4*)(A.a3 + ko);
    r.b0 = *(const u32x4*)(B.p0 + ko); r.b1 = *(const u32x4*)(B.p1 + ko);
}
DI void g_store(const GRegs& r, bf16_t* st, int tid) {
    const int off = (tid >> 3) * LSTR + (tid & 7) * 8;
    *(u32x4*)(st + off) = r.a0; *(u32x4*)(st + off + 64 * LSTR) = r.a1; *(u32x4*)(st + off + 128 * LSTR) = r.a2; *(u32x4*)(st + off + 192 * LSTR) = r.a3;
    *(u32x4*)(st + A_TILE + off) = r.b0; *(u32x4*)(st + A_TILE + off + 64 * LSTR) = r.b1;
}
DI void g_compute(f32x16 (&acc)[2][2], const bf16_t* st, int wm, int wn, int r, int h) {
    const bf16_t* ab = st + (wm * 64 + r) * LSTR + h * 8;
    const bf16_t* bb = st + A_TILE + (wn * 64 + r) * LSTR + h * 8;
#pragma unroll
    for (int s = 0; s < 4; ++s) {
        const bf16x8 af0 = *(const bf16x8*)(ab + s * 16);
        const bf16x8 af1 = *(const bf16x8*)(ab + 32 * LSTR + s * 16);
        const bf16x8 bf0 = *(const bf16x8*)(bb + s * 16);
        const bf16x8 bf1 = *(const bf16x8*)(bb + 32 * LSTR + s * 16);
        acc[0][0] = MFMA32(af0, bf0, acc[0][0]);
        acc[0][1] = MFMA32(af0, bf1, acc[0][1]);
        acc[1][0] = MFMA32(af1, bf0, acc[1][0]);
        acc[1][1] = MFMA32(af1, bf1, acc[1][1]);
    }
}
DI void gemm_mainloop(f32x16 (&acc)[2][2], const ASrc& A, const BSrcBf& B, int K, bf16_t* lds, int tid, int xmode = 0) {
    const int lane = tid & 63, w = tid >> 6, r = lane & 31, h = lane >> 5;
    const int wm = w >> 1, wn = w & 1;
    const int nk = K / BK;
    GRegs RA, RB;
    g_load(RA, A, B, 0);
    g_store(RA, lds, tid);
    if (nk > 1) g_load(RA, A, B, 1);
    if (nk > 2) g_load(RB, A, B, 2);
    __syncthreads();
    for (int kb = 0; kb < nk; kb += 2) {
        if (xmode != 2) g_compute(acc, lds, wm, wn, r, h);
        if (kb + 1 < nk) g_store(RA, lds + STAGE_ELEMS, tid);
        if (kb + 3 < nk) g_load(RA, A, B, xmode == 1 ? 0 : kb + 3);
        __syncthreads();
        if (kb + 1 >= nk) break;
        if (xmode != 2) g_compute(acc, lds + STAGE_ELEMS, wm, wn, r, h);
        if (kb + 2 < nk) g_store(RB, lds, tid);
        if (kb + 4 < nk) g_load(RB, A, B, xmode == 1 ? 1 : kb + 4);
        __syncthreads();
    }
}

DI void zero_acc(f32x16 (&acc)[2][2]) {
#pragma unroll
    for (int a = 0; a < 2; ++a)
#pragma unroll
        for (int b = 0; b < 2; ++b)
#pragma unroll
            for (int i = 0; i < 16; ++i) acc[a][b][i] = 0.f;
}
DI void dump_acc(const f32x16 (&acc)[2][2], float* Ct, int tid) {
    const int lane = tid & 63, w = tid >> 6, r = lane & 31, h = lane >> 5;
    const int wm = w >> 1, wn = w & 1;
#pragma unroll
    for (int tm = 0; tm < 2; ++tm)
#pragma unroll
        for (int tn = 0; tn < 2; ++tn)
#pragma unroll
            for (int i = 0; i < 16; ++i)
                Ct[(wm * 64 + tm * 32 + crow(i, h)) * CT_STRIDE + wn * 64 + tn * 32 + r] = acc[tm][tn][i];
}
struct BSrc2 { const bf16_t* p0; const bf16_t* p1; const bf16_t* p2; const bf16_t* p3; };
struct GRegs2 { u32x4 a0, a1, a2, a3, b0, b1, b2, b3; };
DI void g2_load(GRegs2& r, const ASrc& A, const BSrc2& B, int kb) {
    const int ko = kb * BK;
    r.a0 = *(const u32x4*)(A.a0 + ko); r.a1 = *(const u32x4*)(A.a1 + ko); r.a2 = *(const u32x4*)(A.a2 + ko); r.a3 = *(const u32x4*)(A.a3 + ko);
    r.b0 = *(const u32x4*)(B.p0 + ko); r.b1 = *(const u32x4*)(B.p1 + ko); r.b2 = *(const u32x4*)(B.p2 + ko); r.b3 = *(const u32x4*)(B.p3 + ko);
}
DI void g2_store(const GRegs2& r, bf16_t* st, int tid) {
    const int off = (tid >> 3) * LSTR + (tid & 7) * 8;
    *(u32x4*)(st + off) = r.a0; *(u32x4*)(st + off + 64 * LSTR) = r.a1; *(u32x4*)(st + off + 128 * LSTR) = r.a2; *(u32x4*)(st + off + 192 * LSTR) = r.a3;
    bf16_t* sb = st + A_TILE;
    *(u32x4*)(sb + off) = r.b0; *(u32x4*)(sb + off + 64 * LSTR) = r.b1; *(u32x4*)(sb + off + 128 * LSTR) = r.b2; *(u32x4*)(sb + off + 192 * LSTR) = r.b3;
}
DI void g2_compute(f32x16 (&acc)[2][4], const bf16_t* st, int wm, int wn, int r, int h) {
    const bf16_t* ab = st + (wm * 64 + r) * LSTR + h * 8;
    const bf16_t* bb = st + A_TILE + (wn * 128 + r) * LSTR + h * 8;
#pragma unroll
    for (int s = 0; s < 4; ++s) {
        const bf16x8 af0 = *(const bf16x8*)(ab + s * 16);
        const bf16x8 af1 = *(const bf16x8*)(ab + 32 * LSTR + s * 16);
#pragma unroll
        for (int tn = 0; tn < 4; ++tn) {
            const bf16x8 bf = *(const bf16x8*)(bb + tn * 32 * LSTR + s * 16);
            acc[0][tn] = MFMA32(af0, bf, acc[0][tn]);
            acc[1][tn] = MFMA32(af1, bf, acc[1][tn]);
        }
    }
}
DI void gemm_mainloop2(f32x16 (&acc)[2][4], const ASrc& A, const BSrc2& B, int K, bf16_t* lds, int tid) {
    const int lane = tid & 63, w = tid >> 6, r = lane & 31, h = lane >> 5;
    const int wm = w >> 1, wn = w & 1;
    const int nk = K / BK;
    GRegs2 RA;
    g2_load(RA, A, B, 0);
    g2_store(RA, lds, tid);
    if (nk > 1) g2_load(RA, A, B, 1);
    __syncthreads();
    for (int kb = 0; kb < nk; ++kb) {
        g2_compute(acc, lds + (kb & 1) * STAGE2_ELEMS, wm, wn, r, h);
        if (kb + 1 < nk) g2_store(RA, lds + ((kb + 1) & 1) * STAGE2_ELEMS, tid);
        if (kb + 2 < nk) g2_load(RA, A, B, kb + 2);
        __syncthreads();
    }
}
DI u32x4 scale8(u32x4 v, float sc) {
    u32x4 o;
    o.x = pk2(__builtin_bit_cast(float, v.x << 16) * sc, __builtin_bit_cast(float, v.x & 0xffff0000u) * sc);
    o.y = pk2(__builtin_bit_cast(float, v.y << 16) * sc, __builtin_bit_cast(float, v.y & 0xffff0000u) * sc);
    o.z = pk2(__builtin_bit_cast(float, v.z << 16) * sc, __builtin_bit_cast(float, v.z & 0xffff0000u) * sc);
    o.w = pk2(__builtin_bit_cast(float, v.w << 16) * sc, __builtin_bit_cast(float, v.w & 0xffff0000u) * sc);
    return o;
}
DI void gemm_mainloop2s(f32x16 (&acc)[2][4], const ASrc& A, const BSrc2& B, int K, bf16_t* lds, int tid, const float (&sc)[8]) {
    const int lane = tid & 63, w = tid >> 6, r = lane & 31, h = lane >> 5;
    const int wm = w >> 1, wn = w & 1;
    const int nk = K / BK;
    GRegs2 RA;
    g2_load(RA, A, B, 0);
    { RA.a0 = scale8(RA.a0, sc[0]); RA.a1 = scale8(RA.a1, sc[1]); RA.a2 = scale8(RA.a2, sc[2]); RA.a3 = scale8(RA.a3, sc[3]); }
    g2_store(RA, lds, tid);
    if (nk > 1) g2_load(RA, A, B, 1);
    __syncthreads();
    for (int kb = 0; kb < nk; ++kb) {
        g2_compute(acc, lds + (kb & 1) * STAGE2_ELEMS, wm, wn, r, h);
        if (kb + 1 < nk) {
            const int o = ((kb + 1) * BK < 512) ? 0 : 4;
            RA.a0 = scale8(RA.a0, sc[o]); RA.a1 = scale8(RA.a1, sc[o + 1]); RA.a2 = scale8(RA.a2, sc[o + 2]); RA.a3 = scale8(RA.a3, sc[o + 3]);
            g2_store(RA, lds + ((kb + 1) & 1) * STAGE2_ELEMS, tid);
        }
        if (kb + 2 < nk) g2_load(RA, A, B, kb + 2);
        __syncthreads();
    }
}
DI void zero_acc2(f32x16 (&acc)[2][4]) {
#pragma unroll
    for (int a = 0; a < 2; ++a)
#pragma unroll
        for (int b = 0; b < 4; ++b)
#pragma unroll
            for (int i = 0; i < 16; ++i) acc[a][b][i] = 0.f;
}
DI void dump_acc2(const f32x16 (&acc)[2][4], float* Ct, int tid, int half) {
    const int lane = tid & 63, w = tid >> 6, r = lane & 31, h = lane >> 5;
    const int wm = w >> 1, wn = w & 1;
    if (wn == half) {
#pragma unroll
        for (int tm = 0; tm < 2; ++tm)
#pragma unroll
            for (int tn = 0; tn < 4; ++tn)
#pragma unroll
                for (int i = 0; i < 16; ++i)
                    Ct[(wm * 64 + tm * 32 + crow(i, h)) * CT_STRIDE + tn * 32 + r] = acc[tm][tn][i];
    }
}
DI BSrc2 make_b2(const bf16_t* Bt, long ldb, int N, int n0, int tid) {
    BSrc2 s; const int c = (tid & 7) * 8;
    int n = n0 + (tid >> 3);
    int q0 = n < N ? n : N - 1, q1 = n + 64 < N ? n + 64 : N - 1, q2 = n + 128 < N ? n + 128 : N - 1, q3 = n + 192 < N ? n + 192 : N - 1;
    s.p0 = Bt + (long)q0 * ldb + c; s.p1 = Bt + (long)q1 * ldb + c; s.p2 = Bt + (long)q2 * ldb + c; s.p3 = Bt + (long)q3 * ldb + c; return s;
}
DI const bf16_t* a_ptr(const bf16_t* base, long lda, const int* rows, int M, int m0, int i, int tid) {
    int gm = m0 + (tid >> 3) + 64 * i;
    gm = gm < M ? gm : M - 1;
    const long src = rows ? (long)rows[gm] : (long)gm;
    return base + src * lda + (tid & 7) * 8;
}
DI ASrc make_a(const bf16_t* base, long lda, const int* rows, int M, int m0, int tid) {
    ASrc A; A.a0 = a_ptr(base, lda, rows, M, m0, 0, tid); A.a1 = a_ptr(base, lda, rows, M, m0, 1, tid);
    A.a2 = a_ptr(base, lda, rows, M, m0, 2, tid); A.a3 = a_ptr(base, lda, rows, M, m0, 3, tid); return A;
}
DI BSrcBf make_bbf(const bf16_t* Bt, long ldb, int N, int n0, int tid) {
    int n = n0 + (tid >> 3); int n1 = n + 64;
    n = n < N ? n : N - 1; n1 = n1 < N ? n1 : N - 1;
    BSrcBf s; s.p0 = Bt + (long)n * ldb + (tid & 7) * 8; s.p1 = Bt + (long)n1 * ldb + (tid & 7) * 8; return s;
}
template <class RM>
DI void tconv(const float* src, long sbatch, long sld, int K, int N, bf16_t* dst, long dbatch, long ldd, int nbatch, RM rm, int lo, long gtid, long gstride,
              const float* ks0 = nullptr, const float* ks1 = nullptr) {
    const long per = (long)N * (K >> 5), total = per * nbatch;
    for (long i = gtid; i < total; i += gstride) {
        const int bi = (int)(i / per); const long rem = i - (long)bi * per;
        const int k32 = (int)(rem / N), n = (int)(rem - (long)k32 * N);
        const float* sp = src + bi * sbatch + (long)(k32 * 32) * sld + n;
        float f[32];
#pragma unroll
        for (int j = 0; j < 32; ++j) f[j] = sp[(long)j * sld];
        if (lo) {
#pragma unroll
            for (int j = 0; j < 32; ++j) f[j] = f[j] - bf2f(f2bf(f[j]));
        }
        if (ks0) {
            const float* kp = (k32 * 32 < 512) ? ks0 + k32 * 32 : ks1 + k32 * 32 - 512;
#pragma unroll
            for (int j = 0; j < 32; ++j) f[j] *= kp[j];
        }
        bf16_t* dp = dst + bi * dbatch + (long)rm(n) * ldd + k32 * 32;
#pragma unroll
        for (int q = 0; q < 4; ++q) {
            u32x4 o; o.x = pk2(f[8 * q], f[8 * q + 1]); o.y = pk2(f[8 * q + 2], f[8 * q + 3]); o.z = pk2(f[8 * q + 4], f[8 * q + 5]); o.w = pk2(f[8 * q + 6], f[8 * q + 7]);
            *(u32x4*)(dp + 8 * q) = o;
        }
    }
}
struct RowId { DI int operator()(int n) const { return n; } };
struct RowGU { int tn; DI int operator()(int n) const { return (n >> 6) * 128 + ((n >> 5) & 1) * 64 + tn * 32 + (n & 31); } };
struct RowOff { int off; DI int operator()(int n) const { return n + off; } };

DI void cpow(float lr, float li, float step, int tau, float& re, float& im) {
    const float mag = expf(lr * step * (float)tau);
    const double ang = (double)li * (double)step * (double)tau;
    const double k = rint(ang * 0.15915494309189535);
    const float red = (float)(ang - k * 6.283185307179586);
    float sn, cs; sn = sinf(red); cs = cosf(red);
    re = mag * cs; im = mag * sn;
}
DI void phase0(const Params& P, unsigned char* lds_raw, int tid, int xmode = 0) {
    unsigned char* ws = P.ws;
    const int lane = tid & 63, wv = tid >> 6;
    const int G = gridDim.x, bid = blockIdx.x;
    if (xmode == 0 || xmode == 1) {
        const float* x = P.in[0]; const float* g1 = P.in[1];
        bf16_t* xn = (bf16_t*)(ws + OFF_XN);
        for (int row0 = (bid * 8 + wv) * 2; row0 < T; row0 += G * 16) {
            f32x4 v[2][4]; float s0 = 0.f, s1 = 0.f;
#pragma unroll
            for (int q = 0; q < 2; ++q) {
                const f32x4* xr = (const f32x4*)(x + (size_t)(row0 + q) * 1024) + lane;
#pragma unroll
                for (int j = 0; j < 4; ++j) v[q][j] = xr[64 * j];
            }
#pragma unroll
            for (int j = 0; j < 4; ++j) {
                s0 += v[0][j].x * v[0][j].x + v[0][j].y * v[0][j].y + v[0][j].z * v[0][j].z + v[0][j].w * v[0][j].w;
                s1 += v[1][j].x * v[1][j].x + v[1][j].y * v[1][j].y + v[1][j].z * v[1][j].z + v[1][j].w * v[1][j].w;
            }
            s0 = wave_sum(s0); s1 = wave_sum(s1);
            const float rs0 = rsqrtf(s0 * (1.f / 1024.f) + EPS), rs1 = rsqrtf(s1 * (1.f / 1024.f) + EPS);
#pragma unroll
            for (int j = 0; j < 4; ++j) {
                const f32x4 g = ((const f32x4*)g1)[lane + 64 * j];
                u32x2 o; o.x = pk2(v[0][j].x * rs0 * g.x, v[0][j].y * rs0 * g.y); o.y = pk2(v[0][j].z * rs0 * g.z, v[0][j].w * rs0 * g.w);
                *(u32x2*)(xn + (size_t)row0 * 1024 + lane * 4 + 256 * j) = o;
                o.x = pk2(v[1][j].x * rs1 * g.x, v[1][j].y * rs1 * g.y); o.y = pk2(v[1][j].z * rs1 * g.z, v[1][j].w * rs1 * g.w);
                *(u32x2*)(xn + (size_t)(row0 + 1) * 1024 + lane * 4 + 256 * j) = o;
            }
        }
    }
    if (xmode == 0 || xmode == 2) {
        const float* lam_re = P.in[3]; const float* lam_im = P.in[4]; const float* log_step = P.in[5];
        const float* b_re = P.in[6]; const float* b_im = P.in[7]; const float* c_re = P.in[8]; const float* c_im = P.in[9];
        float* pw_re = (float*)lds_raw;
        float* pw_im = pw_re + 64 * 33;
        float* bb_re = pw_im + 64 * 33;
        float* bb_im = bb_re + 1024;
        float* cc_re = bb_im + 1024;
        float* cc_im = cc_re + 64;
        float* Km = cc_im + 64;
        bf16_t* TgT = (bf16_t*)(ws + OFF_TGT); bf16_t* EgT = (bf16_t*)(ws + OFF_EGT); bf16_t* FgT = (bf16_t*)(ws + OFF_FGT);
        float* lam32 = (float*)(ws + OFF_LAM32);
        for (int u = bid; u < 512; u += G) {
            const int g = u >> 4, h = u & 15;
            const float step = expf(log_step[g]);
            __syncthreads();
            if (tid < 64) {
                const int p = tid;
                float ar, ai; cpow(lam_re[g * 64 + p], lam_im[g * 64 + p], step, 1, ar, ai);
                float zr = 1.f, zi = 0.f;
                for (int tau = 0; tau <= 32; ++tau) {
                    pw_re[p * 33 + tau] = zr; pw_im[p * 33 + tau] = zi;
                    const float nr = zr * ar - zi * ai, ni = zr * ai + zi * ar; zr = nr; zi = ni;
                }
                cc_re[tid] = c_re[(g * 16 + h) * 64 + tid]; cc_im[tid] = c_im[(g * 16 + h) * 64 + tid];
            }
            __syncthreads();
            for (int idx = tid; idx < 1024; idx += NTHREADS) {
                const int p = idx >> 4, hp = idx & 15;
                const float lr = lam_re[g * 64 + p], li = lam_im[g * 64 + p];
                const float re = pw_re[p * 33 + 1], im = pw_im[p * 33 + 1];
                const float nr = re - 1.f, ni = im, den = lr * lr + li * li;
                const float qr = (nr * lr + ni * li) / den, qi = (ni * lr - nr * li) / den;
                const float br = b_re[(g * 64 + p) * 16 + hp], bi = b_im[(g * 64 + p) * 16 + hp];
                bb_re[idx] = qr * br - qi * bi; bb_im[idx] = qr * bi + qi * br;
            }
            __syncthreads();
            {
                const int tau = tid >> 4, hp = tid & 15;
                float s = 0.f;
                for (int p = 0; p < 64; ++p) {
                    const float zr = cc_re[p] * pw_re[p * 33 + tau] - cc_im[p] * pw_im[p * 33 + tau];
                    const float zi = cc_re[p] * pw_im[p * 33 + tau] + cc_im[p] * pw_re[p * 33 + tau];
                    s += zr * bb_re[p * 16 + hp] - zi * bb_im[p * 16 + hp];
                }
                Km[tid] = s;
            }
            __syncthreads();
            for (int it = tid; it < 2048; it += NTHREADS) {
                const int t = it >> 6, q = it & 63, k = q >> 1, hp0 = (q & 1) * 8;
                u32x4 o = {0u, 0u, 0u, 0u};
                if (t >= k) { const float* km = Km + (t - k) * 16 + hp0; o.x = pk2(km[0], km[1]); o.y = pk2(km[2], km[3]); o.z = pk2(km[4], km[5]); o.w = pk2(km[6], km[7]); }
                *(u32x4*)(TgT + ((size_t)g * 512 + t * 16 + h) * 512 + q * 8) = o;
            }
            {
                const int t = tid >> 4, c = tid & 15;
                float f[8];
#pragma unroll
                for (int j = 0; j < 4; ++j) {
                    const int p = 4 * c + j;
                    const float zr = cc_re[p] * pw_re[p * 33 + t + 1] - cc_im[p] * pw_im[p * 33 + t + 1];
                    const float zi = cc_re[p] * pw_im[p * 33 + t + 1] + cc_im[p] * pw_re[p * 33 + t + 1];
                    f[2 * j] = zr; f[2 * j + 1] = -zi;
                }
                u32x4 o; o.x = pk2(f[0], f[1]); o.y = pk2(f[2], f[3]); o.z = pk2(f[4], f[5]); o.w = pk2(f[6], f[7]);
                *(u32x4*)(FgT + ((size_t)g * 512 + t * 16 + h) * 128 + c * 8) = o;
            }
            {
                const int nl = tid >> 6, q = tid & 63, p = 4 * h + (nl >> 1), ri = nl & 1, k = q >> 1, hp0 = (q & 1) * 8;
                const float ar = pw_re[p * 33 + 31 - k], ai = pw_im[p * 33 + 31 - k];
                float f[8];
#pragma unroll
                for (int j = 0; j < 8; ++j) {
                    const float br = bb_re[p * 16 + hp0 + j], bi = bb_im[p * 16 + hp0 + j];
                    f[j] = ri ? (ar * bi + ai * br) : (ar * br - ai * bi);
                }
                u32x4 o; o.x = pk2(f[0], f[1]); o.y = pk2(f[2], f[3]); o.z = pk2(f[4], f[5]); o.w = pk2(f[6], f[7]);
                *(u32x4*)(EgT + ((size_t)g * 128 + 2 * p + ri) * 512 + q * 8) = o;
            }
            if (h == 0 && tid < 64) { lam32[(g * 64 + tid) * 2] = pw_re[tid * 33 + 32]; lam32[(g * 64 + tid) * 2 + 1] = pw_im[tid * 33 + 32]; }
        }
        __syncthreads();
    }
    if (xmode == 0 || xmode == 3) {
        float* red = (float*)lds_raw;
        float* biasp = (float*)(ws + OFF_BIASP);
        for (int u = bid; u < 32; u += G) {
            const int kv = u >> 4, part = u & 15;
            const float* pos = P.in[kv ? 18 : 17]; const float* w1 = P.in[kv ? 21 : 19];
            const int n = tid & 255, half = tid >> 8;
            float s = 0.f;
            const int k0 = part * 128 + half * 64;
            for (int kk = k0; kk < k0 + 64; ++kk) s += pos[kk] * w1[(size_t)kk * 256 + n];
            __syncthreads();
            red[tid] = s;
            __syncthreads();
            if (tid < 256) biasp[(kv * 16 + part) * 256 + tid] = red[tid] + red[tid + 256];
        }
        __syncthreads();
    }
    if (xmode == 0 || xmode == 4) {
        const long gt = (long)bid * NTHREADS + tid, gs = (long)G * NTHREADS;
        tconv(P.in[2], 0, 1816, 1024, 1816, (bf16_t*)(ws + OFF_WINT), 0, 1024, 1, RowId(), 0, gt, gs);
        tconv(P.in[11], 0, 512, 512, 512, (bf16_t*)(ws + OFF_WGLUT), 0, 512, 1, RowId(), 0, gt, gs);
        tconv(P.in[19], (long)1024 * 256, 256, 1024, 256, (bf16_t*)(ws + OFF_WC1T), (long)256 * 1024, 1024, 2, RowId(), 0, gt, gs);
        tconv(P.in[21], (long)1024 * 256, 256, 1024, 256, (bf16_t*)(ws + OFF_WC1T) + (size_t)2 * 256 * 1024, (long)256 * 1024, 1024, 2, RowId(), 0, gt, gs);
        tconv(P.in[25], 0, 1024, 1024, 1024, (bf16_t*)(ws + OFF_WOUTT), 0, 1024, 1, RowId(), 0, gt, gs, P.in[23], P.in[24]);
        { float* ssq = (float*)(ws + OFF_SSQ); for (long i = gt; i < (long)T * 2; i += gs) ssq[i] = 0.f; }
        tconv(P.in[27], 0, 4, 1024, 4, (bf16_t*)(ws + OFF_WRT), 0, 1024, 1, RowId(), 0, gt, gs);
        tconv(P.in[29], 0, 32, 1024, 32, (bf16_t*)(ws + OFF_WRT), 0, 1024, 1, RowOff{4}, 0, gt, gs);
        tconv(P.in[27], 0, 4, 1024, 4, (bf16_t*)(ws + OFF_WRT) + 40 * 1024, 0, 1024, 1, RowId(), 1, gt, gs);
        tconv(P.in[29], 0, 32, 1024, 32, (bf16_t*)(ws + OFF_WRT) + 40 * 1024, 0, 1024, 1, RowOff{4}, 1, gt, gs);
    }
}

DI void epi_inproj(const Params& P, const float* Ct, int m0, int nt, int tid) {
    unsigned char* ws = P.ws;
    const int n0 = nt * 128;
    if (n0 < 512) {
        bf16_t* U = (bf16_t*)(ws + OFF_U);
        for (int it = tid; it < 2048; it += NTHREADS) {
            const int row = it >> 3, gi = it & 7;
            const float* s = Ct + row * CT_STRIDE + gi * 16;
            u32x4 o0, o1;
            o0.x = pk2(s[0], s[1]); o0.y = pk2(s[2], s[3]); o0.z = pk2(s[4], s[5]); o0.w = pk2(s[6], s[7]);
            o1.x = pk2(s[8], s[9]); o1.y = pk2(s[10], s[11]); o1.z = pk2(s[12], s[13]); o1.w = pk2(s[14], s[15]);
            bf16_t* d = U + ((size_t)((n0 >> 4) + gi) * T + m0 + row) * 16;
            *(u32x4*)d = o0; *(u32x4*)(d + 8) = o1;
        }
    } else if (n0 < 1792) {
        const int row = tid & 255, seg = tid >> 8;
        const int grow = m0 + row, b = grow >> 12, l = grow & 4095;
        const float* s = Ct + row * CT_STRIDE + seg * 64;
        const int kind = n0 < 1024 ? 0 : 1 + ((n0 - 1024) >> 7);
        if (kind == 4 || kind == 6) {
            bf16_t* dst = (bf16_t*)(ws + (kind == 4 ? OFF_VST : OFF_VWT));
            const int rl = tid & 63, cq = tid >> 6;
#pragma unroll 1
            for (int rr = 0; rr < 4; ++rr) {
                const int r2 = rl + 64 * rr, gr = m0 + r2, b2 = gr >> 12, l2 = gr & 4095;
#pragma unroll
                for (int cc = 0; cc < 16; ++cc) {
                    const int col = cq * 16 + cc, g = col >> 6, d = col & 63;
                    dst[((size_t)((b2 * 2 + g) * 64 + d)) * 4096 + l2] = (bf16_t)f2bf(Ct[r2 * CT_STRIDE + col]);
                }
            }
        } else {
            float scale = 1.f; const float* gw = nullptr; bf16_t* dst;
            if (kind == 0) { gw = P.in[13]; dst = (bf16_t*)(ws + OFF_QN) + (size_t)grow * 512 + (n0 - 512) + seg * 64; scale = 0.125f * 1.4426950408889634f; }
            else {
                const size_t off = kind == 1 ? OFF_KC : kind == 2 ? OFF_VC : kind == 3 ? OFF_KSN : OFF_KWN;
                dst = (bf16_t*)(ws + off) + ((size_t)((b * 2 + seg) * 4096 + l)) * 64;
                if (kind == 3) gw = P.in[15]; else if (kind == 5) gw = P.in[16];
            }
            float rs = 1.f;
            if (gw) {
                float ss = 0.f;
#pragma unroll
                for (int c4 = 0; c4 < 16; ++c4) { const f32x4 v = *(const f32x4*)(s + c4 * 4); ss += v.x * v.x + v.y * v.y + v.z * v.z + v.w * v.w; }
                rs = rsqrtf(ss * (1.f / 64.f) + EPS) * scale;
            }
#pragma unroll
            for (int c8 = 0; c8 < 8; ++c8) {
                f32x4 v0 = *(const f32x4*)(s + c8 * 8), v1 = *(const f32x4*)(s + c8 * 8 + 4);
                if (gw) {
                    const f32x4 g0 = *(const f32x4*)(gw + c8 * 8), g1 = *(const f32x4*)(gw + c8 * 8 + 4);
                    v0 = v0 * g0 * rs; v1 = v1 * g1 * rs;
                }
                u32x4 o; o.x = pk2(v0.x, v0.y); o.y = pk2(v0.z, v0.w); o.z = pk2(v1.x, v1.y); o.w = pk2(v1.z, v1.w);
                *(u32x4*)(dst + c8 * 8) = o;
            }
        }
    } else {
        if (tid < 256) {
            float* gates = (float*)(ws + OFF_GATES) + (size_t)(m0 + tid) * 24;
            const float* s = Ct + tid * CT_STRIDE;
#pragma unroll
            for (int c = 0; c < 24; ++c) gates[c] = sigmoidf(s[c]);
        }
    }
}
DI void phase1(const Params& P, unsigned char* lds_raw, int tid, int xmode = 0) {
    bf16_t* lds = (bf16_t*)lds_raw; float* Ct = (float*)lds_raw;
    const bf16_t* xn = (const bf16_t*)(P.ws + OFF_XN);
    const bf16_t* WinT = (const bf16_t*)(P.ws + OFF_WINT);
    for (int u = vbid(); u < 64 * 8; u += gridDim.x) {
        const int mt = u >> 3, nt2 = u & 7, m0 = mt * 256;
        f32x16 acc[2][4]; zero_acc2(acc);
        const ASrc A = make_a(xn, 1024, nullptr, T, m0, tid);
        const BSrc2 bs = make_b2(WinT, 1024, DIN, nt2 * 256, tid);
        __syncthreads();
        if (xmode != 4) gemm_mainloop2(acc, A, bs, 1024, lds, tid);
#pragma unroll 1
        for (int half = 0; half < 2; ++half) {
            const int nt = nt2 * 2 + half;
            if (nt * 128 >= DIN) break;
            if (xmode == 5) { if (tid == 0 && acc[0][0][0] + acc[1][3][5] + acc[0][1][1] + acc[1][2][7] + acc[0][2][3] + acc[0][3][9] + acc[1][0][4] + acc[1][1][2] == 12345.f) ((float*)P.ws)[1] = 1.f; continue; }
            dump_acc2(acc, Ct, tid, half);
            __syncthreads();
            epi_inproj(P, Ct, m0, nt, tid);
            __syncthreads();
        }
    }
    __syncthreads();
}

DI void st_wt8(void* p, u32x2 v) { asm volatile("global_store_dwordx2 %0, %1, off sc1\n\ts_nop 1" :: "v"(p), "v"(v) : "memory"); }
DI void st_wt16f(void* p, f32x4 v) { asm volatile("global_store_dwordx4 %0, %1, off sc1\n\ts_nop 1" :: "v"(p), "v"(v) : "memory"); }
DI void unit_signal(unsigned* ctr, int tid) {
    asm volatile("s_waitcnt vmcnt(0)" ::: "memory");
    __syncthreads();
    if (tid == 0) __hip_atomic_fetch_add(ctr, 1u, __ATOMIC_RELAXED, __HIP_MEMORY_SCOPE_AGENT);
}
DI void unit_wait2(unsigned* ctr, unsigned target, unsigned* ctr2, unsigned target2, int tid) {
    if (tid == 0) {
        unsigned sp = 0;
        while (__hip_atomic_load(ctr, __ATOMIC_RELAXED, __HIP_MEMORY_SCOPE_AGENT) < target) { __builtin_amdgcn_s_sleep(4); if (++sp > (1u << 22)) break; }
        if (ctr2) { sp = 0; while (__hip_atomic_load(ctr2, __ATOMIC_RELAXED, __HIP_MEMORY_SCOPE_AGENT) < target2) { __builtin_amdgcn_s_sleep(4); if (++sp > (1u << 22)) break; } }
        __builtin_amdgcn_fence(__ATOMIC_ACQUIRE, "agent");
        asm volatile("s_waitcnt vmcnt(0)" ::: "memory");
    }
    __syncthreads();
}
DI void unit_wait(unsigned* ctr, unsigned target, int tid) {
    if (tid == 0) {
        unsigned sp = 0;
        while (__hip_atomic_load(ctr, __ATOMIC_RELAXED, __HIP_MEMORY_SCOPE_AGENT) < target) { __builtin_amdgcn_s_sleep(4); if (++sp > (1u << 22)) break; }
        __builtin_amdgcn_fence(__ATOMIC_ACQUIRE, "agent");
        asm volatile("s_waitcnt vmcnt(0)" ::: "memory");
    }
    __syncthreads();
}
DI void mlp2_unit(const Params& P, unsigned char* lds_raw, int u, int tid) {
    unsigned char* ws = P.ws;
    {
        unit_wait((unsigned*)(ws + OFF_CTL) + CW_PDONE + (u >> 3), 4u, tid);
            const int idx = u, rc = idx & 7, bg = (idx >> 3) & 7, kv = idx >> 6;
            float* Hs = (float*)lds_raw;
            const float* Pt = (const float*)(ws + OFF_P) + ((size_t)((kv * 8 + bg) * 2 + 0) * 256) * 256;
            const float* Pb = (const float*)(ws + OFF_P) + ((size_t)((kv * 8 + bg) * 2 + 1) * 256) * 256;
            const float* biasp = (const float*)(ws + OFF_BIASP) + kv * 16 * 256;
            const int n = tid & 255;
            float bias = 0.f;
#pragma unroll
            for (int pp = 0; pp < 16; ++pp) bias += biasp[pp * 256 + n];
            for (int it = tid; it < 8192; it += NTHREADS) {
                const int rr = it >> 8, j = rc * 32 + rr;
                float hv = 0.f;
                if (j < 255) hv = gelu_tanh(Pt[j * 256 + n] + Pb[(j + 1) * 256 + n] + bias);
                Hs[rr * 256 + n] = hv;
            }
            __syncthreads();
            const int rr = tid >> 4, dq = tid & 15, j = rc * 32 + rr;
            const float* w2 = P.in[kv ? 22 : 20];
            f32x4 a = {0.f, 0.f, 0.f, 0.f};
            for (int k = 0; k < 256; ++k) {
                const float hv = Hs[rr * 256 + k];
                const f32x4 w = *(const f32x4*)(w2 + k * 64 + dq * 4);
                a = a + w * hv;
            }
            if (kv == 0) {
                float ss = a.x * a.x + a.y * a.y + a.z * a.z + a.w * a.w;
                ss += __shfl_xor(ss, 1); ss += __shfl_xor(ss, 2); ss += __shfl_xor(ss, 4); ss += __shfl_xor(ss, 8);
                const float rs = rsqrtf(ss * (1.f / 64.f) + EPS);
                const f32x4 g = *(const f32x4*)(P.in[14] + dq * 4);
                u32x2 o; o.x = pk2(a.x * rs * g.x, a.y * rs * g.y); o.y = pk2(a.z * rs * g.z, a.w * rs * g.w);
                if (j == 255) { o.x = 0u; o.y = 0u; }
                *(u32x2*)((bf16_t*)(ws + OFF_KCMP) + ((size_t)bg * 256 + j) * 64 + dq * 4) = o;
            } else {
                bf16_t* vt = (bf16_t*)(ws + OFF_VCMPT) + (size_t)bg * 64 * 256;
                if (j == 255) a = (f32x4){0.f, 0.f, 0.f, 0.f};
                vt[(dq * 4 + 0) * 256 + j] = (bf16_t)f2bf(a.x); vt[(dq * 4 + 1) * 256 + j] = (bf16_t)f2bf(a.y);
                vt[(dq * 4 + 2) * 256 + j] = (bf16_t)f2bf(a.z); vt[(dq * 4 + 3) * 256 + j] = (bf16_t)f2bf(a.w);
            }
    }
    __syncthreads();
}
DI void phase2(const Params& P, unsigned char* lds_raw, int tid) {
    bf16_t* lds = (bf16_t*)lds_raw; float* Ct = (float*)lds_raw;
    unsigned char* ws = P.ws;
    {
        const int G = gridDim.x, nh = G > 128 ? G - 128 : G, hid = G > 128 ? vbid() - 128 : vbid();
        if (hid >= 0) {
            const long gt = (long)hid * NTHREADS + tid, gs = (long)nh * NTHREADS;
            tconv(P.in[31], (long)1024 * 256, 256, 1024, 256, (bf16_t*)(ws + OFF_WGUT), (long)512 * 1024, 1024, 32, RowGU{0}, 0, gt, gs);
            tconv(P.in[32], (long)1024 * 256, 256, 1024, 256, (bf16_t*)(ws + OFF_WGUT), (long)512 * 1024, 1024, 32, RowGU{1}, 0, gt, gs);
            tconv(P.in[33], (long)256 * 1024, 1024, 256, 1024, (bf16_t*)(ws + OFF_WDT), (long)1024 * 256, 256, 32, RowId(), 0, gt, gs);
        }
    }
    for (int u = vbid(); u < 128; u += gridDim.x) {
        f32x16 acc[2][2]; zero_acc(acc);
        if (u < 64) {
            const int g = u >> 1, mt = u & 1, m0 = mt * 256;
            const bf16_t* A = (const bf16_t*)(ws + OFF_U) + (size_t)g * T * 16;
            const ASrc As = make_a(A, 512, nullptr, 512, m0, tid);
            const BSrcBf bs = make_bbf((const bf16_t*)(ws + OFF_EGT) + (size_t)g * 128 * 512, 512, 128, 0, tid);
            __syncthreads();
            gemm_mainloop(acc, As, bs, 512, lds, tid);
            dump_acc(acc, Ct, tid);
            __syncthreads();
            if (tid < 128) {
                const int bb = tid >> 6, p = tid & 63;
                const float* lam32 = (const float*)(ws + OFF_LAM32) + (g * 64 + p) * 2;
                const float ar = lam32[0], ai = lam32[1];
                float sr = 0.f, si = 0.f;
                float* zp = Ct + (bb * 128) * CT_STRIDE + 2 * p;
                for (int c = 0; c < 128; ++c) {
                    const float zr = zp[c * CT_STRIDE], zi = zp[c * CT_STRIDE + 1];
                    zp[c * CT_STRIDE] = sr; zp[c * CT_STRIDE + 1] = si;
                    const float nr = ar * sr - ai * si + zr, ni = ar * si + ai * sr + zi;
                    sr = nr; si = ni;
                }
            }
            __syncthreads();
            bf16_t* Sin = (bf16_t*)(ws + OFF_SIN) + ((size_t)g * 512 + m0) * 128;
            for (int it = tid; it < 256 * 16; it += NTHREADS) {
                const int row = it >> 4, c8 = it & 15;
                const float* sp = Ct + row * CT_STRIDE + c8 * 8;
                u32x4 o; o.x = pk2(sp[0], sp[1]); o.y = pk2(sp[2], sp[3]); o.z = pk2(sp[4], sp[5]); o.w = pk2(sp[6], sp[7]);
                *(u32x4*)(Sin + row * 128 + c8 * 8) = o;
            }
        } else {
            const int idx = u - 64, nt = idx & 1, part = (idx >> 1) & 1, bg = (idx >> 2) & 7, kv = idx >> 5;
            const bf16_t* A = (const bf16_t*)(ws + (kv ? OFF_VC : OFF_KC)) + (size_t)bg * 4096 * 64;
            const ASrc As = make_a(A, 1024, nullptr, 256, 0, tid);
            const BSrcBf bs = make_bbf((const bf16_t*)(ws + OFF_WC1T) + (size_t)(kv * 2 + part) * 256 * 1024, 1024, 256, nt * 128, tid);
            __syncthreads();
            gemm_mainloop(acc, As, bs, 1024, lds, tid);
            dump_acc(acc, Ct, tid);
            __syncthreads();
            float* Pp = (float*)(ws + OFF_P) + ((size_t)((kv * 8 + bg) * 2 + part) * 256) * 256 + nt * 128;
            for (int it = tid; it < 256 * 32; it += NTHREADS) {
                const int row = it >> 5, c4 = it & 31;
                st_wt16f(Pp + row * 256 + c4 * 4, *(const f32x4*)(Ct + row * CT_STRIDE + c4 * 4));
            }
            unit_signal((unsigned*)(ws + OFF_CTL) + CW_PDONE + kv * 8 + bg, tid);
        }
    }
    for (int u = vbid(); u < 128; u += gridDim.x) mlp2_unit(P, lds_raw, u, tid);
    __syncthreads();
}

DI void s5_main_unit(const Params& P, unsigned char* lds_raw, int u, int tid) {
    bf16_t* lds = (bf16_t*)lds_raw; float* Ct = (float*)lds_raw;
    unsigned char* ws = P.ws;
    const int nt = u & 3, mt = (u >> 2) & 1, g = u >> 3, m0 = mt * 256, n0 = nt * 128;
    f32x16 acc[2][2]; zero_acc(acc);
    const bf16_t* Ug = (const bf16_t*)(ws + OFF_U) + (size_t)g * T * 16;
    {
        const ASrc As = make_a(Ug, 512, nullptr, 512, m0, tid);
        const BSrcBf bs = make_bbf((const bf16_t*)(ws + OFF_TGT) + (size_t)g * 512 * 512, 512, 512, n0, tid);
        __syncthreads();
        gemm_mainloop(acc, As, bs, 512, lds, tid);
    }
    {
        const bf16_t* S = (const bf16_t*)(ws + OFF_SIN) + (size_t)g * 512 * 128;
        const ASrc As = make_a(S, 128, nullptr, 512, m0, tid);
        const BSrcBf bs = make_bbf((const bf16_t*)(ws + OFF_FGT) + (size_t)g * 512 * 128, 128, 512, n0, tid);
        gemm_mainloop(acc, As, bs, 128, lds, tid);
    }
    dump_acc(acc, Ct, tid);
    __syncthreads();
    const float* dsk = P.in[10] + g * 16;
    bf16_t* y1 = (bf16_t*)(ws + OFF_Y1);
    for (int it = tid; it < 2048; it += NTHREADS) {
        const int row = it >> 3, tt = it & 7;
        const int token = 32 * (m0 + row) + (n0 >> 4) + tt;
        const float* s = Ct + row * CT_STRIDE + tt * 16;
        const u32x4 u0 = *(const u32x4*)(Ug + (size_t)token * 16), u1 = *(const u32x4*)(Ug + (size_t)token * 16 + 8);
        const unsigned uw[8] = {u0.x, u0.y, u0.z, u0.w, u1.x, u1.y, u1.z, u1.w};
        unsigned ow[8];
#pragma unroll
        for (int q = 0; q < 8; ++q) {
            const float ua = bf2f(uw[q] & 0xffffu), ub = bf2f(uw[q] >> 16);
            const float ya = gelu_tanh(s[2 * q] + dsk[2 * q] * ua), yb = gelu_tanh(s[2 * q + 1] + dsk[2 * q + 1] * ub);
            ow[q] = pk2(ya, yb);
        }
        bf16_t* d = y1 + (size_t)token * 512 + g * 16;
        *(u32x4*)d = (u32x4){ow[0], ow[1], ow[2], ow[3]}; *(u32x4*)(d + 8) = (u32x4){ow[4], ow[5], ow[6], ow[7]};
    }
}

constexpr int KSTR = 72, VSTR = 68;
constexpr int KSLOT = 64 * KSTR, VSLOT = 64 * VSTR;
constexpr int AT_KBUF = 0;
constexpr int AT_VBUF = AT_KBUF + 3 * KSLOT * 2;
constexpr int VCSTR = 260;
constexpr int AT_CK   = 0;
constexpr int AT_CV   = AT_CK + 256 * KSTR * 2;
constexpr int AT_RING_END = AT_VBUF + 3 * VSLOT * 2;
constexpr int AT_CEND = AT_CV + 64 * VCSTR * 2;
constexpr int AT_IMP  = (AT_CEND > AT_RING_END ? AT_CEND : AT_RING_END);
constexpr int AT_MASK = AT_IMP + 4 * 64 * 64 * 4;
constexpr int AT_INVL = AT_MASK + 64 * 8;
constexpr int AT_END  = AT_INVL + 256 * 4;

struct KVRegs { u32x4 k; u32x4 v; };
DI void kv_load(KVRegs& r, const bf16_t* Kt, const bf16_t* Vt, long ldv, int tid) {
    r.k = *(const u32x4*)(Kt + (tid >> 3) * 64 + (tid & 7) * 8);
    r.v = *(const u32x4*)(Vt + (long)(tid >> 3) * ldv + (tid & 7) * 8);
}
DI void kv_store(const KVRegs& r, bf16_t* Kb, bf16_t* Vb, int tid) {
    *(u32x4*)(Kb + (tid >> 3) * KSTR + (tid & 7) * 8) = r.k;
    u32x2 lo, hi; lo.x = r.v.x; lo.y = r.v.y; hi.x = r.v.z; hi.y = r.v.w;
    *(u32x2*)(Vb + (tid >> 3) * VSTR + (tid & 7) * 8) = lo;
    *(u32x2*)(Vb + (tid >> 3) * VSTR + (tid & 7) * 8 + 4) = hi;
}
DI bf16x8 pack8(const f32x16& x, int s) {
    u32x4 p;
    p.x = pk2(x[8 * s], x[8 * s + 1]); p.y = pk2(x[8 * s + 2], x[8 * s + 3]); p.z = pk2(x[8 * s + 4], x[8 * s + 5]); p.w = pk2(x[8 * s + 6], x[8 * s + 7]);
    return __builtin_bit_cast(bf16x8, p);
}
DI void qk_tile(f32x16 (&S)[2], const bf16_t* Kb, const bf16x8 (&qf)[4], int r, int h, bool edge, int d0, int dmax, int pm) {
    const int NEGB = __builtin_bit_cast(int, -1e30f);
    if (edge) {
#pragma unroll
        for (int kh = 0; kh < 2; ++kh)
#pragma unroll
            for (int i = 0; i < 16; ++i) {
                const int d = d0 - (32 * kh + (i & 3) + 8 * (i >> 2));
                const int m = (d >> 31) | ((dmax - d) >> 31) | pm;
                S[kh][i] = __builtin_bit_cast(float, m & NEGB);
            }
    } else {
        const float iv = __builtin_bit_cast(float, pm & NEGB);
#pragma unroll
        for (int kh = 0; kh < 2; ++kh)
#pragma unroll
            for (int i = 0; i < 16; ++i) S[kh][i] = iv;
    }
    bf16x8 kf[2][4];
#pragma unroll
    for (int kh = 0; kh < 2; ++kh)
#pragma unroll
        for (int s = 0; s < 4; ++s) kf[kh][s] = *(const bf16x8*)(Kb + (32 * kh + r) * KSTR + 16 * s + 8 * h);
    asm volatile("" ::: "memory");
#pragma unroll
    for (int s = 0; s < 4; ++s)
#pragma unroll
        for (int kh = 0; kh < 2; ++kh) S[kh] = MFMA32(kf[kh][s], qf[s], S[kh]);
}
#ifndef AT_X
#define AT_X 0
#endif
DI void softmax_tile(f32x16 (&S)[2], float& lsum, int ax = 0) {
    float ls = 0.f;
#pragma unroll
    for (int kh = 0; kh < 2; ++kh)
#pragma unroll
        for (int i = 0; i < 16; ++i) { const float p = (ax == 1) ? S[kh][i] * 0.001f : __builtin_amdgcn_exp2f(S[kh][i]); S[kh][i] = p; ls += p; }
    lsum += ls;
}
DI void pv_tile(f32x16 (&O)[2], const f32x16 (&Pm)[2], const bf16_t* Vb, int r, int h) {
    bf16x8 vf[2][2][2];
#pragma unroll
    for (int kh = 0; kh < 2; ++kh)
#pragma unroll
        for (int sp = 0; sp < 2; ++sp)
#pragma unroll
            for (int dh = 0; dh < 2; ++dh) {
                const bf16_t* vp = Vb + (32 * dh + r) * VSTR + 32 * kh + 16 * sp + 4 * h;
                const s16x4 lo = *(const s16x4*)vp, hi = *(const s16x4*)(vp + 8);
                vf[kh][sp][dh] = __builtin_shufflevector(lo, hi, 0, 1, 2, 3, 4, 5, 6, 7);
            }
    asm volatile("" ::: "memory");
#pragma unroll
    for (int kh = 0; kh < 2; ++kh)
#pragma unroll
        for (int sp = 0; sp < 2; ++sp) {
            const bf16x8 pf = pack8(Pm[kh], sp);
#pragma unroll
            for (int dh = 0; dh < 2; ++dh) O[dh] = MFMA32(vf[kh][sp][dh], pf, O[dh]);
        }
}
DI void pv_tile_c(f32x16 (&O)[2], const f32x16 (&Pm)[2], const bf16_t* Vc, int kt, int r, int h) {
    bf16x8 vf[2][2][2];
#pragma unroll
    for (int kh = 0; kh < 2; ++kh)
#pragma unroll
        for (int sp = 0; sp < 2; ++sp)
#pragma unroll
            for (int dh = 0; dh < 2; ++dh) {
                const bf16_t* vp = Vc + (32 * dh + r) * VCSTR + 64 * kt + 32 * kh + 16 * sp + 4 * h;
                const s16x4 lo = *(const s16x4*)vp, hi = *(const s16x4*)(vp + 8);
                vf[kh][sp][dh] = __builtin_shufflevector(lo, hi, 0, 1, 2, 3, 4, 5, 6, 7);
            }
    asm volatile("" ::: "memory");
#pragma unroll
    for (int kh = 0; kh < 2; ++kh)
#pragma unroll
        for (int sp = 0; sp < 2; ++sp) {
            const bf16x8 pf = pack8(Pm[kh], sp);
#pragma unroll
            for (int dh = 0; dh < 2; ++dh) O[dh] = MFMA32(vf[kh][sp][dh], pf, O[dh]);
        }
}
struct SeqBits { unsigned long long rem; DI int pop() { if (rem == 0ull) return -1; const int k = __builtin_ctzll(rem); rem &= rem - 1; return k; } };
struct SeqDown { int cur, lo; DI int pop() { if (cur < lo) return -1; return cur--; } };
template <int BR, class Seq>
DI void attn_stream(f32x16 (&O)[2], float& lsum, Seq seq, const bf16_t* Kg, const bf16_t* Vg, bf16_t* Kbuf, bf16_t* Vbuf,
                    const bf16x8 (&qf)[4], int qt, int tq, unsigned long long mymask, int r, int h, int tid, int ax = 0) {
#define AT_QK(SREG, T, SLOT) do { const int _t = (T); const bool _edge = (_t == qt) || (BR == 2 && _t == qt - 8); \
        const int _pm = (BR == 1) ? ((int)((mymask >> _t) & 1ull) - 1) : 0; int _d0 = tq - 64 * _t - 4 * h; asm volatile("" : "+v"(_d0)); \
        qk_tile(SREG, Kbuf + (SLOT) * KSLOT, qf, r, h, _edge, _d0, BR == 2 ? 511 : 0x3fffffff, _pm); } while (0)
    int t0 = seq.pop(), t1 = seq.pop(), t2 = seq.pop();
    KVRegs R0;
    {
        KVRegs R1;
        kv_load(R0, Kg + (size_t)t0 * 64 * 64, Vg + t0 * 64, 4096, tid);
        if (t1 >= 0) kv_load(R1, Kg + (size_t)t1 * 64 * 64, Vg + t1 * 64, 4096, tid);
        kv_store(R0, Kbuf, Vbuf, tid);
        if (t1 >= 0) kv_store(R1, Kbuf + KSLOT, Vbuf + VSLOT, tid);
    }
    __syncthreads();
    f32x16 Sc[2], Sn[2];
    AT_QK(Sc, t0, 0);
    int sl = 0;
    while (true) {
        const int s1 = sl == 2 ? 0 : sl + 1, s2 = s1 == 2 ? 0 : s1 + 1;
        if (t2 >= 0 && ax != 3 && ax < 7) kv_load(R0, Kg + (size_t)t2 * 64 * 64, Vg + t2 * 64, 4096, tid);
        if (ax == 7) { lsum += (float)t0; }
        else if (ax == 8) { if (t1 >= 0) AT_QK(Sn, t1, s1); lsum += Sn[0][0] + Sn[1][5]; }
        else if (ax == 9) { softmax_tile(Sc, lsum, 0); pv_tile(O, Sc, Vbuf + sl * VSLOT, r, h); Sn[0] = Sc[0]; Sn[1] = Sc[1]; }
        else {
        if (t1 >= 0) AT_QK(Sn, t1, s1);
        softmax_tile(Sc, lsum, ax);
        if (ax != 2) pv_tile(O, Sc, Vbuf + sl * VSLOT, r, h);
        else { O[0][0] += Sc[0][3] + Sc[1][7]; }
        }
        if (t2 >= 0 && ax < 7) kv_store(R0, Kbuf + s2 * KSLOT, Vbuf + s2 * VSLOT, tid);
        if (ax != 5 && ax < 7) __syncthreads();
        if (t1 < 0) break;
#pragma unroll
        for (int kh = 0; kh < 2; ++kh) Sc[kh] = Sn[kh];
        t0 = t1; t1 = t2; t2 = seq.pop(); sl = s1;
    }
#undef AT_QK
}

DI void attn_unit(const Params& P, unsigned char* lds_raw, int a, int tid, bool dry = false, int ax = 0) {
    unsigned char* ws = P.ws;
    const int qt = 63 - (a >> 3), bg = a & 7, b = bg >> 1, g = bg & 1;
    const int lane = tid & 63, w = tid >> 6, r = lane & 31, h = lane >> 5;
    const int hh = w >> 1, th = w & 1;
    const int t0 = qt * 64;
    const int tql = 32 * th + r;
    const int tq = t0 + tql;
    const size_t tqg = (size_t)b * 4096 + tq;
    bf16_t* Kbuf = (bf16_t*)(lds_raw + AT_KBUF);
    bf16_t* Vbuf = (bf16_t*)(lds_raw + AT_VBUF);
    float* imp = (float*)(lds_raw + AT_IMP);
    unsigned long long* selm = (unsigned long long*)(lds_raw + AT_MASK);
    float* invl = (float*)(lds_raw + AT_INVL);

    bf16x8 qf[4];
    {
        const bf16_t* qp = (const bf16_t*)(ws + OFF_QN) + tqg * 512 + g * 256 + hh * 64 + 8 * h;
#pragma unroll
        for (int s = 0; s < 4; ++s) qf[s] = *(const bf16x8*)(qp + 16 * s);
    }
    const float* gp = (const float*)(ws + OFF_GATES) + tqg * 24 + g * 12 + hh * 3;
    const float gate_c = gp[0], gate_s = gp[1], gate_w = gp[2];

    const bf16_t* Kc = (const bf16_t*)(ws + OFF_KCMP) + (size_t)bg * 256 * 64;
    const bf16_t* Vc = (const bf16_t*)(ws + OFF_VCMPT) + (size_t)bg * 64 * 256;
    int ncmp = (4 * qt + 2) / 64 + 1; if (ncmp > 4) ncmp = 4;
    u32x4 kq[4], vq[4];
#pragma unroll
    for (int i = 0; i < 4; ++i) if (i < ncmp) {
        kq[i] = *(const u32x4*)(Kc + (size_t)(64 * i + (tid >> 3)) * 64 + (tid & 7) * 8);
        vq[i] = *(const u32x4*)(Vc + (size_t)(tid >> 3) * 256 + 64 * i + (tid & 7) * 8);
    }
    __syncthreads();
    float* impw = imp + ((hh * 64 + 32 * th) * 64);
    for (int i = lane; i < 32 * 64; i += 64) impw[i] = 0.f;
    f32x16 O[2];
#pragma unroll
    for (int dh = 0; dh < 2; ++dh)
#pragma unroll
        for (int i = 0; i < 16; ++i) O[dh][i] = 0.f;
    float inv_c;
    {
        float lsum = 0.f;
        bf16_t* Kcl = (bf16_t*)(lds_raw + AT_CK); bf16_t* Vcl = (bf16_t*)(lds_raw + AT_CV);
        {
#pragma unroll
            for (int i = 0; i < 4; ++i) if (i < ncmp) {
                *(u32x4*)(Kcl + (64 * i + (tid >> 3)) * KSTR + (tid & 7) * 8) = kq[i];
                bf16_t* vd = Vcl + (tid >> 3) * VCSTR + 64 * i + (tid & 7) * 8;
                u32x2 t; t.x = vq[i].x; t.y = vq[i].y; *(u32x2*)vd = t; t.x = vq[i].z; t.y = vq[i].w; *(u32x2*)(vd + 4) = t;
            }
        }
        __syncthreads();
        int jmax = tq >= 31 ? ((tq - 31) >> 4) : -1; jmax = jmax < 254 ? jmax : 254;
        for (int kt = 0; kt < ncmp; ++kt) {
            f32x16 S[2];
            qk_tile(S, Kcl + kt * 64 * KSTR, qf, r, h, true, jmax - 64 * kt - 4 * h, 0x3fffffff, 0);
            softmax_tile(S, lsum);
            float* ir = impw + r * 64 + 16 * kt + h;
#pragma unroll
            for (int kh = 0; kh < 2; ++kh)
#pragma unroll
                for (int gq = 0; gq < 4; ++gq)
                    ir[8 * kh + 2 * gq] += (S[kh][4 * gq] + S[kh][4 * gq + 1]) + (S[kh][4 * gq + 2] + S[kh][4 * gq + 3]);
            asm volatile("s_waitcnt lgkmcnt(0)" ::: "memory");
#pragma unroll
            for (int kh = 0; kh < 2; ++kh)
#pragma unroll
                for (int gq = 0; gq < 4; ++gq) {
                    const int sl = 8 * kh + 2 * gq + 1;
                    if (16 * kt + h + sl < 64) ir[sl] += S[kh][4 * gq + 3];
                }
            asm volatile("s_waitcnt lgkmcnt(0)" ::: "memory");
            pv_tile_c(O, S, Vcl, kt, r, h);
        }
        lsum += __shfl_xor(lsum, 32);
        inv_c = lsum > 0.f ? 1.f / lsum : 0.f;
        if (h == 0) invl[hh * 64 + tql] = inv_c;
    }
    __syncthreads();
    {
        const int cur = qt;
        const bool forced = (lane == 0) || (lane == cur) || (lane == cur - 1);
        const bool valid = lane <= cur;
        unsigned key[8]; unsigned thr[8];
#pragma unroll
        for (int i = 0; i < 8; ++i) {
            const int tl = w * 8 + i;
            const float v = (imp[(0 * 64 + tl) * 64 + lane] * invl[tl] + imp[(1 * 64 + tl) * 64 + lane] * invl[64 + tl]) + (imp[(2 * 64 + tl) * 64 + lane] * invl[128 + tl] + imp[(3 * 64 + tl) * 64 + lane] * invl[192 + tl]);
            key[i] = forced ? 0xFFFFFFFFu : (valid ? __builtin_bit_cast(unsigned, v) : 0u);
            thr[i] = 0u;
        }
#pragma unroll 1
        for (int bit = 30; bit >= 0; --bit) {
#pragma unroll
            for (int i = 0; i < 8; ++i) {
                const unsigned cand = thr[i] | (1u << bit);
                if (__popcll(__ballot(key[i] >= cand)) >= 16) thr[i] = cand;
            }
        }
#pragma unroll
        for (int i = 0; i < 8; ++i) {
            const int tl = w * 8 + i;
            const unsigned long long gtm = __ballot(key[i] > thr[i]), eqm = __ballot(key[i] == thr[i]);
            const int need = 16 - __popcll(gtm);
            const bool sel = (key[i] > thr[i]) || ((key[i] == thr[i]) && (__popcll(eqm & ((1ull << lane) - 1ull)) < need));
            const unsigned long long mask = __ballot(sel);
            if (lane == 0) selm[tl] = mask;
        }
    }
    __syncthreads();
    float* accw = imp + (w * 32) * 64 + lane;
    {
        const float g_cmp = gate_c * inv_c;
#pragma unroll
        for (int dh = 0; dh < 2; ++dh)
#pragma unroll
            for (int i = 0; i < 16; ++i) accw[(dh * 16 + i) * 64] = g_cmp * O[dh][i];
    }
    const unsigned long long mymask = selm[tql];
    unsigned long long ormask = selm[lane];
#pragma unroll
    for (int o = 1; o < 64; o <<= 1) ormask |= __shfl_xor(ormask, o);
    ormask &= (qt >= 63) ? ~0ull : ((1ull << (qt + 1)) - 1ull);
    ormask |= 1ull;
    {
        const bf16_t* Ks = (const bf16_t*)(ws + OFF_KSN) + (size_t)bg * 4096 * 64;
        const bf16_t* Vs = (const bf16_t*)(ws + OFF_VST) + (size_t)bg * 64 * 4096;
#pragma unroll
        for (int dh = 0; dh < 2; ++dh)
#pragma unroll
            for (int i = 0; i < 16; ++i) O[dh][i] = 0.f;
        float l = 0.f;
        if (ax != 4) attn_stream<1>(O, l, SeqBits{ormask}, Ks, Vs, Kbuf, Vbuf, qf, qt, tq, mymask, r, h, tid, ax); else l = 1.f;
        l += __shfl_xor(l, 32);
        const float sc = gate_s / l;
#pragma unroll
        for (int dh = 0; dh < 2; ++dh)
#pragma unroll
            for (int i = 0; i < 16; ++i) accw[(dh * 16 + i) * 64] += sc * O[dh][i];
    }
    {
        const bf16_t* Kw = (const bf16_t*)(ws + OFF_KWN) + (size_t)bg * 4096 * 64;
        const bf16_t* Vw = (const bf16_t*)(ws + OFF_VWT) + (size_t)bg * 64 * 4096;
#pragma unroll
        for (int dh = 0; dh < 2; ++dh)
#pragma unroll
            for (int i = 0; i < 16; ++i) O[dh][i] = 0.f;
        float l = 0.f;
        if (ax != 4) attn_stream<2>(O, l, SeqDown{qt, qt >= 8 ? qt - 8 : 0}, Kw, Vw, Kbuf, Vbuf, qf, qt, tq, 0ull, r, h, tid, ax); else l = 1.f;
        l += __shfl_xor(l, 32);
        const float sc = gate_w / l;
        bf16_t* dst = (bf16_t*)(ws + OFF_XN) + tqg * 1024 + 512 + g * 256 + hh * 64;
        float sq = 0.f;
#pragma unroll
        for (int dh = 0; dh < 2; ++dh)
#pragma unroll
            for (int gq = 0; gq < 4; ++gq) {
                const float o0 = accw[(dh * 16 + 4 * gq + 0) * 64] + sc * O[dh][4 * gq + 0];
                const float o1 = accw[(dh * 16 + 4 * gq + 1) * 64] + sc * O[dh][4 * gq + 1];
                const float o2 = accw[(dh * 16 + 4 * gq + 2) * 64] + sc * O[dh][4 * gq + 2];
                const float o3 = accw[(dh * 16 + 4 * gq + 3) * 64] + sc * O[dh][4 * gq + 3];
                u32x2 o; o.x = pk2(o0, o1); o.y = pk2(o2, o3);
                if (ax == 0 || o.x == 0x12345678u) *(u32x2*)(dst + 32 * dh + 8 * gq + 4 * h) = o;
                sq += (o0 * o0 + o1 * o1) + (o2 * o2 + o3 * o3);
            }
        sq += __shfl_xor(sq, 32);
        if (h == 0 && !dry) __hip_atomic_fetch_add((float*)(ws + OFF_SSQ) + tqg * 2 + 1, sq, __ATOMIC_RELAXED, __HIP_MEMORY_SCOPE_AGENT);
    }
}
DI void phase4(const Params& P, unsigned char* lds_raw, int tid, int xmode = 0) {
    for (int b = blockIdx.x; b < 256; b += gridDim.x) {
        if (xmode == 2) break;
        attn_unit(P, lds_raw, b, tid, xmode != 0, xmode >= 10 ? xmode - 10 : 0);
        attn_unit(P, lds_raw, 504 - 8 * (b >> 3) + (b & 7), tid, xmode != 0, xmode >= 10 ? xmode - 10 : 0);
    }
    if (xmode != 1 && xmode < 10) for (int u = vbid(); u < 256; u += gridDim.x) s5_main_unit(P, lds_raw, u, tid);
    __syncthreads();
}

DI void phase5(const Params& P, unsigned char* lds_raw, int tid) {
    bf16_t* lds = (bf16_t*)lds_raw; float* Ct = (float*)lds_raw;
    unsigned char* ws = P.ws;
    const bf16_t* y1 = (const bf16_t*)(ws + OFF_Y1);
    for (int u = vbid(); u < 256; u += gridDim.x) {
        const int mt = u >> 2, nt = u & 3, m0 = mt * 256, n0 = nt * 128;
        f32x16 acc[2][2]; zero_acc(acc);
        const ASrc As = make_a(y1, 512, nullptr, T, m0, tid);
        const BSrcBf bs = make_bbf((const bf16_t*)(ws + OFF_WGLUT), 512, 512, n0, tid);
        __syncthreads();
        gemm_mainloop(acc, As, bs, 512, lds, tid);
        dump_acc(acc, Ct, tid);
        __syncthreads();
        const float* bglu = P.in[12];
        bf16_t* mix = (bf16_t*)(ws + OFF_XN);
        for (int it = tid; it < 256 * 32; it += NTHREADS) {
            const int row = it >> 5, c4 = it & 31, n = n0 + c4 * 4;
            const f32x4 v = *(const f32x4*)(Ct + row * CT_STRIDE + c4 * 4);
            const f32x4 bb = *(const f32x4*)(bglu + n);
            const u32x2 yy = *(const u32x2*)(y1 + (size_t)(m0 + row) * 512 + n);
            const float y0 = bf2f(yy.x & 0xffffu), y1v = bf2f(yy.x >> 16), y2 = bf2f(yy.y & 0xffffu), y3 = bf2f(yy.y >> 16);
            const float o0 = y0 * sigmoidf(v.x + bb.x), o1 = y1v * sigmoidf(v.y + bb.y), o2 = y2 * sigmoidf(v.z + bb.z), o3 = y3 * sigmoidf(v.w + bb.w);
            u32x2 o; o.x = pk2(o0, o1); o.y = pk2(o2, o3);
            *(u32x2*)(mix + (size_t)(m0 + row) * 1024 + n) = o;
            float sq = (o0 * o0 + o1 * o1) + (o2 * o2 + o3 * o3);
            sq += __shfl_xor(sq, 1); sq += __shfl_xor(sq, 2); sq += __shfl_xor(sq, 4); sq += __shfl_xor(sq, 8); sq += __shfl_xor(sq, 16);
            if ((tid & 31) == 0) __hip_atomic_fetch_add((float*)(ws + OFF_SSQ) + (size_t)(m0 + row) * 2, sq, __ATOMIC_RELAXED, __HIP_MEMORY_SCOPE_AGENT);
        }
    }
    __syncthreads();
}
DI void phase6(const Params& P, int tid, bool dry = false) {
    const int lane = tid & 63, wv = tid >> 6;
    bf16_t* mix = (bf16_t*)(P.ws + OFF_XN);
    for (int row = blockIdx.x * 8 + wv; row < T; row += gridDim.x * 8) {
#pragma unroll
        for (int seg = 0; seg < 2; ++seg) {
            bf16_t* p = mix + (size_t)row * 1024 + seg * 512 + lane * 8;
            const u32x4 v = *(const u32x4*)p;
            float f[8] = {bf2f(v.x & 0xffffu), bf2f(v.x >> 16), bf2f(v.y & 0xffffu), bf2f(v.y >> 16), bf2f(v.z & 0xffffu), bf2f(v.z >> 16), bf2f(v.w & 0xffffu), bf2f(v.w >> 16)};
            float s = 0.f;
#pragma unroll
            for (int i = 0; i < 8; ++i) s += f[i] * f[i];
            s = wave_sum(s);
            const float rs = rsqrtf(s * (1.f / 512.f) + EPS);
            const float* gw = P.in[seg ? 24 : 23] + lane * 8;
            const f32x4 g0 = *(const f32x4*)gw, g1 = *(const f32x4*)(gw + 4);
            u32x4 o; o.x = pk2(f[0] * rs * g0.x, f[1] * rs * g0.y); o.y = pk2(f[2] * rs * g0.z, f[3] * rs * g0.w);
            o.z = pk2(f[4] * rs * g1.x, f[5] * rs * g1.y); o.w = pk2(f[6] * rs * g1.z, f[7] * rs * g1.w);
            if (dry) o = v;
            *(u32x4*)p = o;
        }
    }
}
DI void phase7(const Params& P, unsigned char* lds_raw, int tid, int xmode = 0) {
    bf16_t* lds = (bf16_t*)lds_raw; float* Ct = (float*)lds_raw;
    const bf16_t* mix = (const bf16_t*)(P.ws + OFF_XN);
    const float* x = P.in[0];
    for (int u = vbid(); u < 256; u += gridDim.x) {
        const int mt = u >> 2, nt2 = u & 3, m0 = mt * 256;
        f32x16 acc[2][4]; zero_acc2(acc);
        const ASrc As = make_a(mix, 1024, nullptr, T, m0, tid);
        const BSrc2 bs = make_b2((const bf16_t*)(P.ws + OFF_WOUTT), 1024, 1024, nt2 * 256, tid);
        __syncthreads();
        float sc[8];
        {
            const float* ssq = (const float*)(P.ws + OFF_SSQ);
#pragma unroll
            for (int i = 0; i < 4; ++i) {
                const int row = m0 + (tid >> 3) + 64 * i;
                sc[i] = rsqrtf(ssq[(size_t)row * 2] * (1.f / 512.f) + EPS);
                sc[4 + i] = rsqrtf(ssq[(size_t)row * 2 + 1] * (1.f / 512.f) + EPS);
            }
        }
        if (xmode != 4) gemm_mainloop2s(acc, As, bs, 1024, lds, tid, sc);
        float* outp = xmode ? (float*)(P.ws + OFF_U) : P.out;
#pragma unroll 1
        for (int half = 0; half < 2; ++half) {
            const int n0 = nt2 * 256 + half * 128;
            if (xmode == 3) { if (tid == 0) outp[(size_t)m0 * 1024 + n0] = acc[0][0][0] + acc[1][3][5]; continue; }
            dump_acc2(acc, Ct, tid, half);
            __syncthreads();
            {
                const int c4 = tid & 31, r0 = tid >> 5;
#pragma unroll 1
                for (int jb = 0; jb < 16; jb += 4) {
                    f32x4 xv[4];
#pragma unroll
                    for (int j = 0; j < 4; ++j) xv[j] = *(const f32x4*)(x + (size_t)(m0 + r0 + 16 * (jb + j)) * 1024 + n0 + c4 * 4);
#pragma unroll
                    for (int j = 0; j < 4; ++j) {
                        const int row = r0 + 16 * (jb + j);
                        const f32x4 v = *(const f32x4*)(Ct + row * CT_STRIDE + c4 * 4);
                        *(f32x4*)(outp + (size_t)(m0 + row) * 1024 + n0 + c4 * 4) = xv[j] + v;
                    }
                }
            }
            __syncthreads();
        }
    }
    __syncthreads();
}
constexpr int RSTR = 264;
constexpr int R_AHI = 0, R_ALO = 64 * RSTR * 2, R_WHI = 2 * 64 * RSTR * 2, R_WLO = R_WHI + 40 * RSTR * 2, R_END = R_WLO + 40 * RSTR * 2;
struct RtRegs { f32x4 x[8]; u32x4 w[5]; };
DI void rt_load(RtRegs& R, const float* x1, const bf16_t* WrT, int m0, int c, int tid) {
    const int lane = tid & 63, w = tid >> 6;
#pragma unroll
    for (int i = 0; i < 8; ++i) R.x[i] = *(const f32x4*)(x1 + (size_t)(m0 + w * 8 + i) * 1024 + c * 256 + lane * 4);
#pragma unroll
    for (int i = 0; i < 5; ++i) { const int ch = tid + 512 * i, rw = ch >> 5, c16 = ch & 31;
        R.w[i] = *(const u32x4*)(WrT + (size_t)rw * 1024 + c * 256 + c16 * 8); }
}
DI void phase8(const Params& P, unsigned char* lds_raw, int tid, bool dry = false) {
    unsigned char* ws = P.ws;
    const float* x1 = P.out; const float* g2 = P.in[26];
    bf16_t* xg = (bf16_t*)(ws + (dry ? OFF_XN : OFF_H2HI));
    const bf16_t* WrT = (const bf16_t*)(ws + OFF_WRT);
    float* rs2 = (float*)(ws + OFF_RS2);
    unsigned* cnt = (unsigned*)(ws + OFF_CTL) + CW_CNT + (dry ? 64 * CNT_STRIDE : 0);
    int* list = (int*)(ws + (dry ? OFF_ACT : OFF_LIST)); float* listw = (float*)(ws + (dry ? OFF_ACT + (size_t)64 * T * 4 : OFF_LISTW));
    bf16_t* Ahi = (bf16_t*)(lds_raw + R_AHI); bf16_t* Alo = (bf16_t*)(lds_raw + R_ALO);
    bf16_t* Whi = (bf16_t*)(lds_raw + R_WHI);
    float* part = (float*)lds_raw;
    float* ssqp = (float*)(lds_raw + R_END);
    unsigned* hist = (unsigned*)(lds_raw + R_END + 256);
    unsigned* lbase = hist + 64;
    const int lane = tid & 63, w = tid >> 6, r = lane & 31, h = lane >> 5, mh = w & 1, ks = w >> 1;
    const int n0 = r, n1 = 32 + r < 40 ? 32 + r : 39;
    for (int u = blockIdx.x; u < 256; u += gridDim.x) {
        const int m0 = u * 64;
        f32x16 acc0, acc1;
#pragma unroll
        for (int i = 0; i < 16; ++i) { acc0[i] = 0.f; acc1[i] = 0.f; }
        float ssq[8];
#pragma unroll
        for (int i = 0; i < 8; ++i) ssq[i] = 0.f;
        RtRegs R;
        rt_load(R, x1, WrT, m0, 0, tid);
        __syncthreads();
#pragma unroll 1
        for (int c = 0; c < 4; ++c) {
            {
                const f32x4 g = *(const f32x4*)(g2 + c * 256 + lane * 4);
#pragma unroll
                for (int i = 0; i < 8; ++i) {
                    f32x4 v = R.x[i];
                    ssq[i] += (v.x * v.x + v.y * v.y) + (v.z * v.z + v.w * v.w);
                    v = v * g;
                    u32x2 hv; hv.x = pk2(v.x, v.y); hv.y = pk2(v.z, v.w);
                    u32x2 lv; lv.x = pk2(v.x - bf2f(hv.x & 0xffffu), v.y - bf2f(hv.x >> 16)); lv.y = pk2(v.z - bf2f(hv.y & 0xffffu), v.w - bf2f(hv.y >> 16));
                    const int row = w * 8 + i;
                    *(u32x2*)(Ahi + row * RSTR + lane * 4) = hv;
                    *(u32x2*)(Alo + row * RSTR + lane * 4) = lv;
                    *(u32x2*)(xg + (size_t)(m0 + row) * 1024 + c * 256 + lane * 4) = hv;
                }
#pragma unroll
                for (int i = 0; i < 5; ++i) { const int ch = tid + 512 * i, rw = ch >> 5, c16 = ch & 31; *(u32x4*)(Whi + rw * RSTR + c16 * 8) = R.w[i]; }
            }
            if (c < 3) rt_load(R, x1, WrT, m0, c + 1, tid);
            __syncthreads();
#pragma unroll 2
            for (int s4 = 0; s4 < 4; ++s4) {
                const int ko = (ks * 4 + s4) * 16 + 8 * h;
                const bf16x8 ah = *(const bf16x8*)(Ahi + (32 * mh + r) * RSTR + ko), al = *(const bf16x8*)(Alo + (32 * mh + r) * RSTR + ko);
                const bf16x8 wh0 = *(const bf16x8*)(Whi + n0 * RSTR + ko), wh1 = *(const bf16x8*)(Whi + n1 * RSTR + ko);
                const bf16x8 wl0 = *(const bf16x8*)(Whi + (40 + n0) * RSTR + ko), wl1 = *(const bf16x8*)(Whi + (40 + n1) * RSTR + ko);
                acc0 = MFMA32(ah, wh0, acc0); acc1 = MFMA32(ah, wh1, acc1);
                acc0 = MFMA32(ah, wl0, acc0); acc1 = MFMA32(ah, wl1, acc1);
                acc0 = MFMA32(al, wh0, acc0); acc1 = MFMA32(al, wh1, acc1);
            }
            __syncthreads();
        }
#pragma unroll
        for (int i = 0; i < 16; ++i) {
            float* d = part + ((ks * 64) + 32 * mh + crow(i, h)) * 64 + r;
            d[0] = acc0[i]; d[32] = acc1[i];
        }
#pragma unroll
        for (int i = 0; i < 8; ++i) { const float sv = wave_sum(ssq[i]); if (lane == 0) ssqp[w * 8 + i] = sv; }
        if (tid < 64) hist[tid] = 0u;
        __syncthreads();
        int vl0 = 0, vl1 = 0; unsigned lr0 = 0, lr1 = 0; float w0 = 0.f, w1 = 0.f;
        if (tid < 64) {
            const int t = tid, grow = m0 + t;
            const float rs = rsqrtf(ssqp[t] * (1.f / 1024.f) + EPS);
            const float* b_grp = P.in[28]; const float* b_exp = P.in[30];
            float gl[4]; int gsel = 0; float gmax = -3e38f;
#pragma unroll
            for (int j = 0; j < 4; ++j) {
                gl[j] = rs * ((part[t * 64 + j] + part[(64 + t) * 64 + j]) + (part[(128 + t) * 64 + j] + part[(192 + t) * 64 + j])) + b_grp[j];
                if (gl[j] > gmax) { gmax = gl[j]; gsel = j; }
            }
            float gsum = 0.f;
#pragma unroll
            for (int j = 0; j < 4; ++j) gsum += __expf(gl[j] - gmax);
            const float gprob = 1.f / gsum;
            float el[8]; float emax = -3e38f;
#pragma unroll
            for (int j = 0; j < 8; ++j) {
                const int cc = 4 + gsel * 8 + j;
                el[j] = rs * ((part[t * 64 + cc] + part[(64 + t) * 64 + cc]) + (part[(128 + t) * 64 + cc] + part[(192 + t) * 64 + cc])) + b_exp[gsel * 8 + j];
                emax = fmaxf(emax, el[j]);
            }
            int i0 = 0; float v0 = -3e38f;
#pragma unroll
            for (int j = 0; j < 8; ++j) if (el[j] > v0) { v0 = el[j]; i0 = j; }
            int i1 = 0; float v1 = -3e38f;
#pragma unroll
            for (int j = 0; j < 8; ++j) if (j != i0 && el[j] > v1) { v1 = el[j]; i1 = j; }
            const float p0 = __expf(v0 - emax), p1 = __expf(v1 - emax);
            w0 = p0 / (p0 + p1) * gprob; w1 = p1 / (p0 + p1) * gprob;
            vl0 = gsel * 8 + i0; vl1 = 32 + gsel * 8 + i1;
            if (!dry) rs2[grow] = rs;
            lr0 = atomicAdd(&hist[vl0], 1u);
            lr1 = atomicAdd(&hist[vl1], 1u);
        }
        __syncthreads();
        if (tid < 64) { const unsigned hc = hist[tid]; lbase[tid] = hc ? atomicAdd(&cnt[tid * CNT_STRIDE], hc) : 0u; }
        __syncthreads();
        if (tid < 64) {
            const int grow = m0 + tid;
            const unsigned q0 = lbase[vl0] + lr0, q1 = lbase[vl1] + lr1;
            list[(size_t)vl0 * T + q0] = grow; listw[(size_t)vl0 * T + q0] = w0;
            list[(size_t)vl1 * T + q1] = grow; listw[(size_t)vl1 * T + q1] = w1;
        }
    }
    __syncthreads();
}
DI bool moe_unit(const unsigned* cnt, int u, int ntn, int vlo, int vhi, int& v, int& mt, int& nt, int& base, int& M) {
    int acc = 0, b = 0;
    for (int vv = 0; vv < vhi; ++vv) {
        const int c = (int)cnt[vv * CNT_STRIDE];
        if (vv >= vlo) {
            const int nu = ((c + 255) >> 8) * ntn;
            if (u < acc + nu) { const int loc = u - acc; v = vv; mt = loc / ntn; nt = loc - mt * ntn; base = b; M = c; return true; }
            acc += nu;
        }
        b += c;
    }
    return false;
}
DI void phase9(const Params& P, unsigned char* lds_raw, int tid, float* outp, int mode = 0) {
    asm volatile("" : "+v"(tid));
    bf16_t* lds = (bf16_t*)lds_raw; float* Ct = (float*)lds_raw;
    unsigned char* ws = P.ws;
    unsigned* ctl = (unsigned*)(ws + OFF_CTL);
    const unsigned* cnt = ctl + CW_CNT;
    const bf16_t* hi = (const bf16_t*)(ws + OFF_H2HI);
    const int* list = (const int*)(ws + OFF_LIST); const float* listw = (const float*)(ws + OFF_LISTW);
    const float* rs2 = (const float*)(ws + OFF_RS2);
    bf16_t* act = (bf16_t*)(ws + OFF_ACT);
    float* rowf = (float*)(lds_raw + 147456);
    int* rowi = (int*)(lds_raw + 147456 + 1024);
    bf16_t* Y0 = (bf16_t*)(ws + OFF_XN);
    int total1 = 0, total2a = 0, total2b = 0;
    for (int vv = 0; vv < 64; ++vv) { const int mtv = ((int)cnt[vv * CNT_STRIDE] + 255) >> 8; total1 += mtv * 2; if (vv < 32) total2a += mtv * 4; else total2b += mtv * 4; }
    const int total = total1 + total2a + total2b;
    volatile unsigned* wq = (volatile unsigned*)(lds_raw + LDS_BYTES - 64) + 8;
    int u = vbid();
    while (u < total) {
        unsigned nxt = 0;
        if (tid == 0) nxt = gridDim.x + __hip_atomic_fetch_add(ctl + CW_WQ, 1u, __ATOMIC_RELAXED, __HIP_MEMORY_SCOPE_AGENT);
        int v, mt, nt, base, M;
        if ((mode == 2 && u >= total1) || (mode == 3 && u < total1)) {
        } else if (u < total1) {
            if (!moe_unit(cnt, u, 2, 0, 64, v, mt, nt, base, M)) break;
            const int e = v & 31;
            const int m0 = mt * 256;
            const int* rows = list + (size_t)v * T;
            f32x16 acc[2][4]; zero_acc2(acc);
            const ASrc As = make_a(hi, 1024, rows, M, m0, tid);
            const BSrc2 bs = make_b2((const bf16_t*)(ws + OFF_WGUT) + (size_t)e * 512 * 1024, 1024, 512, nt * 256, tid);
            float rsr = 0.f;
            if (tid < 256 && m0 + tid < M) rsr = rs2[rows[m0 + tid]];
            __syncthreads();
            gemm_mainloop2(acc, As, bs, 1024, lds, tid);
            if (tid < 256) rowf[tid] = rsr;
#pragma unroll 1
            for (int half = 0; half < 2; ++half) {
                const int nq = nt * 2 + half;
                dump_acc2(acc, Ct, tid, half);
                __syncthreads();
                for (int it = tid; it < 256 * 16; it += NTHREADS) {
                    const int row = it >> 4, q = it & 15, wn_ = q >> 3, c = (q & 7) * 4;
                    if (m0 + row < M) {
                        const float rs = rowf[row];
                        const f32x4 gt = *(const f32x4*)(Ct + row * CT_STRIDE + wn_ * 64 + c) * rs;
                        const f32x4 up = *(const f32x4*)(Ct + row * CT_STRIDE + wn_ * 64 + 32 + c) * rs;
                        u32x2 o; o.x = pk2(gt.x * sigmoidf(gt.x) * up.x, gt.y * sigmoidf(gt.y) * up.y); o.y = pk2(gt.z * sigmoidf(gt.z) * up.z, gt.w * sigmoidf(gt.w) * up.w);
                        st_wt8(act + (size_t)(base + m0 + row) * 256 + nq * 64 + wn_ * 32 + c, o);
                    }
                }
                __syncthreads();
            }
            unit_signal(ctl + CW_DONE + v * 64 + mt, tid);
        } else {
            const bool slot1 = u >= total1 + total2a;
            if (!moe_unit(cnt, slot1 ? u - total1 - total2a : u - total1, 4, slot1 ? 32 : 0, slot1 ? 64 : 32, v, mt, nt, base, M)) break;
            const int e = v & 31;
            const int m0 = mt * 256;
            const bf16_t* A = act + (size_t)base * 256;
            f32x16 acc[2][4]; zero_acc2(acc);
            const ASrc As = make_a(A, 256, nullptr, M, m0, tid);
            const BSrc2 bs = make_b2((const bf16_t*)(ws + OFF_WDT) + (size_t)e * 1024 * 256, 256, 1024, nt * 256, tid);
            int tokr = 0; float wgtr = 0.f;
            if (tid < 256) { const int rr = m0 + tid < M ? m0 + tid : M - 1; tokr = list[(size_t)v * T + rr]; wgtr = listw[(size_t)v * T + rr]; }
            unit_wait2(ctl + CW_DONE + v * 64 + mt, 2u, slot1 ? ctl + CW_S0DONE : nullptr, (unsigned)total2a, tid);
            gemm_mainloop2(acc, As, bs, 256, lds, tid);
            if (tid < 256) { rowi[tid] = tokr; rowf[tid] = wgtr; }
#pragma unroll 1
            for (int half = 0; half < 2; ++half) {
                const int n0 = nt * 256 + half * 128;
                dump_acc2(acc, Ct, tid, half);
                __syncthreads();
                {
                    const int c4 = tid & 31, r0 = tid >> 5;
                    if (!slot1) {
#pragma unroll 4
                        for (int j = 0; j < 16; ++j) {
                            const int row = r0 + 16 * j;
                            if (m0 + row < M) {
                                const f32x4 cv = *(const f32x4*)(Ct + row * CT_STRIDE + c4 * 4) * rowf[row];
                                u32x2 o; o.x = pk2(cv.x, cv.y); o.y = pk2(cv.z, cv.w);
                                st_wt8(Y0 + (size_t)rowi[row] * 1024 + n0 + c4 * 4, o);
                            }
                        }
                    } else {
#pragma unroll 1
                        for (int jb = 0; jb < 16; jb += 8) {
                            f32x4 ov[8]; u32x2 yv[8];
#pragma unroll
                            for (int j = 0; j < 8; ++j) {
                                const size_t o = (size_t)rowi[r0 + 16 * (jb + j)] * 1024 + n0 + c4 * 4;
                                ov[j] = *(const f32x4*)(outp + o);
                                yv[j] = *(const u32x2*)(Y0 + o);
                            }
#pragma unroll
                            for (int j = 0; j < 8; ++j) {
                                const int row = r0 + 16 * (jb + j);
                                if (m0 + row < M) {
                                    const f32x4 cv = *(const f32x4*)(Ct + row * CT_STRIDE + c4 * 4) * rowf[row];
                                    f32x4 nv = ov[j] + cv;
                                    nv.x += bf2f(yv[j].x & 0xffffu); nv.y += bf2f(yv[j].x >> 16); nv.z += bf2f(yv[j].y & 0xffffu); nv.w += bf2f(yv[j].y >> 16);
                                    *(f32x4*)(outp + (size_t)rowi[row] * 1024 + n0 + c4 * 4) = nv;
                                }
                            }
                        }
                    }
                }
                __syncthreads();
            }
            if (!slot1) unit_signal(ctl + CW_S0DONE, tid);
        }
        if (tid == 0) wq[0] = nxt;
        __syncthreads();
        u = __builtin_amdgcn_readfirstlane((int)wq[0]);
    }
    __syncthreads();
}

constexpr int NPHASES = 10;
__global__ void __launch_bounds__(NTHREADS, 2) mk(Params P) {
    extern __shared__ __attribute__((aligned(16))) unsigned char lds_raw[];
    const int tid = threadIdx.x;
    volatile unsigned* misc = (volatile unsigned*)(lds_raw + LDS_BYTES - 64);
    if (tid < 2) misc[tid] = 0u;
    __syncthreads();
    XcdBarrier bar; bar.bar = nullptr; bar.x = 0; bar.st = nullptr;
    const bool multi = (P.ph_hi - P.ph_lo) > 1;
    if (multi) bar = xcd_barrier_post((unsigned*)(P.ws + OFF_CTL) + CW_BAR, misc);
    const int lo = P.ph_lo, hi = P.ph_hi;
#define IN(k) (lo <= (k) && (k) < hi)
#define SEAM(k) do { if (IN(k) && IN((k) + 1)) xcd_barrier(bar); } while (0)
#ifndef PROBE_PHASE
#define PROBE_PHASE -1
#endif
#ifndef PROBE_XMODE
#define PROBE_XMODE 0
#endif
#define RUN(k, call, calldry) do { if (IN(k)) { call; if (PROBE_PHASE == (k) || PROBE_PHASE == 100 + (k) / 4) { xcd_barrier(bar); calldry; } } } while (0)
    RUN(0, phase0(P, lds_raw, tid), phase0(P, lds_raw, tid, PROBE_XMODE));
    SEAM(0);
    RUN(1, phase1(P, lds_raw, tid), phase1(P, lds_raw, tid, PROBE_XMODE));
    SEAM(1);
    RUN(2, phase2(P, lds_raw, tid), phase2(P, lds_raw, tid));
    SEAM(2);
    RUN(4, phase4(P, lds_raw, tid), phase4(P, lds_raw, tid, PROBE_XMODE ? PROBE_XMODE : 3));
    SEAM(4);
    RUN(5, phase5(P, lds_raw, tid), phase5(P, lds_raw, tid));
    SEAM(5);
    RUN(7, phase7(P, lds_raw, tid), phase7(P, lds_raw, tid, PROBE_XMODE));
    SEAM(7);
    if (IN(8)) {
        if (PROBE_PHASE == 8) {
            phase8(P, lds_raw, tid); xcd_barrier(bar);
            if (blockIdx.x == 0 && tid < 64) ((unsigned*)(P.ws + OFF_CTL))[CW_CNT + tid * CNT_STRIDE] = 0u;
            xcd_barrier(bar);
        }
        phase8(P, lds_raw, tid);
    }
    SEAM(8);
    if (IN(9)) {
        if (PROBE_PHASE == 9) {
            unsigned* ctl = (unsigned*)(P.ws + OFF_CTL);
            phase9(P, lds_raw, tid, PROBE_XMODE == 0 ? (float*)(P.ws + OFF_KC) : P.out);
            xcd_barrier(bar);
            if (blockIdx.x == 0) {
                if (PROBE_XMODE == 0) { for (int i = tid; i < 4096; i += NTHREADS) ctl[CW_DONE + i] = 0u; if (tid == 0) ctl[CW_S0DONE] = 0u; }
                if (tid == 0) ctl[CW_WQ] = 0u;
            }
            xcd_barrier(bar);
            phase9(P, lds_raw, tid, PROBE_XMODE == 0 ? P.out : (float*)(P.ws + OFF_KC), PROBE_XMODE >= 2 ? PROBE_XMODE : 0);
        } else phase9(P, lds_raw, tid, P.out);
    }
#undef RUN
#undef IN
#undef SEAM
}

extern "C" void kernel_launch(void* const* d_in, const int* in_sizes, int n_in, void* d_out, int out_size, void* d_ws, size_t ws_size, hipStream_t stream) {
    static int grid = 0;
    if (grid == 0) {
        if (n_in != 34 || out_size != T * DM || ws_size < WS_END) {
            fprintf(stderr, "kernel_launch: unexpected shapes: n_in %d out %d ws %zu (need %zu)\n", n_in, out_size, ws_size, (size_t)WS_END);
            grid = -1; return;
        }
        int dev = 0, cus = 0;
        hipGetDevice(&dev);
        hipDeviceGetAttribute(&cus, hipDeviceAttributeMultiprocessorCount, dev);
        hipFuncSetAttribute((const void*)mk, hipFuncAttributeMaxDynamicSharedMemorySize, LDS_BYTES);
        int per_cu = 0;
        hipOccupancyMaxActiveBlocksPerMultiprocessor(&per_cu, (const void*)mk, NTHREADS, LDS_BYTES);
        (void)hipGetLastError();
        if (per_cu < 1) fprintf(stderr, "kernel_launch: occupancy query says %d blocks/CU\n", per_cu);
        grid = cus > 0 ? cus : 256;
    }
    if (grid < 0) return;
    hipMemsetAsync((char*)d_ws + OFF_CTL, 0, CTL_BYTES, stream);
    Params p{};
    for (int i = 0; i < 34; ++i) p.in[i] = (const float*)d_in[i];
    p.out = (float*)d_out; p.ws = (unsigned char*)d_ws;
#ifndef MK_ONE_LAUNCH
    for (int ph = 0; ph < NPHASES; ++ph) {
        p.ph_lo = ph; p.ph_hi = ph + 1;
        hipLaunchKernelGGL(mk, dim3(grid), dim3(NTHREADS), LDS_BYTES, stream, p);
    }
#else
    p.ph_lo = 0; p.ph_hi = NPHASES;
    hipLaunchKernelGGL(mk, dim3(grid), dim3(NTHREADS), LDS_BYTES, stream, p);
#endif
}
```

```cpp
#define MK_ONE_LAUNCH 1
#include <hip/hip_runtime.h>
#include <stdint.h>
#include <cstdio>

#define DI __device__ __forceinline__
typedef unsigned short bf16_t;
typedef short bf16x8 __attribute__((ext_vector_type(8)));
typedef short s16x4 __attribute__((ext_vector_type(4)));
typedef float f32x16 __attribute__((ext_vector_type(16)));
typedef float f32x4 __attribute__((ext_vector_type(4)));
typedef unsigned u32x4 __attribute__((ext_vector_type(4)));
typedef unsigned u32x2 __attribute__((ext_vector_type(2)));

constexpr int T = 16384, SEQ = 4096, NBATCH = 4, DM = 1024, DIN = 1816;
constexpr int NTHREADS = 512;
constexpr float EPS = 1e-6f;

constexpr size_t al256(size_t x) { return (x + 255) & ~(size_t)255; }
constexpr size_t OFF_CTL   = 0;
constexpr size_t CTL_BYTES = 65536;
constexpr size_t OFF_XN    = OFF_CTL + CTL_BYTES;
constexpr size_t OFF_U     = OFF_XN + (size_t)T * 1024 * 2;
constexpr size_t OFF_QN    = OFF_U + (size_t)T * 512 * 2;
constexpr size_t KV_BYTES  = (size_t)8 * 4096 * 64 * 2;
constexpr size_t OFF_KC    = OFF_QN + (size_t)T * 512 * 2;
constexpr size_t OFF_VC    = OFF_KC + KV_BYTES;
constexpr size_t OFF_KSN   = OFF_VC + KV_BYTES;
constexpr size_t OFF_KWN   = OFF_KSN + KV_BYTES;
constexpr size_t OFF_VST   = OFF_KWN + KV_BYTES;
constexpr size_t OFF_VWT   = OFF_VST + KV_BYTES;
constexpr size_t OFF_GATES = OFF_VWT + KV_BYTES;
constexpr size_t OFF_TGT   = OFF_GATES + (size_t)T * 24 * 4;
constexpr size_t OFF_EGT   = OFF_TGT + (size_t)32 * 512 * 512 * 2;
constexpr size_t OFF_FGT   = OFF_EGT + (size_t)32 * 128 * 512 * 2;
constexpr size_t OFF_LAM32 = OFF_FGT + (size_t)32 * 512 * 128 * 2;
constexpr size_t OFF_BIASP = OFF_LAM32 + 32 * 64 * 2 * 4;
constexpr size_t OFF_Z     = OFF_BIASP + 2 * 16 * 256 * 4;
constexpr size_t OFF_SIN   = OFF_Z + (size_t)32 * 512 * 128 * 4;
constexpr size_t OFF_P     = OFF_SIN + (size_t)32 * 512 * 128 * 2;
constexpr size_t OFF_KCMP  = OFF_P + (size_t)2 * 8 * 2 * 256 * 256 * 4;
constexpr size_t OFF_VCMPT = OFF_KCMP + 8 * 256 * 64 * 2;
constexpr size_t OFF_Y1    = OFF_VCMPT + 8 * 64 * 256 * 2;
constexpr size_t OFF_H2HI  = OFF_U;
constexpr size_t OFF_H2LO  = OFF_TGT;
constexpr size_t OFF_ACT   = OFF_Y1;
constexpr size_t OFF_LIST  = OFF_Y1 + (size_t)T * 512 * 2;
constexpr size_t OFF_LISTW = OFF_LIST + (size_t)64 * T * 4;
constexpr size_t OFF_RS2   = OFF_LISTW + (size_t)64 * T * 4;
constexpr size_t OFF_SSQ   = OFF_RS2 + (size_t)T * 4;
constexpr size_t OFF_WINT  = OFF_SSQ + (size_t)T * 2 * 4;
constexpr size_t OFF_WGLUT = OFF_WINT + (size_t)1816 * 1024 * 2;
constexpr size_t OFF_WC1T  = OFF_WGLUT + (size_t)512 * 512 * 2;
constexpr size_t OFF_WOUTT = OFF_WC1T + (size_t)4 * 256 * 1024 * 2;
constexpr size_t OFF_WRT   = OFF_WOUTT + (size_t)1024 * 1024 * 2;
constexpr size_t OFF_WGUT  = OFF_WRT + (size_t)2 * 40 * 1024 * 2;
constexpr size_t OFF_WDT   = OFF_WGUT + (size_t)32 * 512 * 1024 * 2;
constexpr size_t WS_END    = OFF_WDT + (size_t)32 * 1024 * 256 * 2;
static_assert(OFF_H2HI + (size_t)T * 1024 * 2 <= OFF_KC, "h2hi overlay");
static_assert(OFF_H2LO + (size_t)T * 1024 * 2 <= OFF_SIN, "h2lo overlay");
static_assert(WS_END <= (size_t)256 * 1024 * 1024, "workspace");

constexpr int CW_CNT = 8192;
constexpr int CNT_STRIDE = 32;
constexpr int CW_WQ = 4736;
constexpr int CW_S0DONE = 4608;
constexpr int CW_DONE = 12288;
constexpr int CW_PDONE = 4864;
constexpr int CW_BAR = 1024;

constexpr int LDS_BYTES = 151552;
constexpr int BM = 256, BN = 128, BK = 64;
constexpr int LSTR = 72;
constexpr int A_TILE = BM * LSTR;
constexpr int B_TILE = BN * LSTR;
constexpr int STAGE_ELEMS = A_TILE + B_TILE;
constexpr int CT_STRIDE = 132;
constexpr int STAGE2_ELEMS = (BM + 256) * LSTR;

struct Params {
    const float* in[34];
    float* out;
    unsigned char* ws;
    int ph_lo, ph_hi;
};

DI unsigned f2bf(float f) { unsigned u = __builtin_bit_cast(unsigned, f); return (u + 0x7fffu + ((u >> 16) & 1u)) >> 16; }
DI float bf2f(unsigned b) { return __builtin_bit_cast(float, b << 16); }
typedef float f32x2 __attribute__((ext_vector_type(2)));
typedef __bf16 bf16x2_t __attribute__((ext_vector_type(2)));
DI unsigned pk2(float lo, float hi) { f32x2 v = {lo, hi}; bf16x2_t b = __builtin_convertvector(v, bf16x2_t); return __builtin_bit_cast(unsigned, b); }
DI float wave_sum(float v) {
#pragma unroll
    for (int o = 1; o < 64; o <<= 1) v += __shfl_xor(v, o);
    return v;
}
DI float gelu_tanh(float x) {
    const float k0 = 0.7978845608028654f, k1 = 0.044715f;
    float u = k0 * (x + k1 * x * x * x);
    float e = __expf(2.f * u);
    float th = 1.f - 2.f / (e + 1.f);
    return 0.5f * x * (1.f + th);
}
DI float sigmoidf(float x) { return 1.f / (1.f + __expf(-x)); }
DI int vbid() { const int G = gridDim.x, b = blockIdx.x; return (G & 7) == 0 ? (b & 7) * (G >> 3) + (b >> 3) : b; }
DI int crow(int reg, int h) { return (reg & 3) + 8 * (reg >> 2) + 4 * h; }
#define MFMA32(a, b, c) __builtin_amdgcn_mfma_f32_32x32x16_bf16((a), (b), (c), 0, 0, 0)

#define XB_TMO      128
#define XB_XCNT(j)  (256  + 64 * (j))
#define XB_XSUB(j)  (1280 + 64 * (j))
#define XB_XGEN(j)  (2304 + 64 * (j))
#define XB_TOP      3328
#define XB_TOPGEN   3392
#define XCD_BAR_WORDS 3456
#define XB_SPIN_CAP (1u << 22)
DI unsigned xb_ld(unsigned* p)              { return __hip_atomic_load(p, __ATOMIC_RELAXED, __HIP_MEMORY_SCOPE_AGENT); }
DI unsigned xb_add(unsigned* p, unsigned v) { return __hip_atomic_fetch_add(p, v, __ATOMIC_RELAXED, __HIP_MEMORY_SCOPE_AGENT); }
DI unsigned xb_xcc_id() { return (unsigned)__builtin_amdgcn_s_getreg((3 << 11) | 20) & 0xFu; }
#define XB_SPIN(cond, bar) do { unsigned _sp = 0; while (cond) { __builtin_amdgcn_s_sleep(1); \
    if ((++_sp & 255u) == 0u) { if (xb_ld(&(bar)[XB_TMO])) break; if (_sp > XB_SPIN_CAP) { atomicAdd(&(bar)[XB_TMO], 1u); break; } } } } while (0)
struct XcdBarrier { unsigned* bar; unsigned x; volatile unsigned* st; };
DI XcdBarrier xcd_barrier_post(unsigned* bar, volatile unsigned* st) {
    XcdBarrier b; b.bar = bar; b.x = xb_xcc_id(); b.st = st;
    if (threadIdx.x == 0) (void)xb_add(&bar[XB_XCNT(b.x)], 1u);
    return b;
}
DI void xcd_barrier_complete(unsigned* bar, unsigned x, unsigned& nloc, unsigned& nx) {
    const unsigned G = gridDim.x;
    unsigned sum, cnt, mine, sp = 0u;
    for (;;) {
        sum = 0u; cnt = 0u; mine = 0u;
#pragma unroll
        for (unsigned j = 0; j < 16; ++j) { const unsigned c = xb_ld(&bar[XB_XCNT(j)]); sum += c; cnt += (c > 0u) ? 1u : 0u; mine = (j == x) ? c : mine; }
        if (sum == G) break;
        __builtin_amdgcn_s_sleep(1);
        if ((++sp & 255u) == 0u) { if (xb_ld(&bar[XB_TMO])) break; if (sp > XB_SPIN_CAP) { atomicAdd(&bar[XB_TMO], 1u); break; } }
    }
    nloc = mine > 0u ? mine : 1u; nx = cnt > 0u ? cnt : 1u;
}
DI void xcd_barrier(const XcdBarrier& b) {
    asm volatile("s_waitcnt vmcnt(0)" ::: "memory");
    __syncthreads();
    if (threadIdx.x == 0) {
        unsigned* bar = b.bar;
        __builtin_amdgcn_s_waitcnt(0);
        unsigned nloc = b.st[0], nx = b.st[1];
        if (nloc == 0u) { xcd_barrier_complete(bar, b.x, nloc, nx); b.st[0] = nloc; b.st[1] = nx; }
        const unsigned old = xb_add(&bar[XB_XSUB(b.x)], 1u);
        const unsigned gen = old / nloc;
        if (old + 1u == (gen + 1u) * nloc) {
            __builtin_amdgcn_fence(__ATOMIC_RELEASE, "agent");
            asm volatile("s_waitcnt vmcnt(0)" ::: "memory");
            const unsigned og = xb_add(&bar[XB_TOP], 1u);
            const unsigned tg = og / nx;
            if (og + 1u == (tg + 1u) * nx) xb_add(&bar[XB_TOPGEN], 1u);
            else XB_SPIN(xb_ld(&bar[XB_TOPGEN]) == tg, bar);
            __builtin_amdgcn_fence(__ATOMIC_ACQUIRE, "agent");
            xb_add(&bar[XB_XGEN(b.x)], 1u);
            asm volatile("s_waitcnt vmcnt(0)" ::: "memory");
        } else {
            XB_SPIN(xb_ld(&bar[XB_XGEN(b.x)]) == gen, bar);
            __builtin_amdgcn_fence(__ATOMIC_ACQUIRE, "agent");
            asm volatile("s_waitcnt vmcnt(0)" ::: "memory");
        }
    }
    __syncthreads();
}

struct BSrcBf { const bf16_t* p0; const bf16_t* p1; };
struct GRegs { u32x4 a0, a1, a2, a3, b0, b1; };
struct ASrc { const bf16_t* a0; const bf16_t* a1; const bf16_t* a2; const bf16_t* a3; };
DI void g_load(GRegs& r, const ASrc& A, const BSrcBf& B, int kb) {
    const int ko = kb * BK;
    r.a0 = *(const u32x4*)(A.a0 + ko); r.a1 = *(const u32x4*)(A.a1 + ko); r.a2 = *(const u32x4*)(A.a2 + ko); r.a3 = *(const u32x4*)(A.a3 + ko);
    r.b0 = *(const u32x4*)(B.p0 + ko); r.b1 = *(const u32x4*)(B.p1 + ko);
}
DI void g_store(const GRegs& r, bf16_t* st, int tid) {
    const int off = (tid >> 3) * LSTR + (tid & 7) * 8;
    *(u32x4*)(st + off) = r.a0; *(u32x4*)(st + off + 64 * LSTR) = r.a1; *(u32x4*)(st + off + 128 * LSTR) = r.a2; *(u32x4*)(st + off + 192 * LSTR) = r.a3;
    *(u32x4*)(st + A_TILE + off) = r.b0; *(u32x4*)(st + A_TILE + off + 64 * LSTR) = r.b1;
}
DI void g_compute(f32x16 (&acc)[2][2], const bf16_t* st, int wm, int wn, int r, int h) {
    const bf16_t* ab = st + (wm * 64 + r) * LSTR + h * 8;
    const bf16_t* bb = st + A_TILE + (wn * 64 + r) * LSTR + h * 8;
#pragma unroll
    for (int s = 0; s < 4; ++s) {
        const bf16x8 af0 = *(const bf16x8*)(ab + s * 16);
        const bf16x8 af1 = *(const bf16x8*)(ab + 32 * LSTR + s * 16);
        const bf16x8 bf0 = *(const bf16x8*)(bb + s * 16);
        const bf16x8 bf1 = *(const bf16x8*)(bb + 32 * LSTR + s * 16);
        acc[0][0] = MFMA32(af0, bf0, acc[0][0]);
        acc[0][1] = MFMA32(af0, bf1, acc[0][1]);
        acc[1][0] = MFMA32(af1, bf0, acc[1][0]);
        acc[1][1] = MFMA32(af1, bf1, acc[1][1]);
    }
}
DI void gemm_mainloop(f32x16 (&acc)[2][2], const ASrc& A, const BSrcBf& B, int K, bf16_t* lds, int tid, int xmode = 0) {
    const int lane = tid & 63, w = tid >> 6, r = lane & 31, h = lane >> 5;
    const int wm = w >> 1, wn = w & 1;
    const int nk = K / BK;
    GRegs RA, RB;
    g_load(RA, A, B, 0);
    g_store(RA, lds, tid);
    if (nk > 1) g_load(RA, A, B, 1);
    if (nk > 2) g_load(RB, A, B, 2);
    __syncthreads();
    for (int kb = 0; kb < nk; kb += 2) {
        if (xmode != 2) g_compute(acc, lds, wm, wn, r, h);
        if (kb + 1 < nk) g_store(RA, lds + STAGE_ELEMS, tid);
        if (kb + 3 < nk) g_load(RA, A, B, xmode == 1 ? 0 : kb + 3);
        __syncthreads();
        if (kb + 1 >= nk) break;
        if (xmode != 2) g_compute(acc, lds + STAGE_ELEMS, wm, wn, r, h);
        if (kb + 2 < nk) g_store(RB, lds, tid);
        if (kb + 4 < nk) g_load(RB, A, B, xmode == 1 ? 1 : kb + 4);
        __syncthreads();
    }
}

DI void zero_acc(f32x16 (&acc)[2][2]) {
#pragma unroll
    for (int a = 0; a < 2; ++a)
#pragma unroll
        for (int b = 0; b < 2; ++b)
#pragma unroll
            for (int i = 0; i < 16; ++i) acc[a][b][i] = 0.f;
}
DI void dump_acc(const f32x16 (&acc)[2][2], float* Ct, int tid) {
    const int lane = tid & 63, w = tid >> 6, r = lane & 31, h = lane >> 5;
    const int wm = w >> 1, wn = w & 1;
#pragma unroll
    for (int tm = 0; tm < 2; ++tm)
#pragma unroll
        for (int tn = 0; tn < 2; ++tn)
#pragma unroll
            for (int i = 0; i < 16; ++i)
                Ct[(wm * 64 + tm * 32 + crow(i, h)) * CT_STRIDE + wn * 64 + tn * 32 + r] = acc[tm][tn][i];
}
struct BSrc2 { const bf16_t* p0; const bf16_t* p1; const bf16_t* p2; const bf16_t* p3; };
struct GRegs2 { u32x4 a0, a1, a2, a3, b0, b1, b2, b3; };
DI void g2_load(GRegs2& r, const ASrc& A, const BSrc2& B, int kb) {
    const int ko = kb * BK;
    r.a0 = *(const u32x4*)(A.a0 + ko); r.a1 = *(const u32x4*)(A.a1 + ko); r.a2 = *(const u32x4*)(A.a2 + ko); r.a3 = *(const u32x4*)(A.a3 + ko);
    r.b0 = *(const u32x4*)(B.p0 + ko); r.b1 = *(const u32x4*)(B.p1 + ko); r.b2 = *(const u32x4*)(B.p2 + ko); r.b3 = *(const u32x4*)(B.p3 + ko);
}
DI void g2_store(const GRegs2& r, bf16_t* st, int tid) {
    const int off = (tid >> 3) * LSTR + (tid & 7) * 8;
    *(u32x4*)(st + off) = r.a0; *(u32x4*)(st + off + 64 * LSTR) = r.a1; *(u32x4*)(st + off + 128 * LSTR) = r.a2; *(u32x4*)(st + off + 192 * LSTR) = r.a3;
    bf16_t* sb = st + A_TILE;
    *(u32x4*)(sb + off) = r.b0; *(u32x4*)(sb + off + 64 * LSTR) = r.b1; *(u32x4*)(sb + off + 128 * LSTR) = r.b2; *(u32x4*)(sb + off + 192 * LSTR) = r.b3;
}
DI void g2_compute(f32x16 (&acc)[2][4], const bf16_t* st, int wm, int wn, int r, int h) {
    const bf16_t* ab = st + (wm * 64 + r) * LSTR + h * 8;
    const bf16_t* bb = st + A_TILE + (wn * 128 + r) * LSTR + h * 8;
#pragma unroll
    for (int s = 0; s < 4; ++s) {
        const bf16x8 af0 = *(const bf16x8*)(ab + s * 16);
        const bf16x8 af1 = *(const bf16x8*)(ab + 32 * LSTR + s * 16);
#pragma unroll
        for (int tn = 0; tn < 4; ++tn) {
            const bf16x8 bf = *(const bf16x8*)(bb + tn * 32 * LSTR + s * 16);
            acc[0][tn] = MFMA32(af0, bf, acc[0][tn]);
            acc[1][tn] = MFMA32(af1, bf, acc[1][tn]);
        }
    }
}
DI void gemm_mainloop2(f32x16 (&acc)[2][4], const ASrc& A, const BSrc2& B, int K, bf16_t* lds, int tid) {
    const int lane = tid & 63, w = tid >> 6, r = lane & 31, h = lane >> 5;
    const int wm = w >> 1, wn = w & 1;
    const int nk = K / BK;
    GRegs2 RA;
    g2_load(RA, A, B, 0);
    g2_store(RA, lds, tid);
    if (nk > 1) g2_load(RA, A, B, 1);
    __syncthreads();
    for (int kb = 0; kb < nk; ++kb) {
        g2_compute(acc, lds + (kb & 1) * STAGE2_ELEMS, wm, wn, r, h);
        if (kb + 1 < nk) g2_store(RA, lds + ((kb + 1) & 1) * STAGE2_ELEMS, tid);
        if (kb + 2 < nk) g2_load(RA, A, B, kb + 2);
        __syncthreads();
    }
}
DI u32x4 scale8(u32x4 v, float sc) {
    u32x4 o;
    o.x = pk2(__builtin_bit_cast(float, v.x << 16) * sc, __builtin_bit_cast(float, v.x & 0xffff0000u) * sc);
    o.y = pk2(__builtin_bit_cast(float, v.y << 16) * sc, __builtin_bit_cast(float, v.y & 0xffff0000u) * sc);
    o.z = pk2(__builtin_bit_cast(float, v.z << 16) * sc, __builtin_bit_cast(float, v.z & 0xffff0000u) * sc);
    o.w = pk2(__builtin_bit_cast(float, v.w << 16) * sc, __builtin_bit_cast(float, v.w & 0xffff0000u) * sc);
    return o;
}
DI void gemm_mainloop2s(f32x16 (&acc)[2][4], const ASrc& A, const BSrc2& B, int K, bf16_t* lds, int tid, const float (&sc)[8]) {
    const int lane = tid & 63, w = tid >> 6, r = lane & 31, h = lane >> 5;
    const int wm = w >> 1, wn = w & 1;
    const int nk = K / BK;
    GRegs2 RA;
    g2_load(RA, A, B, 0);
    { RA.a0 = scale8(RA.a0, sc[0]); RA.a1 = scale8(RA.a1, sc[1]); RA.a2 = scale8(RA.a2, sc[2]); RA.a3 = scale8(RA.a3, sc[3]); }
    g2_store(RA, lds, tid);
    if (nk > 1) g2_load(RA, A, B, 1);
    __syncthreads();
    for (int kb = 0; kb < nk; ++kb) {
        g2_compute(acc, lds + (kb & 1) * STAGE2_ELEMS, wm, wn, r, h);
        if (kb + 1 < nk) {
            const int o = ((kb + 1) * BK < 512) ? 0 : 4;
            RA.a0 = scale8(RA.a0, sc[o]); RA.a1 = scale8(RA.a1, sc[o + 1]); RA.a2 = scale8(RA.a2, sc[o + 2]); RA.a3 = scale8(RA.a3, sc[o + 3]);
            g2_store(RA, lds + ((kb + 1) & 1) * STAGE2_ELEMS, tid);
        }
        if (kb + 2 < nk) g2_load(RA, A, B, kb + 2);
        __syncthreads();
    }
}
DI void zero_acc2(f32x16 (&acc)[2][4]) {
#pragma unroll
    for (int a = 0; a < 2; ++a)
#pragma unroll
        for (int b = 0; b < 4; ++b)
#pragma unroll
            for (int i = 0; i < 16; ++i) acc[a][b][i] = 0.f;
}
DI void dump_acc2(const f32x16 (&acc)[2][4], float* Ct, int tid, int half) {
    const int lane = tid & 63, w = tid >> 6, r = lane & 31, h = lane >> 5;
    const int wm = w >> 1, wn = w & 1;
    if (wn == half) {
#pragma unroll
        for (int tm = 0; tm < 2; ++tm)
#pragma unroll
            for (int tn = 0; tn < 4; ++tn)
#pragma unroll
                for (int i = 0; i < 16; ++i)
                    Ct[(wm * 64 + tm * 32 + crow(i, h)) * CT_STRIDE + tn * 32 + r] = acc[tm][tn][i];
    }
}
DI BSrc2 make_b2(const bf16_t* Bt, long ldb, int N, int n0, int tid) {
    BSrc2 s; const int c = (tid & 7) * 8;
    int n = n0 + (tid >> 3);
    int q0 = n < N ? n : N - 1, q1 = n + 64 < N ? n + 64 : N - 1, q2 = n + 128 < N ? n + 128 : N - 1, q3 = n + 192 < N ? n + 192 : N - 1;
    s.p0 = Bt + (long)q0 * ldb + c; s.p1 = Bt + (long)q1 * ldb + c; s.p2 = Bt + (long)q2 * ldb + c; s.p3 = Bt + (long)q3 * ldb + c; return s;
}
DI const bf16_t* a_ptr(const bf16_t* base, long lda, const int* rows, int M, int m0, int i, int tid) {
    int gm = m0 + (tid >> 3) + 64 * i;
    gm = gm < M ? gm : M - 1;
    const long src = rows ? (long)rows[gm] : (long)gm;
    return base + src * lda + (tid & 7) * 8;
}
DI ASrc make_a(const bf16_t* base, long lda, const int* rows, int M, int m0, int tid) {
    ASrc A; A.a0 = a_ptr(base, lda, rows, M, m0, 0, tid); A.a1 = a_ptr(base, lda, rows, M, m0, 1, tid);
    A.a2 = a_ptr(base, lda, rows, M, m0, 2, tid); A.a3 = a_ptr(base, lda, rows, M, m0, 3, tid); return A;
}
DI BSrcBf make_bbf(const bf16_t* Bt, long ldb, int N, int n0, int tid) {
    int n = n0 + (tid >> 3); int n1 = n + 64;
    n = n < N ? n : N - 1; n1 = n1 < N ? n1 : N - 1;
    BSrcBf s; s.p0 = Bt + (long)n * ldb + (tid & 7) * 8; s.p1 = Bt + (long)n1 * ldb + (tid & 7) * 8; return s;
}
template <class RM>
DI void tconv(const float* src, long sbatch, long sld, int K, int N, bf16_t* dst, long dbatch, long ldd, int nbatch, RM rm, int lo, long gtid, long gstride,
              const float* ks0 = nullptr, const float* ks1 = nullptr) {
    const long per = (long)N * (K >> 5), total = per * nbatch;
    for (long i = gtid; i < total; i += gstride) {
        const int bi = (int)(i / per); const long rem = i - (long)bi * per;
        const int k32 = (int)(rem / N), n = (int)(rem - (long)k32 * N);
        const float* sp = src + bi * sbatch + (long)(k32 * 32) * sld + n;
        float f[32];
#pragma unroll
        for (int j = 0; j < 32; ++j) f[j] = sp[(long)j * sld];
        if (lo) {
#pragma unroll
            for (int j = 0; j < 32; ++j) f[j] = f[j] - bf2f(f2bf(f[j]));
        }
        if (ks0) {
            const float* kp = (k32 * 32 < 512) ? ks0 + k32 * 32 : ks1 + k32 * 32 - 512;
#pragma unroll
            for (int j = 0; j < 32; ++j) f[j] *= kp[j];
        }
        bf16_t* dp = dst + bi * dbatch + (long)rm(n) * ldd + k32 * 32;
#pragma unroll
        for (int q = 0; q < 4; ++q) {
            u32x4 o; o.x = pk2(f[8 * q], f[8 * q + 1]); o.y = pk2(f[8 * q + 2], f[8 * q + 3]); o.z = pk2(f[8 * q + 4], f[8 * q + 5]); o.w = pk2(f[8 * q + 6], f[8 * q + 7]);
            *(u32x4*)(dp + 8 * q) = o;
        }
    }
}
struct RowId { DI int operator()(int n) const { return n; } };
struct RowGU { int tn; DI int operator()(int n) const { return (n >> 6) * 128 + ((n >> 5) & 1) * 64 + tn * 32 + (n & 31); } };
struct RowOff { int off; DI int operator()(int n) const { return n + off; } };

DI void cpow(float lr, float li, float step, int tau, float& re, float& im) {
    const float mag = expf(lr * step * (float)tau);
    const double ang = (double)li * (double)step * (double)tau;
    const double k = rint(ang * 0.15915494309189535);
    const float red = (float)(ang - k * 6.283185307179586);
    float sn, cs; sn = sinf(red); cs = cosf(red);
    re = mag * cs; im = mag * sn;
}
DI void phase0(const Params& P, unsigned char* lds_raw, int tid, int xmode = 0) {
    unsigned char* ws = P.ws;
    const int lane = tid & 63, wv = tid >> 6;
    const int G = gridDim.x, bid = blockIdx.x;
    if (xmode == 0 || xmode == 1) {
        const float* x = P.in[0]; const float* g1 = P.in[1];
        bf16_t* xn = (bf16_t*)(ws + OFF_XN);
        for (int row0 = (bid * 8 + wv) * 2; row0 < T; row0 += G * 16) {
            f32x4 v[2][4]; float s0 = 0.f, s1 = 0.f;
#pragma unroll
            for (int q = 0; q < 2; ++q) {
                const f32x4* xr = (const f32x4*)(x + (size_t)(row0 + q) * 1024) + lane;
#pragma unroll
                for (int j = 0; j < 4; ++j) v[q][j] = xr[64 * j];
            }
#pragma unroll
            for (int j = 0; j < 4; ++j) {
                s0 += v[0][j].x * v[0][j].x + v[0][j].y * v[0][j].y + v[0][j].z * v[0][j].z + v[0][j].w * v[0][j].w;
                s1 += v[1][j].x * v[1][j].x + v[1][j].y * v[1][j].y + v[1][j].z * v[1][j].z + v[1][j].w * v[1][j].w;
            }
            s0 = wave_sum(s0); s1 = wave_sum(s1);
            const float rs0 = rsqrtf(s0 * (1.f / 1024.f) + EPS), rs1 = rsqrtf(s1 * (1.f / 1024.f) + EPS);
#pragma unroll
            for (int j = 0; j < 4; ++j) {
                const f32x4 g = ((const f32x4*)g1)[lane + 64 * j];
                u32x2 o; o.x = pk2(v[0][j].x * rs0 * g.x, v[0][j].y * rs0 * g.y); o.y = pk2(v[0][j].z * rs0 * g.z, v[0][j].w * rs0 * g.w);
                *(u32x2*)(xn + (size_t)row0 * 1024 + lane * 4 + 256 * j) = o;
                o.x = pk2(v[1][j].x * rs1 * g.x, v[1][j].y * rs1 * g.y); o.y = pk2(v[1][j].z * rs1 * g.z, v[1][j].w * rs1 * g.w);
                *(u32x2*)(xn + (size_t)(row0 + 1) * 1024 + lane * 4 + 256 * j) = o;
            }
        }
    }
    if (xmode == 0 || xmode == 2) {
        const float* lam_re = P.in[3]; const float* lam_im = P.in[4]; const float* log_step = P.in[5];
        const float* b_re = P.in[6]; const float* b_im = P.in[7]; const float* c_re = P.in[8]; const float* c_im = P.in[9];
        float* pw_re = (float*)lds_raw;
        float* pw_im = pw_re + 64 * 33;
        float* bb_re = pw_im + 64 * 33;
        float* bb_im = bb_re + 1024;
        float* cc_re = bb_im + 1024;
        float* cc_im = cc_re + 64;
        float* Km = cc_im + 64;
        bf16_t* TgT = (bf16_t*)(ws + OFF_TGT); bf16_t* EgT = (bf16_t*)(ws + OFF_EGT); bf16_t* FgT = (bf16_t*)(ws + OFF_FGT);
        float* lam32 = (float*)(ws + OFF_LAM32);
        for (int u = bid; u < 512; u += G) {
            const int g = u >> 4, h = u & 15;
            const float step = expf(log_step[g]);
            __syncthreads();
            if (tid < 64) {
                const int p = tid;
                float ar, ai; cpow(lam_re[g * 64 + p], lam_im[g * 64 + p], step, 1, ar, ai);
                float zr = 1.f, zi = 0.f;
                for (int tau = 0; tau <= 32; ++tau) {
                    pw_re[p * 33 + tau] = zr; pw_im[p * 33 + tau] = zi;
                    const float nr = zr * ar - zi * ai, ni = zr * ai + zi * ar; zr = nr; zi = ni;
                }
                cc_re[tid] = c_re[(g * 16 + h) * 64 + tid]; cc_im[tid] = c_im[(g * 16 + h) * 64 + tid];
            }
            __syncthreads();
            for (int idx = tid; idx < 1024; idx += NTHREADS) {
                const int p = idx >> 4, hp = idx & 15;
                const float lr = lam_re[g * 64 + p], li = lam_im[g * 64 + p];
                const float re = pw_re[p * 33 + 1], im = pw_im[p * 33 + 1];
                const float nr = re - 1.f, ni = im, den = lr * lr + li * li;
                const float qr = (nr * lr + ni * li) / den, qi = (ni * lr - nr * li) / den;
                const float br = b_re[(g * 64 + p) * 16 + hp], bi = b_im[(g * 64 + p) * 16 + hp];
                bb_re[idx] = qr * br - qi * bi; bb_im[idx] = qr * bi + qi * br;
            }
            __syncthreads();
            {
                const int tau = tid >> 4, hp = tid & 15;
                float s = 0.f;
                for (int p = 0; p < 64; ++p) {
                    const float zr = cc_re[p] * pw_re[p * 33 + tau] - cc_im[p] * pw_im[p * 33 + tau];
                    const float zi = cc_re[p] * pw_im[p * 33 + tau] + cc_im[p] * pw_re[p * 33 + tau];
                    s += zr * bb_re[p * 16 + hp] - zi * bb_im[p * 16 + hp];
                }
                Km[tid] = s;
            }
            __syncthreads();
            for (int it = tid; it < 2048; it += NTHREADS) {
                const int t = it >> 6, q = it & 63, k = q >> 1, hp0 = (q & 1) * 8;
                u32x4 o = {0u, 0u, 0u, 0u};
                if (t >= k) { const float* km = Km + (t - k) * 16 + hp0; o.x = pk2(km[0], km[1]); o.y = pk2(km[2], km[3]); o.z = pk2(km[4], km[5]); o.w = pk2(km[6], km[7]); }
                *(u32x4*)(TgT + ((size_t)g * 512 + t * 16 + h) * 512 + q * 8) = o;
            }
            {
                const int t = tid >> 4, c = tid & 15;
                float f[8];
#pragma unroll
                for (int j = 0; j < 4; ++j) {
                    const int p = 4 * c + j;
                    const float zr = cc_re[p] * pw_re[p * 33 + t + 1] - cc_im[p] * pw_im[p * 33 + t + 1];
                    const float zi = cc_re[p] * pw_im[p * 33 + t + 1] + cc_im[p] * pw_re[p * 33 + t + 1];
                    f[2 * j] = zr; f[2 * j + 1] = -zi;
                }
                u32x4 o; o.x = pk2(f[0], f[1]); o.y = pk2(f[2], f[3]); o.z = pk2(f[4], f[5]); o.w = pk2(f[6], f[7]);
                *(u32x4*)(FgT + ((size_t)g * 512 + t * 16 + h) * 128 + c * 8) = o;
            }
            {
                const int nl = tid >> 6, q = tid & 63, p = 4 * h + (nl >> 1), ri = nl & 1, k = q >> 1, hp0 = (q & 1) * 8;
                const float ar = pw_re[p * 33 + 31 - k], ai = pw_im[p * 33 + 31 - k];
                float f[8];
#pragma unroll
                for (int j = 0; j < 8; ++j) {
                    const float br = bb_re[p * 16 + hp0 + j], bi = bb_im[p * 16 + hp0 + j];
                    f[j] = ri ? (ar * bi + ai * br) : (ar * br - ai * bi);
                }
                u32x4 o; o.x = pk2(f[0], f[1]); o.y = pk2(f[2], f[3]); o.z = pk2(f[4], f[5]); o.w = pk2(f[6], f[7]);
                *(u32x4*)(EgT + ((size_t)g * 128 + 2 * p + ri) * 512 + q * 8) = o;
            }
            if (h == 0 && tid < 64) { lam32[(g * 64 + tid) * 2] = pw_re[tid * 33 + 32]; lam32[(g * 64 + tid) * 2 + 1] = pw_im[tid * 33 + 32]; }
        }
        __syncthreads();
    }
    if (xmode == 0 || xmode == 3) {
        float* red = (float*)lds_raw;
        float* biasp = (float*)(ws + OFF_BIASP);
        for (int u = bid; u < 32; u += G) {
            const int kv = u >> 4, part = u & 15;
            const float* pos = P.in[kv ? 18 : 17]; const float* w1 = P.in[kv ? 21 : 19];
            const int n = tid & 255, half = tid >> 8;
            float s = 0.f;
            const int k0 = part * 128 + half * 64;
            for (int kk = k0; kk < k0 + 64; ++kk) s += pos[kk] * w1[(size_t)kk * 256 + n];
            __syncthreads();
            red[tid] = s;
            __syncthreads();
            if (tid < 256) biasp[(kv * 16 + part) * 256 + tid] = red[tid] + red[tid + 256];
        }
        __syncthreads();
    }
    if (xmode == 0 || xmode == 4) {
        const long gt = (long)bid * NTHREADS + tid, gs = (long)G * NTHREADS;
        tconv(P.in[2], 0, 1816, 1024, 1816, (bf16_t*)(ws + OFF_WINT), 0, 1024, 1, RowId(), 0, gt, gs);
        tconv(P.in[11], 0, 512, 512, 512, (bf16_t*)(ws + OFF_WGLUT), 0, 512, 1, RowId(), 0, gt, gs);
        tconv(P.in[19], (long)1024 * 256, 256, 1024, 256, (bf16_t*)(ws + OFF_WC1T), (long)256 * 1024, 1024, 2, RowId(), 0, gt, gs);
        tconv(P.in[21], (long)1024 * 256, 256, 1024, 256, (bf16_t*)(ws + OFF_WC1T) + (size_t)2 * 256 * 1024, (long)256 * 1024, 1024, 2, RowId(), 0, gt, gs);
        tconv(P.in[25], 0, 1024, 1024, 1024, (bf16_t*)(ws + OFF_WOUTT), 0, 1024, 1, RowId(), 0, gt, gs, P.in[23], P.in[24]);
        { float* ssq = (float*)(ws + OFF_SSQ); for (long i = gt; i < (long)T * 2; i += gs) ssq[i] = 0.f; }
        tconv(P.in[27], 0, 4, 1024, 4, (bf16_t*)(ws + OFF_WRT), 0, 1024, 1, RowId(), 0, gt, gs);
        tconv(P.in[29], 0, 32, 1024, 32, (bf16_t*)(ws + OFF_WRT), 0, 1024, 1, RowOff{4}, 0, gt, gs);
        tconv(P.in[27], 0, 4, 1024, 4, (bf16_t*)(ws + OFF_WRT) + 40 * 1024, 0, 1024, 1, RowId(), 1, gt, gs);
        tconv(P.in[29], 0, 32, 1024, 32, (bf16_t*)(ws + OFF_WRT) + 40 * 1024, 0, 1024, 1, RowOff{4}, 1, gt, gs);
    }
}

DI void epi_inproj(const Params& P, const float* Ct, int m0, int nt, int tid) {
    unsigned char* ws = P.ws;
    const int n0 = nt * 128;
    if (n0 < 512) {
        bf16_t* U = (bf16_t*)(ws + OFF_U);
        for (int it = tid; it < 2048; it += NTHREADS) {
            const int row = it >> 3, gi = it & 7;
            const float* s = Ct + row * CT_STRIDE + gi * 16;
            u32x4 o0, o1;
            o0.x = pk2(s[0], s[1]); o0.y = pk2(s[2], s[3]); o0.z = pk2(s[4], s[5]); o0.w = pk2(s[6], s[7]);
            o1.x = pk2(s[8], s[9]); o1.y = pk2(s[10], s[11]); o1.z = pk2(s[12], s[13]); o1.w = pk2(s[14], s[15]);
            bf16_t* d = U + ((size_t)((n0 >> 4) + gi) * T + m0 + row) * 16;
            *(u32x4*)d = o0; *(u32x4*)(d + 8) = o1;
        }
    } else if (n0 < 1792) {
        const int row = tid & 255, seg = tid >> 8;
        const int grow = m0 + row, b = grow >> 12, l = grow & 4095;
        const float* s = Ct + row * CT_STRIDE + seg * 64;
        const int kind = n0 < 1024 ? 0 : 1 + ((n0 - 1024) >> 7);
        if (kind == 4 || kind == 6) {
            bf16_t* dst = (bf16_t*)(ws + (kind == 4 ? OFF_VST : OFF_VWT));
            const int rl = tid & 63, cq = tid >> 6;
#pragma unroll 1
            for (int rr = 0; rr < 4; ++rr) {
                const int r2 = rl + 64 * rr, gr = m0 + r2, b2 = gr >> 12, l2 = gr & 4095;
#pragma unroll
                for (int cc = 0; cc < 16; ++cc) {
                    const int col = cq * 16 + cc, g = col >> 6, d = col & 63;
                    dst[((size_t)((b2 * 2 + g) * 64 + d)) * 4096 + l2] = (bf16_t)f2bf(Ct[r2 * CT_STRIDE + col]);
                }
            }
        } else {
            float scale = 1.f; const float* gw = nullptr; bf16_t* dst;
            if (kind == 0) { gw = P.in[13]; dst = (bf16_t*)(ws + OFF_QN) + (size_t)grow * 512 + (n0 - 512) + seg * 64; scale = 0.125f * 1.4426950408889634f; }
            else {
                const size_t off = kind == 1 ? OFF_KC : kind == 2 ? OFF_VC : kind == 3 ? OFF_KSN : OFF_KWN;
                dst = (bf16_t*)(ws + off) + ((size_t)((b * 2 + seg) * 4096 + l)) * 64;
                if (kind == 3) gw = P.in[15]; else if (kind == 5) gw = P.in[16];
            }
            float rs = 1.f;
            if (gw) {
                float ss = 0.f;
#pragma unroll
                for (int c4 = 0; c4 < 16; ++c4) { const f32x4 v = *(const f32x4*)(s + c4 * 4); ss += v.x * v.x + v.y * v.y + v.z * v.z + v.w * v.w; }
                rs = rsqrtf(ss * (1.f / 64.f) + EPS) * scale;
            }
#pragma unroll
            for (int c8 = 0; c8 < 8; ++c8) {
                f32x4 v0 = *(const f32x4*)(s + c8 * 8), v1 = *(const f32x4*)(s + c8 * 8 + 4);
                if (gw) {
                    const f32x4 g0 = *(const f32x4*)(gw + c8 * 8), g1 = *(const f32x4*)(gw + c8 * 8 + 4);
                    v0 = v0 * g0 * rs; v1 = v1 * g1 * rs;
                }
                u32x4 o; o.x = pk2(v0.x, v0.y); o.y = pk2(v0.z, v0.w); o.z = pk2(v1.x, v1.y); o.w = pk2(v1.z, v1.w);
                *(u32x4*)(dst + c8 * 8) = o;
            }
        }
    } else {
        if (tid < 256) {
            float* gates = (float*)(ws + OFF_GATES) + (size_t)(m0 + tid) * 24;
            const float* s = Ct + tid * CT_STRIDE;
#pragma unroll
            for (int c = 0; c < 24; ++c) gates[c] = sigmoidf(s[c]);
        }
    }
}
DI void phase1(const Params& P, unsigned char* lds_raw, int tid, int xmode = 0) {
    bf16_t* lds = (bf16_t*)lds_raw; float* Ct = (float*)lds_raw;
    const bf16_t* xn = (const bf16_t*)(P.ws + OFF_XN);
    const bf16_t* WinT = (const bf16_t*)(P.ws + OFF_WINT);
    for (int u = vbid(); u < 64 * 8; u += gridDim.x) {
        const int mt = u >> 3, nt2 = u & 7, m0 = mt * 256;
        f32x16 acc[2][4]; zero_acc2(acc);
        const ASrc A = make_a(xn, 1024, nullptr, T, m0, tid);
        const BSrc2 bs = make_b2(WinT, 1024, DIN, nt2 * 256, tid);
        __syncthreads();
        if (xmode != 4) gemm_mainloop2(acc, A, bs, 1024, lds, tid);
#pragma unroll 1
        for (int half = 0; half < 2; ++half) {
            const int nt = nt2 * 2 + half;
            if (nt * 128 >= DIN) break;
            if (xmode == 5) { if (tid == 0 && acc[0][0][0] + acc[1][3][5] + acc[0][1][1] + acc[1][2][7] + acc[0][2][3] + acc[0][3][9] + acc[1][0][4] + acc[1][1][2] == 12345.f) ((float*)P.ws)[1] = 1.f; continue; }
            dump_acc2(acc, Ct, tid, half);
            __syncthreads();
            epi_inproj(P, Ct, m0, nt, tid);
            __syncthreads();
        }
    }
    __syncthreads();
}

DI void st_wt8(void* p, u32x2 v) { asm volatile("global_store_dwordx2 %0, %1, off sc1\n\ts_nop 1" :: "v"(p), "v"(v) : "memory"); }
DI void st_wt16f(void* p, f32x4 v) { asm volatile("global_store_dwordx4 %0, %1, off sc1\n\ts_nop 1" :: "v"(p), "v"(v) : "memory"); }
DI void unit_signal(unsigned* ctr, int tid) {
    asm volatile("s_waitcnt vmcnt(0)" ::: "memory");
    __syncthreads();
    if (tid == 0) __hip_atomic_fetch_add(ctr, 1u, __ATOMIC_RELAXED, __HIP_MEMORY_SCOPE_AGENT);
}
DI void unit_wait2(unsigned* ctr, unsigned target, unsigned* ctr2, unsigned target2, int tid) {
    if (tid == 0) {
        unsigned sp = 0;
        while (__hip_atomic_load(ctr, __ATOMIC_RELAXED, __HIP_MEMORY_SCOPE_AGENT) < target) { __builtin_amdgcn_s_sleep(4); if (++sp > (1u << 22)) break; }
        if (ctr2) { sp = 0; while (__hip_atomic_load(ctr2, __ATOMIC_RELAXED, __HIP_MEMORY_SCOPE_AGENT) < target2) { __builtin_amdgcn_s_sleep(4); if (++sp > (1u << 22)) break; } }
        __builtin_amdgcn_fence(__ATOMIC_ACQUIRE, "agent");
        asm volatile("s_waitcnt vmcnt(0)" ::: "memory");
    }
    __syncthreads();
}
DI void unit_wait(unsigned* ctr, unsigned target, int tid) {
    if (tid == 0) {
        unsigned sp = 0;
        while (__hip_atomic_load(ctr, __ATOMIC_RELAXED, __HIP_MEMORY_SCOPE_AGENT) < target) { __builtin_amdgcn_s_sleep(4); if (++sp > (1u << 22)) break; }
        __builtin_amdgcn_fence(__ATOMIC_ACQUIRE, "agent");
        asm volatile("s_waitcnt vmcnt(0)" ::: "memory");
    }
    __syncthreads();
}
DI void mlp2_unit(const Params& P, unsigned char* lds_raw, int u, int tid) {
    unsigned char* ws = P.ws;
    {
        unit_wait((unsigned*)(ws + OFF_CTL) + CW_PDONE + (u >> 3), 4u, tid);
            const int idx = u, rc = idx & 7, bg = (idx >> 3) & 7, kv = idx >> 6;
            float* Hs = (float*)lds_raw;
            const float* Pt = (const float*)(ws + OFF_P) + ((size_t)((kv * 8 + bg) * 2 + 0) * 256) * 256;
            const float* Pb = (const float*)(ws + OFF_P) + ((size_t)((kv * 8 + bg) * 2 + 1) * 256) * 256;
            const float* biasp = (const float*)(ws + OFF_BIASP) + kv * 16 * 256;
            const int n = tid & 255;
            float bias = 0.f;
#pragma unroll
            for (int pp = 0; pp < 16; ++pp) bias += biasp[pp * 256 + n];
            for (int it = tid; it < 8192; it += NTHREADS) {
                const int rr = it >> 8, j = rc * 32 + rr;
                float hv = 0.f;
                if (j < 255) hv = gelu_tanh(Pt[j * 256 + n] + Pb[(j + 1) * 256 + n] + bias);
                Hs[rr * 256 + n] = hv;
            }
            __syncthreads();
            const int rr = tid >> 4, dq = tid & 15, j = rc * 32 + rr;
            const float* w2 = P.in[kv ? 22 : 20];
            f32x4 a = {0.f, 0.f, 0.f, 0.f};
            for (int k = 0; k < 256; ++k) {
                const float hv = Hs[rr * 256 + k];
                const f32x4 w = *(const f32x4*)(w2 + k * 64 + dq * 4);
                a = a + w * hv;
            }
            if (kv == 0) {
                float ss = a.x * a.x + a.y * a.y + a.z * a.z + a.w * a.w;
                ss += __shfl_xor(ss, 1); ss += __shfl_xor(ss, 2); ss += __shfl_xor(ss, 4); ss += __shfl_xor(ss, 8);
                const float rs = rsqrtf(ss * (1.f / 64.f) + EPS);
                const f32x4 g = *(const f32x4*)(P.in[14] + dq * 4);
                u32x2 o; o.x = pk2(a.x * rs * g.x, a.y * rs * g.y); o.y = pk2(a.z * rs * g.z, a.w * rs * g.w);
                if (j == 255) { o.x = 0u; o.y = 0u; }
                *(u32x2*)((bf16_t*)(ws + OFF_KCMP) + ((size_t)bg * 256 + j) * 64 + dq * 4) = o;
            } else {
                bf16_t* vt = (bf16_t*)(ws + OFF_VCMPT) + (size_t)bg * 64 * 256;
                if (j == 255) a = (f32x4){0.f, 0.f, 0.f, 0.f};
                vt[(dq * 4 + 0) * 256 + j] = (bf16_t)f2bf(a.x); vt[(dq * 4 + 1) * 256 + j] = (bf16_t)f2bf(a.y);
                vt[(dq * 4 + 2) * 256 + j] = (bf16_t)f2bf(a.z); vt[(dq * 4 + 3) * 256 + j] = (bf16_t)f2bf(a.w);
            }
    }
    __syncthreads();
}
DI void phase2(const Params& P, unsigned char* lds_raw, int tid) {
    bf16_t* lds = (bf16_t*)lds_raw; float* Ct = (float*)lds_raw;
    unsigned char* ws = P.ws;
    {
        const int G = gridDim.x, nh = G > 128 ? G - 128 : G, hid = G > 128 ? vbid() - 128 : vbid();
        if (hid >= 0) {
            const long gt = (long)hid * NTHREADS + tid, gs = (long)nh * NTHREADS;
            tconv(P.in[31], (long)1024 * 256, 256, 1024, 256, (bf16_t*)(ws + OFF_WGUT), (long)512 * 1024, 1024, 32, RowGU{0}, 0, gt, gs);
            tconv(P.in[32], (long)1024 * 256, 256, 1024, 256, (bf16_t*)(ws + OFF_WGUT), (long)512 * 1024, 1024, 32, RowGU{1}, 0, gt, gs);
            tconv(P.in[33], (long)256 * 1024, 1024, 256, 1024, (bf16_t*)(ws + OFF_WDT), (long)1024 * 256, 256, 32, RowId(), 0, gt, gs);
        }
    }
    for (int u = vbid(); u < 128; u += gridDim.x) {
        f32x16 acc[2][2]; zero_acc(acc);
        if (u < 64) {
            const int g = u >> 1, mt = u & 1, m0 = mt * 256;
            const bf16_t* A = (const bf16_t*)(ws + OFF_U) + (size_t)g * T * 16;
            const ASrc As = make_a(A, 512, nullptr, 512, m0, tid);
            const BSrcBf bs = make_bbf((const bf16_t*)(ws + OFF_EGT) + (size_t)g * 128 * 512, 512, 128, 0, tid);
            __syncthreads();
            gemm_mainloop(acc, As, bs, 512, lds, tid);
            dump_acc(acc, Ct, tid);
            __syncthreads();
            if (tid < 128) {
                const int bb = tid >> 6, p = tid & 63;
                const float* lam32 = (const float*)(ws + OFF_LAM32) + (g * 64 + p) * 2;
                const float ar = lam32[0], ai = lam32[1];
                float sr = 0.f, si = 0.f;
                float* zp = Ct + (bb * 128) * CT_STRIDE + 2 * p;
                for (int c = 0; c < 128; ++c) {
                    const float zr = zp[c * CT_STRIDE], zi = zp[c * CT_STRIDE + 1];
                    zp[c * CT_STRIDE] = sr; zp[c * CT_STRIDE + 1] = si;
                    const float nr = ar * sr - ai * si + zr, ni = ar * si + ai * sr + zi;
                    sr = nr; si = ni;
                }
            }
            __syncthreads();
            bf16_t* Sin = (bf16_t*)(ws + OFF_SIN) + ((size_t)g * 512 + m0) * 128;
            for (int it = tid; it < 256 * 16; it += NTHREADS) {
                const int row = it >> 4, c8 = it & 15;
                const float* sp = Ct + row * CT_STRIDE + c8 * 8;
                u32x4 o; o.x = pk2(sp[0], sp[1]); o.y = pk2(sp[2], sp[3]); o.z = pk2(sp[4], sp[5]); o.w = pk2(sp[6], sp[7]);
                *(u32x4*)(Sin + row * 128 + c8 * 8) = o;
            }
        } else {
            const int idx = u - 64, nt = idx & 1, part = (idx >> 1) & 1, bg = (idx >> 2) & 7, kv = idx >> 5;
            const bf16_t* A = (const bf16_t*)(ws + (kv ? OFF_VC : OFF_KC)) + (size_t)bg * 4096 * 64;
            const ASrc As = make_a(A, 1024, nullptr, 256, 0, tid);
            const BSrcBf bs = make_bbf((const bf16_t*)(ws + OFF_WC1T) + (size_t)(kv * 2 + part) * 256 * 1024, 1024, 256, nt * 128, tid);
            __syncthreads();
            gemm_mainloop(acc, As, bs, 1024, lds, tid);
            dump_acc(acc, Ct, tid);
            __syncthreads();
            float* Pp = (float*)(ws + OFF_P) + ((size_t)((kv * 8 + bg) * 2 + part) * 256) * 256 + nt * 128;
            for (int it = tid; it < 256 * 32; it += NTHREADS) {
                const int row = it >> 5, c4 = it & 31;
                st_wt16f(Pp + row * 256 + c4 * 4, *(const f32x4*)(Ct + row * CT_STRIDE + c4 * 4));
            }
            unit_signal((unsigned*)(ws + OFF_CTL) + CW_PDONE + kv * 8 + bg, tid);
        }
    }
    for (int u = vbid(); u < 128; u += gridDim.x) mlp2_unit(P, lds_raw, u, tid);
    __syncthreads();
}

DI void s5_main_unit(const Params& P, unsigned char* lds_raw, int u, int tid) {
    bf16_t* lds = (bf16_t*)lds_raw; float* Ct = (float*)lds_raw;
    unsigned char* ws = P.ws;
    const int nt = u & 3, mt = (u >> 2) & 1, g = u >> 3, m0 = mt * 256, n0 = nt * 128;
    f32x16 acc[2][2]; zero_acc(acc);
    const bf16_t* Ug = (const bf16_t*)(ws + OFF_U) + (size_t)g * T * 16;
    {
        const ASrc As = make_a(Ug, 512, nullptr, 512, m0, tid);
        const BSrcBf bs = make_bbf((const bf16_t*)(ws + OFF_TGT) + (size_t)g * 512 * 512, 512, 512, n0, tid);
        __syncthreads();
        gemm_mainloop(acc, As, bs, 512, lds, tid);
    }
    {
        const bf16_t* S = (const bf16_t*)(ws + OFF_SIN) + (size_t)g * 512 * 128;
        const ASrc As = make_a(S, 128, nullptr, 512, m0, tid);
        const BSrcBf bs = make_bbf((const bf16_t*)(ws + OFF_FGT) + (size_t)g * 512 * 128, 128, 512, n0, tid);
        gemm_mainloop(acc, As, bs, 128, lds, tid);
    }
    dump_acc(acc, Ct, tid);
    __syncthreads();
    const float* dsk = P.in[10] + g * 16;
    bf16_t* y1 = (bf16_t*)(ws + OFF_Y1);
    for (int it = tid; it < 2048; it += NTHREADS) {
        const int row = it >> 3, tt = it & 7;
        const int token = 32 * (m0 + row) + (n0 >> 4) + tt;
        const float* s = Ct + row * CT_STRIDE + tt * 16;
        const u32x4 u0 = *(const u32x4*)(Ug + (size_t)token * 16), u1 = *(const u32x4*)(Ug + (size_t)token * 16 + 8);
        const unsigned uw[8] = {u0.x, u0.y, u0.z, u0.w, u1.x, u1.y, u1.z, u1.w};
        unsigned ow[8];
#pragma unroll
        for (int q = 0; q < 8; ++q) {
            const float ua = bf2f(uw[q] & 0xffffu), ub = bf2f(uw[q] >> 16);
            const float ya = gelu_tanh(s[2 * q] + dsk[2 * q] * ua), yb = gelu_tanh(s[2 * q + 1] + dsk[2 * q + 1] * ub);
            ow[q] = pk2(ya, yb);
        }
        bf16_t* d = y1 + (size_t)token * 512 + g * 16;
        *(u32x4*)d = (u32x4){ow[0], ow[1], ow[2], ow[3]}; *(u32x4*)(d + 8) = (u32x4){ow[4], ow[5], ow[6], ow[7]};
    }
}

constexpr int KSTR = 72, VSTR = 68;
constexpr int KSLOT = 64 * KSTR, VSLOT = 64 * VSTR;
constexpr int AT_KBUF = 0;
constexpr int AT_VBUF = AT_KBUF + 3 * KSLOT * 2;
constexpr int VCSTR = 260;
constexpr int AT_CK   = 0;
constexpr int AT_CV   = AT_CK + 256 * KSTR * 2;
constexpr int AT_RING_END = AT_VBUF + 3 * VSLOT * 2;
constexpr int AT_CEND = AT_CV + 64 * VCSTR * 2;
constexpr int AT_IMP  = (AT_CEND > AT_RING_END ? AT_CEND : AT_RING_END);
constexpr int IMPS = 65;
constexpr int AT_MASK = AT_IMP + 4 * 64 * IMPS * 4;
constexpr int AT_INVL = AT_MASK + 64 * 8;
constexpr int AT_END  = AT_INVL + 256 * 4;

struct KVRegs { u32x4 k; u32x4 v; };
DI void kv_load(KVRegs& r, const bf16_t* Kt, const bf16_t* Vt, long ldv, int tid) {
    r.k = *(const u32x4*)(Kt + (tid >> 3) * 64 + (tid & 7) * 8);
    r.v = *(const u32x4*)(Vt + (long)(tid >> 3) * ldv + (tid & 7) * 8);
}
DI void kv_store(const KVRegs& r, bf16_t* Kb, bf16_t* Vb, int tid) {
    *(u32x4*)(Kb + (tid >> 3) * KSTR + (tid & 7) * 8) = r.k;
    u32x2 lo, hi; lo.x = r.v.x; lo.y = r.v.y; hi.x = r.v.z; hi.y = r.v.w;
    *(u32x2*)(Vb + (tid >> 3) * VSTR + (tid & 7) * 8) = lo;
    *(u32x2*)(Vb + (tid >> 3) * VSTR + (tid & 7) * 8 + 4) = hi;
}
DI bf16x8 pack8(const f32x16& x, int s) {
    u32x4 p;
    p.x = pk2(x[8 * s], x[8 * s + 1]); p.y = pk2(x[8 * s + 2], x[8 * s + 3]); p.z = pk2(x[8 * s + 4], x[8 * s + 5]); p.w = pk2(x[8 * s + 6], x[8 * s + 7]);
    return __builtin_bit_cast(bf16x8, p);
}
DI void qk_tile(f32x16 (&S)[2], const bf16_t* Kb, const bf16x8 (&qf)[4], int r, int h, bool edge, int d0, int dmax, int pm) {
    const int NEGB = __builtin_bit_cast(int, -1e30f);
    if (edge) {
#pragma unroll
        for (int kh = 0; kh < 2; ++kh)
#pragma unroll
            for (int i = 0; i < 16; ++i) {
                const int d = d0 - (32 * kh + (i & 3) + 8 * (i >> 2));
                const int m = (d >> 31) | ((dmax - d) >> 31) | pm;
                S[kh][i] = __builtin_bit_cast(float, m & NEGB);
            }
    } else {
        const float iv = __builtin_bit_cast(float, pm & NEGB);
#pragma unroll
        for (int kh = 0; kh < 2; ++kh)
#pragma unroll
            for (int i = 0; i < 16; ++i) S[kh][i] = iv;
    }
    bf16x8 kf[2][4];
#pragma unroll
    for (int kh = 0; kh < 2; ++kh)
#pragma unroll
        for (int s = 0; s < 4; ++s) kf[kh][s] = *(const bf16x8*)(Kb + (32 * kh + r) * KSTR + 16 * s + 8 * h);
    asm volatile("" ::: "memory");
#pragma unroll
    for (int s = 0; s < 4; ++s)
#pragma unroll
        for (int kh = 0; kh < 2; ++kh) S[kh] = MFMA32(kf[kh][s], qf[s], S[kh]);
}
#ifndef AT_X
#define AT_X 0
#endif
DI void softmax_tile(f32x16 (&S)[2], float& lsum, int ax = 0) {
    float ls = 0.f;
#pragma unroll
    for (int kh = 0; kh < 2; ++kh)
#pragma unroll
        for (int i = 0; i < 16; ++i) { const float p = (ax == 1) ? S[kh][i] * 0.001f : __builtin_amdgcn_exp2f(S[kh][i]); S[kh][i] = p; ls += p; }
    lsum += ls;
}
DI void pv_tile(f32x16 (&O)[2], const f32x16 (&Pm)[2], const bf16_t* Vb, int r, int h) {
    bf16x8 vf[2][2][2];
#pragma unroll
    for (int kh = 0; kh < 2; ++kh)
#pragma unroll
        for (int sp = 0; sp < 2; ++sp)
#pragma unroll
            for (int dh = 0; dh < 2; ++dh) {
                const bf16_t* vp = Vb + (32 * dh + r) * VSTR + 32 * kh + 16 * sp + 4 * h;
                const s16x4 lo = *(const s16x4*)vp, hi = *(const s16x4*)(vp + 8);
                vf[kh][sp][dh] = __builtin_shufflevector(lo, hi, 0, 1, 2, 3, 4, 5, 6, 7);
            }
    asm volatile("" ::: "memory");
#pragma unroll
    for (int kh = 0; kh < 2; ++kh)
#pragma unroll
        for (int sp = 0; sp < 2; ++sp) {
            const bf16x8 pf = pack8(Pm[kh], sp);
#pragma unroll
            for (int dh = 0; dh < 2; ++dh) O[dh] = MFMA32(vf[kh][sp][dh], pf, O[dh]);
        }
}
DI void pv_tile_c(f32x16 (&O)[2], const f32x16 (&Pm)[2], const bf16_t* Vc, int kt, int r, int h) {
    bf16x8 vf[2][2][2];
#pragma unroll
    for (int kh = 0; kh < 2; ++kh)
#pragma unroll
        for (int sp = 0; sp < 2; ++sp)
#pragma unroll
            for (int dh = 0; dh < 2; ++dh) {
                const bf16_t* vp = Vc + (32 * dh + r) * VCSTR + 64 * kt + 32 * kh + 16 * sp + 4 * h;
                const s16x4 lo = *(const s16x4*)vp, hi = *(const s16x4*)(vp + 8);
                vf[kh][sp][dh] = __builtin_shufflevector(lo, hi, 0, 1, 2, 3, 4, 5, 6, 7);
            }
    asm volatile("" ::: "memory");
#pragma unroll
    for (int kh = 0; kh < 2; ++kh)
#pragma unroll
        for (int sp = 0; sp < 2; ++sp) {
            const bf16x8 pf = pack8(Pm[kh], sp);
#pragma unroll
            for (int dh = 0; dh < 2; ++dh) O[dh] = MFMA32(vf[kh][sp][dh], pf, O[dh]);
        }
}
struct SeqBits { unsigned long long rem; DI int pop() { if (rem == 0ull) return -1; const int k = __builtin_ctzll(rem); rem &= rem - 1; return k; } };
struct SeqDown { int cur, lo; DI int pop() { if (cur < lo) return -1; return cur--; } };
template <int BR, class Seq>
DI void attn_stream(f32x16 (&O)[2], float& lsum, Seq seq, const bf16_t* Kg, const bf16_t* Vg, bf16_t* Kbuf, bf16_t* Vbuf,
                    const bf16x8 (&qf)[4], int qt, int tq, unsigned long long mymask, int r, int h, int tid, int ax = 0) {
#define AT_QK(SREG, T, SLOT) do { const int _t = (T); const bool _edge = (_t == qt) || (BR == 2 && _t == qt - 8); \
        const int _pm = (BR == 1) ? ((int)((mymask >> _t) & 1ull) - 1) : 0; int _d0 = tq - 64 * _t - 4 * h; asm volatile("" : "+v"(_d0)); \
        qk_tile(SREG, Kbuf + (SLOT) * KSLOT, qf, r, h, _edge, _d0, BR == 2 ? 511 : 0x3fffffff, _pm); } while (0)
    int t0 = seq.pop(), t1 = seq.pop(), t2 = seq.pop();
    KVRegs R0;
    {
        KVRegs R1;
        kv_load(R0, Kg + (size_t)t0 * 64 * 64, Vg + t0 * 64, 4096, tid);
        if (t1 >= 0) kv_load(R1, Kg + (size_t)t1 * 64 * 64, Vg + t1 * 64, 4096, tid);
        kv_store(R0, Kbuf, Vbuf, tid);
        if (t1 >= 0) kv_store(R1, Kbuf + KSLOT, Vbuf + VSLOT, tid);
    }
    __syncthreads();
    f32x16 Sc[2], Sn[2];
    AT_QK(Sc, t0, 0);
    int sl = 0;
    while (true) {
        const int s1 = sl == 2 ? 0 : sl + 1, s2 = s1 == 2 ? 0 : s1 + 1;
        if (t2 >= 0 && ax != 3 && ax < 7) kv_load(R0, Kg + (size_t)t2 * 64 * 64, Vg + t2 * 64, 4096, tid);
        if (ax == 7) { lsum += (float)t0; }
        else if (ax == 8) { if (t1 >= 0) AT_QK(Sn, t1, s1); lsum += Sn[0][0] + Sn[1][5]; }
        else if (ax == 9) { softmax_tile(Sc, lsum, 0); pv_tile(O, Sc, Vbuf + sl * VSLOT, r, h); Sn[0] = Sc[0]; Sn[1] = Sc[1]; }
        else {
        if (t1 >= 0) AT_QK(Sn, t1, s1);
        softmax_tile(Sc, lsum, ax);
        if (ax != 2) pv_tile(O, Sc, Vbuf + sl * VSLOT, r, h);
        else { O[0][0] += Sc[0][3] + Sc[1][7]; }
        }
        if (t2 >= 0 && ax < 7) kv_store(R0, Kbuf + s2 * KSLOT, Vbuf + s2 * VSLOT, tid);
        if (ax != 5 && ax < 7) __syncthreads();
        if (t1 < 0) break;
#pragma unroll
        for (int kh = 0; kh < 2; ++kh) Sc[kh] = Sn[kh];
        t0 = t1; t1 = t2; t2 = seq.pop(); sl = s1;
    }
#undef AT_QK
}

DI void attn_unit(const Params& P, unsigned char* lds_raw, int a, int tid, bool dry = false, int ax = 0) {
    unsigned char* ws = P.ws;
    const int qt = 63 - (a >> 3), bg = a & 7, b = bg >> 1, g = bg & 1;
    const int lane = tid & 63, w = tid >> 6, r = lane & 31, h = lane >> 5;
    const int hh = w >> 1, th = w & 1;
    const int t0 = qt * 64;
    const int tql = 32 * th + r;
    const int tq = t0 + tql;
    const size_t tqg = (size_t)b * 4096 + tq;
    bf16_t* Kbuf = (bf16_t*)(lds_raw + AT_KBUF);
    bf16_t* Vbuf = (bf16_t*)(lds_raw + AT_VBUF);
    float* imp = (float*)(lds_raw + AT_IMP);
    unsigned long long* selm = (unsigned long long*)(lds_raw + AT_MASK);
    float* invl = (float*)(lds_raw + AT_INVL);

    bf16x8 qf[4];
    {
        const bf16_t* qp = (const bf16_t*)(ws + OFF_QN) + tqg * 512 + g * 256 + hh * 64 + 8 * h;
#pragma unroll
        for (int s = 0; s < 4; ++s) qf[s] = *(const bf16x8*)(qp + 16 * s);
    }
    const float* gp = (const float*)(ws + OFF_GATES) + tqg * 24 + g * 12 + hh * 3;
    const float gate_c = gp[0], gate_s = gp[1], gate_w = gp[2];

    const bf16_t* Kc = (const bf16_t*)(ws + OFF_KCMP) + (size_t)bg * 256 * 64;
    const bf16_t* Vc = (const bf16_t*)(ws + OFF_VCMPT) + (size_t)bg * 64 * 256;
    int ncmp = (4 * qt + 2) / 64 + 1; if (ncmp > 4) ncmp = 4;
    u32x4 kq[4], vq[4];
#pragma unroll
    for (int i = 0; i < 4; ++i) if (i < ncmp) {
        kq[i] = *(const u32x4*)(Kc + (size_t)(64 * i + (tid >> 3)) * 64 + (tid & 7) * 8);
        vq[i] = *(const u32x4*)(Vc + (size_t)(tid >> 3) * 256 + 64 * i + (tid & 7) * 8);
    }
    __syncthreads();
    float* impw = imp + ((hh * 64 + 32 * th) * IMPS);
    for (int i = lane; i < 32 * IMPS; i += 64) impw[i] = 0.f;
    f32x16 O[2];
#pragma unroll
    for (int dh = 0; dh < 2; ++dh)
#pragma unroll
        for (int i = 0; i < 16; ++i) O[dh][i] = 0.f;
    float inv_c;
    {
        float lsum = 0.f;
        bf16_t* Kcl = (bf16_t*)(lds_raw + AT_CK); bf16_t* Vcl = (bf16_t*)(lds_raw + AT_CV);
        {
#pragma unroll
            for (int i = 0; i < 4; ++i) if (i < ncmp) {
                *(u32x4*)(Kcl + (64 * i + (tid >> 3)) * KSTR + (tid & 7) * 8) = kq[i];
                bf16_t* vd = Vcl + (tid >> 3) * VCSTR + 64 * i + (tid & 7) * 8;
                u32x2 t; t.x = vq[i].x; t.y = vq[i].y; *(u32x2*)vd = t; t.x = vq[i].z; t.y = vq[i].w; *(u32x2*)(vd + 4) = t;
            }
        }
        __syncthreads();
        int jmax = tq >= 31 ? ((tq - 31) >> 4) : -1; jmax = jmax < 254 ? jmax : 254;
        for (int kt = 0; kt < ncmp; ++kt) {
            f32x16 S[2];
            qk_tile(S, Kcl + kt * 64 * KSTR, qf, r, h, true, jmax - 64 * kt - 4 * h, 0x3fffffff, 0);
            softmax_tile(S, lsum);
            float* ir = impw + r * IMPS + 16 * kt + h;
#pragma unroll
            for (int kh = 0; kh < 2; ++kh)
#pragma unroll
                for (int gq = 0; gq < 4; ++gq)
                    ir[8 * kh + 2 * gq] += (S[kh][4 * gq] + S[kh][4 * gq + 1]) + (S[kh][4 * gq + 2] + S[kh][4 * gq + 3]);
            asm volatile("s_waitcnt lgkmcnt(0)" ::: "memory");
#pragma unroll
            for (int kh = 0; kh < 2; ++kh)
#pragma unroll
                for (int gq = 0; gq < 4; ++gq) {
                    const int sl = 8 * kh + 2 * gq + 1;
                    if (16 * kt + h + sl < 64) ir[sl] += S[kh][4 * gq + 3];
                }
            asm volatile("s_waitcnt lgkmcnt(0)" ::: "memory");
            pv_tile_c(O, S, Vcl, kt, r, h);
        }
        lsum += __shfl_xor(lsum, 32);
        inv_c = lsum > 0.f ? 1.f / lsum : 0.f;
        if (h == 0) invl[hh * 64 + tql] = inv_c;
    }
    __syncthreads();
    {
        const int cur = qt;
        const bool forced = (lane == 0) || (lane == cur) || (lane == cur - 1);
        const bool valid = lane <= cur;
        unsigned key[8]; unsigned thr[8];
#pragma unroll
        for (int i = 0; i < 8; ++i) {
            const int tl = w * 8 + i;
            const float v = (imp[(0 * 64 + tl) * IMPS + lane] * invl[tl] + imp[(1 * 64 + tl) * IMPS + lane] * invl[64 + tl]) + (imp[(2 * 64 + tl) * IMPS + lane] * invl[128 + tl] + imp[(3 * 64 + tl) * IMPS + lane] * invl[192 + tl]);
            key[i] = forced ? 0xFFFFFFFFu : (valid ? __builtin_bit_cast(unsigned, v) : 0u);
            thr[i] = 0u;
        }
#pragma unroll 1
        for (int bit = 30; bit >= 0; --bit) {
#pragma unroll
            for (int i = 0; i < 8; ++i) {
                const unsigned cand = thr[i] | (1u << bit);
                if (__popcll(__ballot(key[i] >= cand)) >= 16) thr[i] = cand;
            }
        }
#pragma unroll
        for (int i = 0; i < 8; ++i) {
            const int tl = w * 8 + i;
            const unsigned long long gtm = __ballot(key[i] > thr[i]), eqm = __ballot(key[i] == thr[i]);
            const int need = 16 - __popcll(gtm);
            const bool sel = (key[i] > thr[i]) || ((key[i] == thr[i]) && (__popcll(eqm & ((1ull << lane) - 1ull)) < need));
            const unsigned long long mask = __ballot(sel);
            if (lane == 0) selm[tl] = mask;
        }
    }
    __syncthreads();
    float* accw = imp + (w * 32) * 64 + lane;
    {
        const float g_cmp = gate_c * inv_c;
#pragma unroll
        for (int dh = 0; dh < 2; ++dh)
#pragma unroll
            for (int i = 0; i < 16; ++i) accw[(dh * 16 + i) * 64] = g_cmp * O[dh][i];
    }
    const unsigned long long mymask = selm[tql];
    unsigned long long ormask = selm[lane];
#pragma unroll
    for (int o = 1; o < 64; o <<= 1) ormask |= __shfl_xor(ormask, o);
    ormask &= (qt >= 63) ? ~0ull : ((1ull << (qt + 1)) - 1ull);
    ormask |= 1ull;
    {
        const bf16_t* Ks = (const bf16_t*)(ws + OFF_KSN) + (size_t)bg * 4096 * 64;
        const bf16_t* Vs = (const bf16_t*)(ws + OFF_VST) + (size_t)bg * 64 * 4096;
#pragma unroll
        for (int dh = 0; dh < 2; ++dh)
#pragma unroll
            for (int i = 0; i < 16; ++i) O[dh][i] = 0.f;
        float l = 0.f;
        if (ax != 4) attn_stream<1>(O, l, SeqBits{ormask}, Ks, Vs, Kbuf, Vbuf, qf, qt, tq, mymask, r, h, tid, ax); else l = 1.f;
        l += __shfl_xor(l, 32);
        const float sc = gate_s / l;
#pragma unroll
        for (int dh = 0; dh < 2; ++dh)
#pragma unroll
            for (int i = 0; i < 16; ++i) accw[(dh * 16 + i) * 64] += sc * O[dh][i];
    }
    {
        const bf16_t* Kw = (const bf16_t*)(ws + OFF_KWN) + (size_t)bg * 4096 * 64;
        const bf16_t* Vw = (const bf16_t*)(ws + OFF_VWT) + (size_t)bg * 64 * 4096;
#pragma unroll
        for (int dh = 0; dh < 2; ++dh)
#pragma unroll
            for (int i = 0; i < 16; ++i) O[dh][i] = 0.f;
        float l = 0.f;
        if (ax != 4) attn_stream<2>(O, l, SeqDown{qt, qt >= 8 ? qt - 8 : 0}, Kw, Vw, Kbuf, Vbuf, qf, qt, tq, 0ull, r, h, tid, ax); else l = 1.f;
        l += __shfl_xor(l, 32);
        const float sc = gate_w / l;
        bf16_t* dst = (bf16_t*)(ws + OFF_XN) + tqg * 1024 + 512 + g * 256 + hh * 64;
        float sq = 0.f;
#pragma unroll
        for (int dh = 0; dh < 2; ++dh)
#pragma unroll
            for (int gq = 0; gq < 4; ++gq) {
                const float o0 = accw[(dh * 16 + 4 * gq + 0) * 64] + sc * O[dh][4 * gq + 0];
                const float o1 = accw[(dh * 16 + 4 * gq + 1) * 64] + sc * O[dh][4 * gq + 1];
                const float o2 = accw[(dh * 16 + 4 * gq + 2) * 64] + sc * O[dh][4 * gq + 2];
                const float o3 = accw[(dh * 16 + 4 * gq + 3) * 64] + sc * O[dh][4 * gq + 3];
                u32x2 o; o.x = pk2(o0, o1); o.y = pk2(o2, o3);
                if (ax == 0 || o.x == 0x12345678u) *(u32x2*)(dst + 32 * dh + 8 * gq + 4 * h) = o;
                sq += (o0 * o0 + o1 * o1) + (o2 * o2 + o3 * o3);
            }
        sq += __shfl_xor(sq, 32);
        if (h == 0 && !dry) __hip_atomic_fetch_add((float*)(ws + OFF_SSQ) + tqg * 2 + 1, sq, __ATOMIC_RELAXED, __HIP_MEMORY_SCOPE_AGENT);
    }
}
DI void phase4(const Params& P, unsigned char* lds_raw, int tid, int xmode = 0) {
    for (int b = blockIdx.x; b < 256; b += gridDim.x) {
        if (xmode == 2) break;
        attn_unit(P, lds_raw, b, tid, xmode != 0, xmode >= 10 ? xmode - 10 : 0);
        attn_unit(P, lds_raw, 504 - 8 * (b >> 3) + (b & 7), tid, xmode != 0, xmode >= 10 ? xmode - 10 : 0);
    }
    if (xmode != 1 && xmode < 10) for (int u = vbid(); u < 256; u += gridDim.x) s5_main_unit(P, lds_raw, u, tid);
    __syncthreads();
}

DI void phase5(const Params& P, unsigned char* lds_raw, int tid) {
    bf16_t* lds = (bf16_t*)lds_raw; float* Ct = (float*)lds_raw;
    unsigned char* ws = P.ws;
    const bf16_t* y1 = (const bf16_t*)(ws + OFF_Y1);
    for (int u = vbid(); u < 256; u += gridDim.x) {
        const int mt = u >> 2, nt = u & 3, m0 = mt * 256, n0 = nt * 128;
        f32x16 acc[2][2]; zero_acc(acc);
        const ASrc As = make_a(y1, 512, nullptr, T, m0, tid);
        const BSrcBf bs = make_bbf((const bf16_t*)(ws + OFF_WGLUT), 512, 512, n0, tid);
        __syncthreads();
        gemm_mainloop(acc, As, bs, 512, lds, tid);
        dump_acc(acc, Ct, tid);
        __syncthreads();
        const float* bglu = P.in[12];
        bf16_t* mix = (bf16_t*)(ws + OFF_XN);
        for (int it = tid; it < 256 * 32; it += NTHREADS) {
            const int row = it >> 5, c4 = it & 31, n = n0 + c4 * 4;
            const f32x4 v = *(const f32x4*)(Ct + row * CT_STRIDE + c4 * 4);
            const f32x4 bb = *(const f32x4*)(bglu + n);
            const u32x2 yy = *(const u32x2*)(y1 + (size_t)(m0 + row) * 512 + n);
            const float y0 = bf2f(yy.x & 0xffffu), y1v = bf2f(yy.x >> 16), y2 = bf2f(yy.y & 0xffffu), y3 = bf2f(yy.y >> 16);
            const float o0 = y0 * sigmoidf(v.x + bb.x), o1 = y1v * sigmoidf(v.y + bb.y), o2 = y2 * sigmoidf(v.z + bb.z), o3 = y3 * sigmoidf(v.w + bb.w);
            u32x2 o; o.x = pk2(o0, o1); o.y = pk2(o2, o3);
            *(u32x2*)(mix + (size_t)(m0 + row) * 1024 + n) = o;
            float sq = (o0 * o0 + o1 * o1) + (o2 * o2 + o3 * o3);
            sq += __shfl_xor(sq, 1); sq += __shfl_xor(sq, 2); sq += __shfl_xor(sq, 4); sq += __shfl_xor(sq, 8); sq += __shfl_xor(sq, 16);
            if ((tid & 31) == 0) __hip_atomic_fetch_add((float*)(ws + OFF_SSQ) + (size_t)(m0 + row) * 2, sq, __ATOMIC_RELAXED, __HIP_MEMORY_SCOPE_AGENT);
        }
    }
    __syncthreads();
}
DI void phase6(const Params& P, int tid, bool dry = false) {
    const int lane = tid & 63, wv = tid >> 6;
    bf16_t* mix = (bf16_t*)(P.ws + OFF_XN);
    for (int row = blockIdx.x * 8 + wv; row < T; row += gridDim.x * 8) {
#pragma unroll
        for (int seg = 0; seg < 2; ++seg) {
            bf16_t* p = mix + (size_t)row * 1024 + seg * 512 + lane * 8;
            const u32x4 v = *(const u32x4*)p;
            float f[8] = {bf2f(v.x & 0xffffu), bf2f(v.x >> 16), bf2f(v.y & 0xffffu), bf2f(v.y >> 16), bf2f(v.z & 0xffffu), bf2f(v.z >> 16), bf2f(v.w & 0xffffu), bf2f(v.w >> 16)};
            float s = 0.f;
#pragma unroll
            for (int i = 0; i < 8; ++i) s += f[i] * f[i];
            s = wave_sum(s);
            const float rs = rsqrtf(s * (1.f / 512.f) + EPS);
            const float* gw = P.in[seg ? 24 : 23] + lane * 8;
            const f32x4 g0 = *(const f32x4*)gw, g1 = *(const f32x4*)(gw + 4);
            u32x4 o; o.x = pk2(f[0] * rs * g0.x, f[1] * rs * g0.y); o.y = pk2(f[2] * rs * g0.z, f[3] * rs * g0.w);
            o.z = pk2(f[4] * rs * g1.x, f[5] * rs * g1.y); o.w = pk2(f[6] * rs * g1.z, f[7] * rs * g1.w);
            if (dry) o = v;
            *(u32x4*)p = o;
        }
    }
}
DI void phase7(const Params& P, unsigned char* lds_raw, int tid, int xmode = 0) {
    bf16_t* lds = (bf16_t*)lds_raw; float* Ct = (float*)lds_raw;
    const bf16_t* mix = (const bf16_t*)(P.ws + OFF_XN);
    const float* x = P.in[0];
    for (int u = vbid(); u < 256; u += gridDim.x) {
        const int mt = u >> 2, nt2 = u & 3, m0 = mt * 256;
        f32x16 acc[2][4]; zero_acc2(acc);
        const ASrc As = make_a(mix, 1024, nullptr, T, m0, tid);
        const BSrc2 bs = make_b2((const bf16_t*)(P.ws + OFF_WOUTT), 1024, 1024, nt2 * 256, tid);
        __syncthreads();
        float sc[8];
        {
            const float* ssq = (const float*)(P.ws + OFF_SSQ);
#pragma unroll
            for (int i = 0; i < 4; ++i) {
                const int row = m0 + (tid >> 3) + 64 * i;
                sc[i] = rsqrtf(ssq[(size_t)row * 2] * (1.f / 512.f) + EPS);
                sc[4 + i] = rsqrtf(ssq[(size_t)row * 2 + 1] * (1.f / 512.f) + EPS);
            }
        }
        if (xmode != 4) gemm_mainloop2s(acc, As, bs, 1024, lds, tid, sc);
        float* outp = xmode ? (float*)(P.ws + OFF_U) : P.out;
#pragma unroll 1
        for (int half = 0; half < 2; ++half) {
            const int n0 = nt2 * 256 + half * 128;
            if (xmode == 3) { if (tid == 0) outp[(size_t)m0 * 1024 + n0] = acc[0][0][0] + acc[1][3][5]; continue; }
            dump_acc2(acc, Ct, tid, half);
            __syncthreads();
            {
                const int c4 = tid & 31, r0 = tid >> 5;
#pragma unroll 1
                for (int jb = 0; jb < 16; jb += 4) {
                    f32x4 xv[4];
#pragma unroll
                    for (int j = 0; j < 4; ++j) xv[j] = *(const f32x4*)(x + (size_t)(m0 + r0 + 16 * (jb + j)) * 1024 + n0 + c4 * 4);
#pragma unroll
                    for (int j = 0; j < 4; ++j) {
                        const int row = r0 + 16 * (jb + j);
                        const f32x4 v = *(const f32x4*)(Ct + row * CT_STRIDE + c4 * 4);
                        *(f32x4*)(outp + (size_t)(m0 + row) * 1024 + n0 + c4 * 4) = xv[j] + v;
                    }
                }
            }
            __syncthreads();
        }
    }
    __syncthreads();
}
constexpr int RSTR = 264;
constexpr int R_AHI = 0, R_ALO = 64 * RSTR * 2, R_WHI = 2 * 64 * RSTR * 2, R_WLO = R_WHI + 40 * RSTR * 2, R_END = R_WLO + 40 * RSTR * 2;
struct RtRegs { f32x4 x[8]; u32x4 w[5]; };
DI void rt_load(RtRegs& R, const float* x1, const bf16_t* WrT, int m0, int c, int tid) {
    const int lane = tid & 63, w = tid >> 6;
#pragma unroll
    for (int i = 0; i < 8; ++i) R.x[i] = *(const f32x4*)(x1 + (size_t)(m0 + w * 8 + i) * 1024 + c * 256 + lane * 4);
#pragma unroll
    for (int i = 0; i < 5; ++i) { const int ch = tid + 512 * i, rw = ch >> 5, c16 = ch & 31;
        R.w[i] = *(const u32x4*)(WrT + (size_t)rw * 1024 + c * 256 + c16 * 8); }
}
DI void phase8(const Params& P, unsigned char* lds_raw, int tid, bool dry = false) {
    unsigned char* ws = P.ws;
    const float* x1 = P.out; const float* g2 = P.in[26];
    bf16_t* xg = (bf16_t*)(ws + (dry ? OFF_XN : OFF_H2HI));
    const bf16_t* WrT = (const bf16_t*)(ws + OFF_WRT);
    float* rs2 = (float*)(ws + OFF_RS2);
    unsigned* cnt = (unsigned*)(ws + OFF_CTL) + CW_CNT + (dry ? 64 * CNT_STRIDE : 0);
    int* list = (int*)(ws + (dry ? OFF_ACT : OFF_LIST)); float* listw = (float*)(ws + (dry ? OFF_ACT + (size_t)64 * T * 4 : OFF_LISTW));
    bf16_t* Ahi = (bf16_t*)(lds_raw + R_AHI); bf16_t* Alo = (bf16_t*)(lds_raw + R_ALO);
    bf16_t* Whi = (bf16_t*)(lds_raw + R_WHI);
    float* part = (float*)lds_raw;
    float* ssqp = (float*)(lds_raw + R_END);
    unsigned* hist = (unsigned*)(lds_raw + R_END + 256);
    unsigned* lbase = hist + 64;
    const int lane = tid & 63, w = tid >> 6, r = lane & 31, h = lane >> 5, mh = w & 1, ks = w >> 1;
    const int n0 = r, n1 = 32 + r < 40 ? 32 + r : 39;
    for (int u = blockIdx.x; u < 256; u += gridDim.x) {
        const int m0 = u * 64;
        f32x16 acc0, acc1;
#pragma unroll
        for (int i = 0; i < 16; ++i) { acc0[i] = 0.f; acc1[i] = 0.f; }
        float ssq[8];
#pragma unroll
        for (int i = 0; i < 8; ++i) ssq[i] = 0.f;
        RtRegs R;
        rt_load(R, x1, WrT, m0, 0, tid);
        __syncthreads();
#pragma unroll 1
        for (int c = 0; c < 4; ++c) {
            {
                const f32x4 g = *(const f32x4*)(g2 + c * 256 + lane * 4);
#pragma unroll
                for (int i = 0; i < 8; ++i) {
                    f32x4 v = R.x[i];
                    ssq[i] += (v.x * v.x + v.y * v.y) + (v.z * v.z + v.w * v.w);
                    v = v * g;
                    u32x2 hv; hv.x = pk2(v.x, v.y); hv.y = pk2(v.z, v.w);
                    u32x2 lv; lv.x = pk2(v.x - bf2f(hv.x & 0xffffu), v.y - bf2f(hv.x >> 16)); lv.y = pk2(v.z - bf2f(hv.y & 0xffffu), v.w - bf2f(hv.y >> 16));
                    const int row = w * 8 + i;
                    *(u32x2*)(Ahi + row * RSTR + lane * 4) = hv;
                    *(u32x2*)(Alo + row * RSTR + lane * 4) = lv;
                    *(u32x2*)(xg + (size_t)(m0 + row) * 1024 + c * 256 + lane * 4) = hv;
                }
#pragma unroll
                for (int i = 0; i < 5; ++i) { const int ch = tid + 512 * i, rw = ch >> 5, c16 = ch & 31; *(u32x4*)(Whi + rw * RSTR + c16 * 8) = R.w[i]; }
            }
            if (c < 3) rt_load(R, x1, WrT, m0, c + 1, tid);
            __syncthreads();
#pragma unroll 2
            for (int s4 = 0; s4 < 4; ++s4) {
                const int ko = (ks * 4 + s4) * 16 + 8 * h;
                const bf16x8 ah = *(const bf16x8*)(Ahi + (32 * mh + r) * RSTR + ko), al = *(const bf16x8*)(Alo + (32 * mh + r) * RSTR + ko);
                const bf16x8 wh0 = *(const bf16x8*)(Whi + n0 * RSTR + ko), wh1 = *(const bf16x8*)(Whi + n1 * RSTR + ko);
                const bf16x8 wl0 = *(const bf16x8*)(Whi + (40 + n0) * RSTR + ko), wl1 = *(const bf16x8*)(Whi + (40 + n1) * RSTR + ko);
                acc0 = MFMA32(ah, wh0, acc0); acc1 = MFMA32(ah, wh1, acc1);
                acc0 = MFMA32(ah, wl0, acc0); acc1 = MFMA32(ah, wl1, acc1);
                acc0 = MFMA32(al, wh0, acc0); acc1 = MFMA32(al, wh1, acc1);
            }
            __syncthreads();
        }
#pragma unroll
        for (int i = 0; i < 16; ++i) {
            float* d = part + ((ks * 64) + 32 * mh + crow(i, h)) * 64 + r;
            d[0] = acc0[i]; d[32] = acc1[i];
        }
#pragma unroll
        for (int i = 0; i < 8; ++i) { const float sv = wave_sum(ssq[i]); if (lane == 0) ssqp[w * 8 + i] = sv; }
        if (tid < 64) hist[tid] = 0u;
        __syncthreads();
        int vl0 = 0, vl1 = 0; unsigned lr0 = 0, lr1 = 0; float w0 = 0.f, w1 = 0.f;
        if (tid < 64) {
            const int t = tid, grow = m0 + t;
            const float rs = rsqrtf(ssqp[t] * (1.f / 1024.f) + EPS);
            const float* b_grp = P.in[28]; const float* b_exp = P.in[30];
            float gl[4]; int gsel = 0; float gmax = -3e38f;
#pragma unroll
            for (int j = 0; j < 4; ++j) {
                gl[j] = rs * ((part[t * 64 + j] + part[(64 + t) * 64 + j]) + (part[(128 + t) * 64 + j] + part[(192 + t) * 64 + j])) + b_grp[j];
                if (gl[j] > gmax) { gmax = gl[j]; gsel = j; }
            }
            float gsum = 0.f;
#pragma unroll
            for (int j = 0; j < 4; ++j) gsum += __expf(gl[j] - gmax);
            const float gprob = 1.f / gsum;
            float el[8]; float emax = -3e38f;
#pragma unroll
            for (int j = 0; j < 8; ++j) {
                const int cc = 4 + gsel * 8 + j;
                el[j] = rs * ((part[t * 64 + cc] + part[(64 + t) * 64 + cc]) + (part[(128 + t) * 64 + cc] + part[(192 + t) * 64 + cc])) + b_exp[gsel * 8 + j];
                emax = fmaxf(emax, el[j]);
            }
            int i0 = 0; float v0 = -3e38f;
#pragma unroll
            for (int j = 0; j < 8; ++j) if (el[j] > v0) { v0 = el[j]; i0 = j; }
            int i1 = 0; float v1 = -3e38f;
#pragma unroll
            for (int j = 0; j < 8; ++j) if (j != i0 && el[j] > v1) { v1 = el[j]; i1 = j; }
            const float p0 = __expf(v0 - emax), p1 = __expf(v1 - emax);
            w0 = p0 / (p0 + p1) * gprob; w1 = p1 / (p0 + p1) * gprob;
            vl0 = gsel * 8 + i0; vl1 = 32 + gsel * 8 + i1;
            if (!dry) rs2[grow] = rs;
            lr0 = atomicAdd(&hist[vl0], 1u);
            lr1 = atomicAdd(&hist[vl1], 1u);
        }
        __syncthreads();
        if (tid < 64) { const unsigned hc = hist[tid]; lbase[tid] = hc ? atomicAdd(&cnt[tid * CNT_STRIDE], hc) : 0u; }
        __syncthreads();
        if (tid < 64) {
            const int grow = m0 + tid;
            const unsigned q0 = lbase[vl0] + lr0, q1 = lbase[vl1] + lr1;
            list[(size_t)vl0 * T + q0] = grow; listw[(size_t)vl0 * T + q0] = w0;
            list[(size_t)vl1 * T + q1] = grow; listw[(size_t)vl1 * T + q1] = w1;
        }
    }
    __syncthreads();
}
DI bool moe_unit(const unsigned* cnt, int u, int ntn, int vlo, int vhi, int& v, int& mt, int& nt, int& base, int& M) {
    int acc = 0, b = 0;
    for (int vv = 0; vv < vhi; ++vv) {
        const int c = (int)cnt[vv * CNT_STRIDE];
        if (vv >= vlo) {
            const int nu = ((c + 255) >> 8) * ntn;
            if (u < acc + nu) { const int loc = u - acc; v = vv; mt = loc / ntn; nt = loc - mt * ntn; base = b; M = c; return true; }
            acc += nu;
        }
        b += c;
    }
    return false;
}
DI void phase9(const Params& P, unsigned char* lds_raw, int tid, float* outp, int mode = 0) {
    asm volatile("" : "+v"(tid));
    bf16_t* lds = (bf16_t*)lds_raw; float* Ct = (float*)lds_raw;
    unsigned char* ws = P.ws;
    unsigned* ctl = (unsigned*)(ws + OFF_CTL);
    const unsigned* cnt = ctl + CW_CNT;
    const bf16_t* hi = (const bf16_t*)(ws + OFF_H2HI);
    const int* list = (const int*)(ws + OFF_LIST); const float* listw = (const float*)(ws + OFF_LISTW);
    const float* rs2 = (const float*)(ws + OFF_RS2);
    bf16_t* act = (bf16_t*)(ws + OFF_ACT);
    float* rowf = (float*)(lds_raw + 147456);
    int* rowi = (int*)(lds_raw + 147456 + 1024);
    bf16_t* Y0 = (bf16_t*)(ws + OFF_XN);
    int total1 = 0, total2a = 0, total2b = 0;
    for (int vv = 0; vv < 64; ++vv) { const int mtv = ((int)cnt[vv * CNT_STRIDE] + 255) >> 8; total1 += mtv * 2; if (vv < 32) total2a += mtv * 4; else total2b += mtv * 4; }
    const int total = total1 + total2a + total2b;
    volatile unsigned* wq = (volatile unsigned*)(lds_raw + LDS_BYTES - 64) + 8;
    int u = vbid();
    while (u < total) {
        unsigned nxt = 0;
        if (tid == 0) nxt = gridDim.x + __hip_atomic_fetch_add(ctl + CW_WQ, 1u, __ATOMIC_RELAXED, __HIP_MEMORY_SCOPE_AGENT);
        int v, mt, nt, base, M;
        if ((mode == 2 && u >= total1) || (mode == 3 && u < total1)) {
        } else if (u < total1) {
            if (!moe_unit(cnt, u, 2, 0, 64, v, mt, nt, base, M)) break;
            const int e = v & 31;
            const int m0 = mt * 256;
            const int* rows = list + (size_t)v * T;
            f32x16 acc[2][4]; zero_acc2(acc);
            const ASrc As = make_a(hi, 1024, rows, M, m0, tid);
            const BSrc2 bs = make_b2((const bf16_t*)(ws + OFF_WGUT) + (size_t)e * 512 * 1024, 1024, 512, nt * 256, tid);
            float rsr = 0.f;
            if (tid < 256 && m0 + tid < M) rsr = rs2[rows[m0 + tid]];
            __syncthreads();
            gemm_mainloop2(acc, As, bs, 1024, lds, tid);
            if (tid < 256) rowf[tid] = rsr;
#pragma unroll 1
            for (int half = 0; half < 2; ++half) {
                const int nq = nt * 2 + half;
                dump_acc2(acc, Ct, tid, half);
                __syncthreads();
                for (int it = tid; it < 256 * 16; it += NTHREADS) {
                    const int row = it >> 4, q = it & 15, wn_ = q >> 3, c = (q & 7) * 4;
                    if (m0 + row < M) {
                        const float rs = rowf[row];
                        const f32x4 gt = *(const f32x4*)(Ct + row * CT_STRIDE + wn_ * 64 + c) * rs;
                        const f32x4 up = *(const f32x4*)(Ct + row * CT_STRIDE + wn_ * 64 + 32 + c) * rs;
                        u32x2 o; o.x = pk2(gt.x * sigmoidf(gt.x) * up.x, gt.y * sigmoidf(gt.y) * up.y); o.y = pk2(gt.z * sigmoidf(gt.z) * up.z, gt.w * sigmoidf(gt.w) * up.w);
                        st_wt8(act + (size_t)(base + m0 + row) * 256 + nq * 64 + wn_ * 32 + c, o);
                    }
                }
                __syncthreads();
            }
            unit_signal(ctl + CW_DONE + v * 64 + mt, tid);
        } else {
            const bool slot1 = u >= total1 + total2a;
            if (!moe_unit(cnt, slot1 ? u - total1 - total2a : u - total1, 4, slot1 ? 32 : 0, slot1 ? 64 : 32, v, mt, nt, base, M)) break;
            const int e = v & 31;
            const int m0 = mt * 256;
            const bf16_t* A = act + (size_t)base * 256;
            f32x16 acc[2][4]; zero_acc2(acc);
            const ASrc As = make_a(A, 256, nullptr, M, m0, tid);
            const BSrc2 bs = make_b2((const bf16_t*)(ws + OFF_WDT) + (size_t)e * 1024 * 256, 256, 1024, nt * 256, tid);
            int tokr = 0; float wgtr = 0.f;
            if (tid < 256) { const int rr = m0 + tid < M ? m0 + tid : M - 1; tokr = list[(size_t)v * T + rr]; wgtr = listw[(size_t)v * T + rr]; }
            unit_wait2(ctl + CW_DONE + v * 64 + mt, 2u, slot1 ? ctl + CW_S0DONE : nullptr, (unsigned)total2a, tid);
            gemm_mainloop2(acc, As, bs, 256, lds, tid);
            if (tid < 256) { rowi[tid] = tokr; rowf[tid] = wgtr; }
#pragma unroll 1
            for (int half = 0; half < 2; ++half) {
                const int n0 = nt * 256 + half * 128;
                dump_acc2(acc, Ct, tid, half);
                __syncthreads();
                {
                    const int c4 = tid & 31, r0 = tid >> 5;
                    if (!slot1) {
#pragma unroll 4
                        for (int j = 0; j < 16; ++j) {
                            const int row = r0 + 16 * j;
                            if (m0 + row < M) {
                                const f32x4 cv = *(const f32x4*)(Ct + row * CT_STRIDE + c4 * 4) * rowf[row];
                                u32x2 o; o.x = pk2(cv.x, cv.y); o.y = pk2(cv.z, cv.w);
                                st_wt8(Y0 + (size_t)rowi[row] * 1024 + n0 + c4 * 4, o);
                            }
                        }
                    } else {
#pragma unroll 1
                        for (int jb = 0; jb < 16; jb += 8) {
                            f32x4 ov[8]; u32x2 yv[8];
#pragma unroll
                            for (int j = 0; j < 8; ++j) {
                                const size_t o = (size_t)rowi[r0 + 16 * (jb + j)] * 1024 + n0 + c4 * 4;
                                ov[j] = *(const f32x4*)(outp + o);
                                yv[j] = *(const u32x2*)(Y0 + o);
                            }
#pragma unroll
                            for (int j = 0; j < 8; ++j) {
                                const int row = r0 + 16 * (jb + j);
                                if (m0 + row < M) {
                                    const f32x4 cv = *(const f32x4*)(Ct + row * CT_STRIDE + c4 * 4) * rowf[row];
                                    f32x4 nv = ov[j] + cv;
                                    nv.x += bf2f(yv[j].x & 0xffffu); nv.y += bf2f(yv[j].x >> 16); nv.z += bf2f(yv[j].y & 0xffffu); nv.w += bf2f(yv[j].y >> 16);
                                    *(f32x4*)(outp + (size_t)rowi[row] * 1024 + n0 + c4 * 4) = nv;
                                }
                            }
                        }
                    }
                }
                __syncthreads();
            }
            if (!slot1) unit_signal(ctl + CW_S0DONE, tid);
        }
        if (tid == 0) wq[0] = nxt;
        __syncthreads();
        u = __builtin_amdgcn_readfirstlane((int)wq[0]);
    }
    __syncthreads();
}

constexpr int NPHASES = 10;
__global__ void __launch_bounds__(NTHREADS, 2) mk(Params P) {
    extern __shared__ __attribute__((aligned(16))) unsigned char lds_raw[];
    const int tid = threadIdx.x;
    volatile unsigned* misc = (volatile unsigned*)(lds_raw + LDS_BYTES - 64);
    if (tid < 2) misc[tid] = 0u;
    __syncthreads();
    XcdBarrier bar; bar.bar = nullptr; bar.x = 0; bar.st = nullptr;
    const bool multi = (P.ph_hi - P.ph_lo) > 1;
    if (multi) bar = xcd_barrier_post((unsigned*)(P.ws + OFF_CTL) + CW_BAR, misc);
    const int lo = P.ph_lo, hi = P.ph_hi;
#define IN(k) (lo <= (k) && (k) < hi)
#define SEAM(k) do { if (IN(k) && IN((k) + 1)) xcd_barrier(bar); } while (0)
#ifndef PROBE_PHASE
#define PROBE_PHASE -1
#endif
#ifndef PROBE_XMODE
#define PROBE_XMODE 0
#endif
#define RUN(k, call, calldry) do { if (IN(k)) { call; if (PROBE_PHASE == (k) || PROBE_PHASE == 100 + (k) / 4) { xcd_barrier(bar); calldry; } } } while (0)
    RUN(0, phase0(P, lds_raw, tid), phase0(P, lds_raw, tid, PROBE_XMODE));
    SEAM(0);
    RUN(1, phase1(P, lds_raw, tid), phase1(P, lds_raw, tid, PROBE_XMODE));
    SEAM(1);
    RUN(2, phase2(P, lds_raw, tid), phase2(P, lds_raw, tid));
    SEAM(2);
    RUN(4, phase4(P, lds_raw, tid), phase4(P, lds_raw, tid, PROBE_XMODE ? PROBE_XMODE : 3));
    SEAM(4);
    RUN(5, phase5(P, lds_raw, tid), phase5(P, lds_raw, tid));
    SEAM(5);
    RUN(7, phase7(P, lds_raw, tid), phase7(P, lds_raw, tid, PROBE_XMODE));
    SEAM(7);
    if (IN(8)) {
        if (PROBE_PHASE == 8) {
            phase8(P, lds_raw, tid); xcd_barrier(bar);
            if (blockIdx.x == 0 && tid < 64) ((unsigned*)(P.ws + OFF_CTL))[CW_CNT + tid * CNT_STRIDE] = 0u;
            xcd_barrier(bar);
        }
        phase8(P, lds_raw, tid);
    }
    SEAM(8);
    if (IN(9)) {
        if (PROBE_PHASE == 9) {
            unsigned* ctl = (unsigned*)(P.ws + OFF_CTL);
            phase9(P, lds_raw, tid, PROBE_XMODE == 0 ? (float*)(P.ws + OFF_KC) : P.out);
            xcd_barrier(bar);
            if (blockIdx.x == 0) {
                if (PROBE_XMODE == 0) { for (int i = tid; i < 4096; i += NTHREADS) ctl[CW_DONE + i] = 0u; if (tid == 0) ctl[CW_S0DONE] = 0u; }
                if (tid == 0) ctl[CW_WQ] = 0u;
            }
            xcd_barrier(bar);
            phase9(P, lds_raw, tid, PROBE_XMODE == 0 ? P.out : (float*)(P.ws + OFF_KC), PROBE_XMODE >= 2 ? PROBE_XMODE : 0);
        } else phase9(P, lds_raw, tid, P.out);
    }
#undef RUN
#undef IN
#undef SEAM
}

extern "C" void kernel_launch(void* const* d_in, const int* in_sizes, int n_in, void* d_out, int out_size, void* d_ws, size_t ws_size, hipStream_t stream) {
    static int grid = 0;
    if (grid == 0) {
        if (n_in != 34 || out_size != T * DM || ws_size < WS_END) {
            fprintf(stderr, "kernel_launch: unexpected shapes: n_in %d out %d ws %zu (need %zu)\n", n_in, out_size, ws_size, (size_t)WS_END);
            grid = -1; return;
        }
        int dev = 0, cus = 0;
        hipGetDevice(&dev);
        hipDeviceGetAttribute(&cus, hipDeviceAttributeMultiprocessorCount, dev);
        hipFuncSetAttribute((const void*)mk, hipFuncAttributeMaxDynamicSharedMemorySize, LDS_BYTES);
        int per_cu = 0;
        hipOccupancyMaxActiveBlocksPerMultiprocessor(&per_cu, (const void*)mk, NTHREADS, LDS_BYTES);
        (void)hipGetLastError();
        if (per_cu < 1) fprintf(stderr, "kernel_launch: occupancy query says %d blocks/CU\n", per_cu);
        grid = cus > 0 ? cus : 256;
    }
    if (grid < 0) return;
    hipMemsetAsync((char*)d_ws + OFF_CTL, 0, CTL_BYTES, stream);
    Params p{};
    for (int i = 0; i < 34; ++i) p.in[i] = (const float*)d_in[i];
    p.out = (float*)d_out; p.ws = (unsigned char*)d_ws;
#ifndef MK_ONE_LAUNCH
    for (int ph = 0; ph < NPHASES; ++ph) {
        p.ph_lo = ph; p.ph_hi = ph + 1;
        hipLaunchKernelGGL(mk, dim3(grid), dim3(NTHREADS), LDS_BYTES, stream, p);
    }
#else
    p.ph_lo = 0; p.ph_hi = NPHASES;
    hipLaunchKernelGGL(mk, dim3(grid), dim3(NTHREADS), LDS_BYTES, stream, p);
#endif
}
```

```cpp
#define MK_ONE_LAUNCH 1
#include <hip/hip_runtime.h>
#include <stdint.h>
#include <cstdio>

#define DI __device__ __forceinline__
typedef unsigned short bf16_t;
typedef short bf16x8 __attribute__((ext_vector_type(8)));
typedef short s16x4 __attribute__((ext_vector_type(4)));
typedef float f32x16 __attribute__((ext_vector_type(16)));
typedef float f32x4 __attribute__((ext_vector_type(4)));
typedef unsigned u32x4 __attribute__((ext_vector_type(4)));
typedef unsigned u32x2 __attribute__((ext_vector_type(2)));

constexpr int T = 16384, SEQ = 4096, NBATCH = 4, DM = 1024, DIN = 1816;
constexpr int NTHREADS = 512;
constexpr float EPS = 1e-6f;

constexpr size_t al256(size_t x) { return (x + 255) & ~(size_t)255; }
constexpr size_t OFF_CTL   = 0;
constexpr size_t CTL_BYTES = 65536;
constexpr size_t OFF_XN    = OFF_CTL + CTL_BYTES;
constexpr size_t OFF_U     = OFF_XN + (size_t)T * 1024 * 2;
constexpr size_t OFF_QN    = OFF_U + (size_t)T * 512 * 2;
constexpr size_t KV_BYTES  = (size_t)8 * 4096 * 64 * 2;
constexpr size_t OFF_KC    = OFF_QN + (size_t)T * 512 * 2;
constexpr size_t OFF_VC    = OFF_KC + KV_BYTES;
constexpr size_t OFF_KSN   = OFF_VC + KV_BYTES;
constexpr size_t OFF_KWN   = OFF_KSN + KV_BYTES;
constexpr size_t OFF_VST   = OFF_KWN + KV_BYTES;
constexpr size_t OFF_VWT   = OFF_VST + KV_BYTES;
constexpr size_t OFF_GATES = OFF_VWT + KV_BYTES;
constexpr size_t OFF_TGT   = OFF_GATES + (size_t)T * 24 * 4;
constexpr size_t OFF_EGT   = OFF_TGT + (size_t)32 * 512 * 512 * 2;
constexpr size_t OFF_FGT   = OFF_EGT + (size_t)32 * 128 * 512 * 2;
constexpr size_t OFF_LAM32 = OFF_FGT + (size_t)32 * 512 * 128 * 2;
constexpr size_t OFF_BIASP = OFF_LAM32 + 32 * 64 * 2 * 4;
constexpr size_t OFF_Z     = OFF_BIASP + 2 * 16 * 256 * 4;
constexpr size_t OFF_SIN   = OFF_Z + (size_t)32 * 512 * 128 * 4;
constexpr size_t OFF_P     = OFF_SIN + (size_t)32 * 512 * 128 * 2;
constexpr size_t OFF_KCMP  = OFF_P + (size_t)2 * 8 * 2 * 256 * 256 * 4;
constexpr size_t OFF_VCMPT = OFF_KCMP + 8 * 256 * 64 * 2;
constexpr size_t OFF_Y1    = OFF_VCMPT + 8 * 64 * 256 * 2;
constexpr size_t OFF_H2HI  = OFF_U;
constexpr size_t OFF_H2LO  = OFF_TGT;
constexpr size_t OFF_ACT   = OFF_Y1;
constexpr size_t OFF_LIST  = OFF_Y1 + (size_t)T * 512 * 2;
constexpr size_t OFF_LISTW = OFF_LIST + (size_t)64 * T * 4;
constexpr size_t OFF_RS2   = OFF_LISTW + (size_t)64 * T * 4;
constexpr size_t OFF_SSQ   = OFF_RS2 + (size_t)T * 4;
constexpr size_t OFF_WINT  = OFF_SSQ + (size_t)T * 2 * 4;
constexpr size_t OFF_WGLUT = OFF_WINT + (size_t)1816 * 1024 * 2;
constexpr size_t OFF_WC1T  = OFF_WGLUT + (size_t)512 * 512 * 2;
constexpr size_t OFF_WOUTT = OFF_WC1T + (size_t)4 * 256 * 1024 * 2;
constexpr size_t OFF_WRT   = OFF_WOUTT + (size_t)1024 * 1024 * 2;
constexpr size_t OFF_WGUT  = OFF_WRT + (size_t)2 * 40 * 1024 * 2;
constexpr size_t OFF_WDT   = OFF_WGUT + (size_t)32 * 512 * 1024 * 2;
constexpr size_t WS_END    = OFF_WDT + (size_t)32 * 1024 * 256 * 2;
static_assert(OFF_H2HI + (size_t)T * 1024 * 2 <= OFF_KC, "h2hi overlay");
static_assert(OFF_H2LO + (size_t)T * 1024 * 2 <= OFF_SIN, "h2lo overlay");
static_assert(WS_END <= (size_t)256 * 1024 * 1024, "workspace");

constexpr int CW_CNT = 8192;
constexpr int CNT_STRIDE = 32;
constexpr int CW_WQ = 4736;
constexpr int CW_S0DONE = 4608;
constexpr int CW_DONE = 12288;
constexpr int CW_PDONE = 4864;
constexpr int CW_BAR = 1024;

constexpr int LDS_BYTES = 151552;
constexpr int BM = 256, BN = 128, BK = 64;
constexpr int LSTR = 72;
constexpr int A_TILE = BM * LSTR;
constexpr int B_TILE = BN * LSTR;
constexpr int STAGE_ELEMS = A_TILE + B_TILE;
constexpr int CT_STRIDE = 132;
constexpr int STAGE2_ELEMS = (BM + 256) * LSTR;

struct Params {
    const float* in[34];
    float* out;
    unsigned char* ws;
    int ph_lo, ph_hi;
};

DI unsigned f2bf(float f) { unsigned u = __builtin_bit_cast(unsigned, f); return (u + 0x7fffu + ((u >> 16) & 1u)) >> 16; }
DI float bf2f(unsigned b) { return __builtin_bit_cast(float, b << 16); }
typedef float f32x2 __attribute__((ext_vector_type(2)));
typedef __bf16 bf16x2_t __attribute__((ext_vector_type(2)));
DI unsigned pk2(float lo, float hi) { f32x2 v = {lo, hi}; bf16x2_t b = __builtin_convertvector(v, bf16x2_t); return __builtin_bit_cast(unsigned, b); }
DI float wave_sum(float v) {
#pragma unroll
    for (int o = 1; o < 64; o <<= 1) v += __shfl_xor(v, o);
    return v;
}
DI float gelu_tanh(float x) {
    const float k0 = 0.7978845608028654f, k1 = 0.044715f;
    float u = k0 * (x + k1 * x * x * x);
    float e = __expf(2.f * u);
    float th = 1.f - 2.f / (e + 1.f);
    return 0.5f * x * (1.f + th);
}
DI float sigmoidf(float x) { return 1.f / (1.f + __expf(-x)); }
DI int vbid() { const int G = gridDim.x, b = blockIdx.x; return (G & 7) == 0 ? (b & 7) * (G >> 3) + (b >> 3) : b; }
DI int crow(int reg, int h) { return (reg & 3) + 8 * (reg >> 2) + 4 * h; }
#define MFMA32(a, b, c) __builtin_amdgcn_mfma_f32_32x32x16_bf16((a), (b), (c), 0, 0, 0)

#define XB_TMO      128
#define XB_XCNT(j)  (256  + 64 * (j))
#define XB_XSUB(j)  (1280 + 64 * (j))
#define XB_XGEN(j)  (2304 + 64 * (j))
#define XB_TOP      3328
#define XB_TOPGEN   3392
#define XCD_BAR_WORDS 3456
#define XB_SPIN_CAP (1u << 22)
DI unsigned xb_ld(unsigned* p)              { return __hip_atomic_load(p, __ATOMIC_RELAXED, __HIP_MEMORY_SCOPE_AGENT); }
DI unsigned xb_add(unsigned* p, unsigned v) { return __hip_atomic_fetch_add(p, v, __ATOMIC_RELAXED, __HIP_MEMORY_SCOPE_AGENT); }
DI unsigned xb_xcc_id() { return (unsigned)__builtin_amdgcn_s_getreg((3 << 11) | 20) & 0xFu; }
#define XB_SPIN(cond, bar) do { unsigned _sp = 0; while (cond) { __builtin_amdgcn_s_sleep(1); \
    if ((++_sp & 255u) == 0u) { if (xb_ld(&(bar)[XB_TMO])) break; if (_sp > XB_SPIN_CAP) { atomicAdd(&(bar)[XB_TMO], 1u); break; } } } } while (0)
struct XcdBarrier { unsigned* bar; unsigned x; volatile unsigned* st; };
DI XcdBarrier xcd_barrier_post(unsigned* bar, volatile unsigned* st) {
    XcdBarrier b; b.bar = bar; b.x = xb_xcc_id(); b.st = st;
    if (threadIdx.x == 0) (void)xb_add(&bar[XB_XCNT(b.x)], 1u);
    return b;
}
DI void xcd_barrier_complete(unsigned* bar, unsigned x, unsigned& nloc, unsigned& nx) {
    const unsigned G = gridDim.x;
    unsigned sum, cnt, mine, sp = 0u;
    for (;;) {
        sum = 0u; cnt = 0u; mine = 0u;
#pragma unroll
        for (unsigned j = 0; j < 16; ++j) { const unsigned c = xb_ld(&bar[XB_XCNT(j)]); sum += c; cnt += (c > 0u) ? 1u : 0u; mine = (j == x) ? c : mine; }
        if (sum == G) break;
        __builtin_amdgcn_s_sleep(1);
        if ((++sp & 255u) == 0u) { if (xb_ld(&bar[XB_TMO])) break; if (sp > XB_SPIN_CAP) { atomicAdd(&bar[XB_TMO], 1u); break; } }
    }
    nloc = mine > 0u ? mine : 1u; nx = cnt > 0u ? cnt : 1u;
}
DI void xcd_barrier(const XcdBarrier& b) {
    asm volatile("s_waitcnt vmcnt(0)" ::: "memory");
    __syncthreads();
    if (threadIdx.x == 0) {
        unsigned* bar = b.bar;
        __builtin_amdgcn_s_waitcnt(0);
        unsigned nloc = b.st[0], nx = b.st[1];
        if (nloc == 0u) { xcd_barrier_complete(bar, b.x, nloc, nx); b.st[0] = nloc; b.st[1] = nx; }
        const unsigned old = xb_add(&bar[XB_XSUB(b.x)], 1u);
        const unsigned gen = old / nloc;
        if (old + 1u == (gen + 1u) * nloc) {
            __builtin_amdgcn_fence(__ATOMIC_RELEASE, "agent");
            asm volatile("s_waitcnt vmcnt(0)" ::: "memory");
            const unsigned og = xb_add(&bar[XB_TOP], 1u);
            const unsigned tg = og / nx;
            if (og + 1u == (tg + 1u) * nx) xb_add(&bar[XB_TOPGEN], 1u);
            else XB_SPIN(xb_ld(&bar[XB_TOPGEN]) == tg, bar);
            __builtin_amdgcn_fence(__ATOMIC_ACQUIRE, "agent");
            xb_add(&bar[XB_XGEN(b.x)], 1u);
            asm volatile("s_waitcnt vmcnt(0)" ::: "memory");
        } else {
            XB_SPIN(xb_ld(&bar[XB_XGEN(b.x)]) == gen, bar);
            __builtin_amdgcn_fence(__ATOMIC_ACQUIRE, "agent");
            asm volatile("s_waitcnt vmcnt(0)" ::: "memory");
        }
    }
    __syncthreads();
}

struct BSrcBf { const bf16_t* p0; const bf16_t* p1; };
struct GRegs { u32x4 a0, a1, a2, a3, b0, b1; };
struct ASrc { const bf16_t* a0; const bf16_t* a1; const bf16_t* a2; const bf16_t* a3; };
DI void g_load(GRegs& r, const ASrc& A, const BSrcBf& B, int kb) {
    const int ko = kb * BK;
    r.a0 = *(const u32x4*)(A.a0 + ko); r.a1 = *(const u32x4*)(A.a1 + ko); r.a2 = *(const u32x4*)(A.a2 + ko); r.a3 = *(const u32x4*)(A.a3 + ko);
    r.b0 = *(const u32x4*)(B.p0 + ko); r.b1 = *(const u32x4*)(B.p1 + ko);
}
DI void g_store(const GRegs& r, bf16_t* st, int tid) {
    const int off = (tid >> 3) * LSTR + (tid & 7) * 8;
    *(u32x4*)(st + off) = r.a0; *(u32x4*)(st + off + 64 * LSTR) = r.a1; *(u32x4*)(st + off + 128 * LSTR) = r.a2; *(u32x4*)(st + off + 192 * LSTR) = r.a3;
    *(u32x4*)(st + A_TILE + off) = r.b0; *(u32x4*)(st + A_TILE + off + 64 * LSTR) = r.b1;
}
DI void g_compute(f32x16 (&acc)[2][2], const bf16_t* st, int wm, int wn, int r, int h) {
    const bf16_t* ab = st + (wm * 64 + r) * LSTR + h * 8;
    const bf16_t* bb = st + A_TILE + (wn * 64 + r) * LSTR + h * 8;
#pragma unroll
    for (int s = 0; s < 4; ++s) {
        const bf16x8 af0 = *(const bf16x8*)(ab + s * 16);
        const bf16x8 af1 = *(const bf16x8*)(ab + 32 * LSTR + s * 16);
        const bf16x8 bf0 = *(const bf16x8*)(bb + s * 16);
        const bf16x8 bf1 = *(const bf16x8*)(bb + 32 * LSTR + s * 16);
        acc[0][0] = MFMA32(af0, bf0, acc[0][0]);
        acc[0][1] = MFMA32(af0, bf1, acc[0][1]);
        acc[1][0] = MFMA32(af1, bf0, acc[1][0]);
        acc[1][1] = MFMA32(af1, bf1, acc[1][1]);
    }
}
DI void gemm_mainloop(f32x16 (&acc)[2][2], const ASrc& A, const BSrcBf& B, int K, bf16_t* lds, int tid, int xmode = 0) {
    const int lane = tid & 63, w = tid >> 6, r = lane & 31, h = lane >> 5;
    const int wm = w >> 1, wn = w & 1;
    const int nk = K / BK;
    GRegs RA, RB;
    g_load(RA, A, B, 0);
    g_store(RA, lds, tid);
    if (nk > 1) g_load(RA, A, B, 1);
    if (nk > 2) g_load(RB, A, B, 2);
    __syncthreads();
    for (int kb = 0; kb < nk; kb += 2) {
        if (xmode != 2) g_compute(acc, lds, wm, wn, r, h);
        if (kb + 1 < nk) g_store(RA, lds + STAGE_ELEMS, tid);
        if (kb + 3 < nk) g_load(RA, A, B, xmode == 1 ? 0 : kb + 3);
        __syncthreads();
        if (kb + 1 >= nk) break;
        if (xmode != 2) g_compute(acc, lds + STAGE_ELEMS, wm, wn, r, h);
        if (kb + 2 < nk) g_store(RB, lds, tid);
        if (kb + 4 < nk) g_load(RB, A, B, xmode == 1 ? 1 : kb + 4);
        __syncthreads();
    }
}

DI void zero_acc(f32x16 (&acc)[2][2]) {
#pragma unroll
    for (int a = 0; a < 2; ++a)
#pragma unroll
        for (int b = 0; b < 2; ++b)
#pragma unroll
            for (int i = 0; i < 16; ++i) acc[a][b][i] = 0.f;
}
DI void dump_acc(const f32x16 (&acc)[2][2], float* Ct, int tid) {
    const int lane = tid & 63, w = tid >> 6, r = lane & 31, h = lane >> 5;
    const int wm = w >> 1, wn = w & 1;
#pragma unroll
    for (int tm = 0; tm < 2; ++tm)
#pragma unroll
        for (int tn = 0; tn < 2; ++tn)
#pragma unroll
            for (int i = 0; i < 16; ++i)
                Ct[(wm * 64 + tm * 32 + crow(i, h)) * CT_STRIDE + wn * 64 + tn * 32 + r] = acc[tm][tn][i];
}
struct BSrc2 { const bf16_t* p0; const bf16_t* p1; const bf16_t* p2; const bf16_t* p3; };
struct GRegs2 { u32x4 a0, a1, a2, a3, b0, b1, b2, b3; };
DI void g2_load(GRegs2& r, const ASrc& A, const BSrc2& B, int kb) {
    const int ko = kb * BK;
    r.a0 = *(const u32x4*)(A.a0 + ko); r.a1 = *(const u32x4*)(A.a1 + ko); r.a2 = *(const u32x4*)(A.a2 + ko); r.a3 = *(const u32x4*)(A.a3 + ko);
    r.b0 = *(const u32x4*)(B.p0 + ko); r.b1 = *(const u32x4*)(B.p1 + ko); r.b2 = *(const u32x4*)(B.p2 + ko); r.b3 = *(const u32x4*)(B.p3 + ko);
}
DI void g2_store(const GRegs2& r, bf16_t* st, int tid) {
    const int off = (tid >> 3) * LSTR + (tid & 7) * 8;
    *(u32x4*)(st + off) = r.a0; *(u32x4*)(st + off + 64 * LSTR) = r.a1; *(u32x4*)(st + off + 128 * LSTR) = r.a2; *(u32x4*)(st + off + 192 * LSTR) = r.a3;
    bf16_t* sb = st + A_TILE;
    *(u32x4*)(sb + off) = r.b0; *(u32x4*)(sb + off + 64 * LSTR) = r.b1; *(u32x4*)(sb + off + 128 * LSTR) = r.b2; *(u32x4*)(sb + off + 192 * LSTR) = r.b3;
}
DI void g2_compute(f32x16 (&acc)[2][4], const bf16_t* st, int wm, int wn, int r, int h) {
    const bf16_t* ab = st + (wm * 64 + r) * LSTR + h * 8;
    const bf16_t* bb = st + A_TILE + (wn * 128 + r) * LSTR + h * 8;
#pragma unroll
    for (int s = 0; s < 4; ++s) {
        const bf16x8 af0 = *(const bf16x8*)(ab + s * 16);
        const bf16x8 af1 = *(const bf16x8*)(ab + 32 * LSTR + s * 16);
#pragma unroll
        for (int tn = 0; tn < 4; ++tn) {
            const bf16x8 bf = *(const bf16x8*)(bb + tn * 32 * LSTR + s * 16);
            acc[0][tn] = MFMA32(af0, bf, acc[0][tn]);
            acc[1][tn] = MFMA32(af1, bf, acc[1][tn]);
        }
    }
}
DI void gemm_mainloop2(f32x16 (&acc)[2][4], const ASrc& A, const BSrc2& B, int K, bf16_t* lds, int tid) {
    const int lane = tid & 63, w = tid >> 6, r = lane & 31, h = lane >> 5;
    const int wm = w >> 1, wn = w & 1;
    const int nk = K / BK;
    GRegs2 RA;
    g2_load(RA, A, B, 0);
    g2_store(RA, lds, tid);
    if (nk > 1) g2_load(RA, A, B, 1);
    __syncthreads();
    for (int kb = 0; kb < nk; ++kb) {
        g2_compute(acc, lds + (kb & 1) * STAGE2_ELEMS, wm, wn, r, h);
        if (kb + 1 < nk) g2_store(RA, lds + ((kb + 1) & 1) * STAGE2_ELEMS, tid);
        if (kb + 2 < nk) g2_load(RA, A, B, kb + 2);
        __syncthreads();
    }
}
DI u32x4 scale8(u32x4 v, float sc) {
    u32x4 o;
    o.x = pk2(__builtin_bit_cast(float, v.x << 16) * sc, __builtin_bit_cast(float, v.x & 0xffff0000u) * sc);
    o.y = pk2(__builtin_bit_cast(float, v.y << 16) * sc, __builtin_bit_cast(float, v.y & 0xffff0000u) * sc);
    o.z = pk2(__builtin_bit_cast(float, v.z << 16) * sc, __builtin_bit_cast(float, v.z & 0xffff0000u) * sc);
    o.w = pk2(__builtin_bit_cast(float, v.w << 16) * sc, __builtin_bit_cast(float, v.w & 0xffff0000u) * sc);
    return o;
}
DI void gemm_mainloop2s(f32x16 (&acc)[2][4], const ASrc& A, const BSrc2& B, int K, bf16_t* lds, int tid, const float (&sc)[8]) {
    const int lane = tid & 63, w = tid >> 6, r = lane & 31, h = lane >> 5;
    const int wm = w >> 1, wn = w & 1;
    const int nk = K / BK;
    GRegs2 RA;
    g2_load(RA, A, B, 0);
    { RA.a0 = scale8(RA.a0, sc[0]); RA.a1 = scale8(RA.a1, sc[1]); RA.a2 = scale8(RA.a2, sc[2]); RA.a3 = scale8(RA.a3, sc[3]); }
    g2_store(RA, lds, tid);
    if (nk > 1) g2_load(RA, A, B, 1);
    __syncthreads();
    for (int kb = 0; kb < nk; ++kb) {
        g2_compute(acc, lds + (kb & 1) * STAGE2_ELEMS, wm, wn, r, h);
        if (kb + 1 < nk) {
            const int o = ((kb + 1) * BK < 512) ? 0 : 4;
            RA.a0 = scale8(RA.a0, sc[o]); RA.a1 = scale8(RA.a1, sc[o + 1]); RA.a2 = scale8(RA.a2, sc[o + 2]); RA.a3 = scale8(RA.a3, sc[o + 3]);
            g2_store(RA, lds + ((kb + 1) & 1) * STAGE2_ELEMS, tid);
        }
        if (kb + 2 < nk) g2_load(RA, A, B, kb + 2);
        __syncthreads();
    }
}
DI void zero_acc2(f32x16 (&acc)[2][4]) {
#pragma unroll
    for (int a = 0; a < 2; ++a)
#pragma unroll
        for (int b = 0; b < 4; ++b)
#pragma unroll
            for (int i = 0; i < 16; ++i) acc[a][b][i] = 0.f;
}
DI void dump_acc2(const f32x16 (&acc)[2][4], float* Ct, int tid, int half) {
    const int lane = tid & 63, w = tid >> 6, r = lane & 31, h = lane >> 5;
    const int wm = w >> 1, wn = w & 1;
    if (wn == half) {
#pragma unroll
        for (int tm = 0; tm < 2; ++tm)
#pragma unroll
            for (int tn = 0; tn < 4; ++tn)
#pragma unroll
                for (int i = 0; i < 16; ++i)
                    Ct[(wm * 64 + tm * 32 + crow(i, h)) * CT_STRIDE + tn * 32 + r] = acc[tm][tn][i];
    }
}
DI BSrc2 make_b2(const bf16_t* Bt, long ldb, int N, int n0, int tid) {
    BSrc2 s; const int c = (tid & 7) * 8;
    int n = n0 + (tid >> 3);
    int q0 = n < N ? n : N - 1, q1 = n + 64 < N ? n + 64 : N - 1, q2 = n + 128 < N ? n + 128 : N - 1, q3 = n + 192 < N ? n + 192 : N - 1;
    s.p0 = Bt + (long)q0 * ldb + c; s.p1 = Bt + (long)q1 * ldb + c; s.p2 = Bt + (long)q2 * ldb + c; s.p3 = Bt + (long)q3 * ldb + c; return s;
}
DI const bf16_t* a_ptr(const bf16_t* base, long lda, const int* rows, int M, int m0, int i, int tid) {
    int gm = m0 + (tid >> 3) + 64 * i;
    gm = gm < M ? gm : M - 1;
    const long src = rows ? (long)rows[gm] : (long)gm;
    return base + src * lda + (tid & 7) * 8;
}
DI ASrc make_a(const bf16_t* base, long lda, const int* rows, int M, int m0, int tid) {
    ASrc A; A.a0 = a_ptr(base, lda, rows, M, m0, 0, tid); A.a1 = a_ptr(base, lda, rows, M, m0, 1, tid);
    A.a2 = a_ptr(base, lda, rows, M, m0, 2, tid); A.a3 = a_ptr(base, lda, rows, M, m0, 3, tid); return A;
}
DI BSrcBf make_bbf(const bf16_t* Bt, long ldb, int N, int n0, int tid) {
    int n = n0 + (tid >> 3); int n1 = n + 64;
    n = n < N ? n : N - 1; n1 = n1 < N ? n1 : N - 1;
    BSrcBf s; s.p0 = Bt + (long)n * ldb + (tid & 7) * 8; s.p1 = Bt + (long)n1 * ldb + (tid & 7) * 8; return s;
}
template <class RM>
DI void tconv(const float* src, long sbatch, long sld, int K, int N, bf16_t* dst, long dbatch, long ldd, int nbatch, RM rm, int lo, long gtid, long gstride,
              const float* ks0 = nullptr, const float* ks1 = nullptr) {
    const long per = (long)N * (K >> 5), total = per * nbatch;
    for (long i = gtid; i < total; i += gstride) {
        const int bi = (int)(i / per); const long rem = i - (long)bi * per;
        const int k32 = (int)(rem / N), n = (int)(rem - (long)k32 * N);
        const float* sp = src + bi * sbatch + (long)(k32 * 32) * sld + n;
        float f[32];
#pragma unroll
        for (int j = 0; j < 32; ++j) f[j] = sp[(long)j * sld];
        if (lo) {
#pragma unroll
            for (int j = 0; j < 32; ++j) f[j] = f[j] - bf2f(f2bf(f[j]));
        }
        if (ks0) {
            const float* kp = (k32 * 32 < 512) ? ks0 + k32 * 32 : ks1 + k32 * 32 - 512;
#pragma unroll
            for (int j = 0; j < 32; ++j) f[j] *= kp[j];
        }
        bf16_t* dp = dst + bi * dbatch + (long)rm(n) * ldd + k32 * 32;
#pragma unroll
        for (int q = 0; q < 4; ++q) {
            u32x4 o; o.x = pk2(f[8 * q], f[8 * q + 1]); o.y = pk2(f[8 * q + 2], f[8 * q + 3]); o.z = pk2(f[8 * q + 4], f[8 * q + 5]); o.w = pk2(f[8 * q + 6], f[8 * q + 7]);
            *(u32x4*)(dp + 8 * q) = o;
        }
    }
}
struct RowId { DI int operator()(int n) const { return n; } };
struct RowGU { int tn; DI int operator()(int n) const { return (n >> 6) * 128 + ((n >> 5) & 1) * 64 + tn * 32 + (n & 31); } };
struct RowOff { int off; DI int operator()(int n) const { return n + off; } };

DI void cpow(float lr, float li, float step, int tau, float& re, float& im) {
    const float mag = expf(lr * step * (float)tau);
    const double ang = (double)li * (double)step * (double)tau;
    const double k = rint(ang * 0.15915494309189535);
    const float red = (float)(ang - k * 6.283185307179586);
    float sn, cs; sn = sinf(red); cs = cosf(red);
    re = mag * cs; im = mag * sn;
}
DI void phase0(const Params& P, unsigned char* lds_raw, int tid, int xmode = 0) {
    unsigned char* ws = P.ws;
    const int lane = tid & 63, wv = tid >> 6;
    const int G = gridDim.x, bid = blockIdx.x;
    if (xmode == 0 || xmode == 1) {
        const float* x = P.in[0]; const float* g1 = P.in[1];
        bf16_t* xn = (bf16_t*)(ws + OFF_XN);
        for (int row0 = (bid * 8 + wv) * 2; row0 < T; row0 += G * 16) {
            f32x4 v[2][4]; float s0 = 0.f, s1 = 0.f;
#pragma unroll
            for (int q = 0; q < 2; ++q) {
                const f32x4* xr = (const f32x4*)(x + (size_t)(row0 + q) * 1024) + lane;
#pragma unroll
                for (int j = 0; j < 4; ++j) v[q][j] = xr[64 * j];
            }
#pragma unroll
            for (int j = 0; j < 4; ++j) {
                s0 += v[0][j].x * v[0][j].x + v[0][j].y * v[0][j].y + v[0][j].z * v[0][j].z + v[0][j].w * v[0][j].w;
                s1 += v[1][j].x * v[1][j].x + v[1][j].y * v[1][j].y + v[1][j].z * v[1][j].z + v[1][j].w * v[1][j].w;
            }
            s0 = wave_sum(s0); s1 = wave_sum(s1);
            const float rs0 = rsqrtf(s0 * (1.f / 1024.f) + EPS), rs1 = rsqrtf(s1 * (1.f / 1024.f) + EPS);
#pragma unroll
            for (int j = 0; j < 4; ++j) {
                const f32x4 g = ((const f32x4*)g1)[lane + 64 * j];
                u32x2 o; o.x = pk2(v[0][j].x * rs0 * g.x, v[0][j].y * rs0 * g.y); o.y = pk2(v[0][j].z * rs0 * g.z, v[0][j].w * rs0 * g.w);
                *(u32x2*)(xn + (size_t)row0 * 1024 + lane * 4 + 256 * j) = o;
                o.x = pk2(v[1][j].x * rs1 * g.x, v[1][j].y * rs1 * g.y); o.y = pk2(v[1][j].z * rs1 * g.z, v[1][j].w * rs1 * g.w);
                *(u32x2*)(xn + (size_t)(row0 + 1) * 1024 + lane * 4 + 256 * j) = o;
            }
        }
    }
    if (xmode == 0 || xmode == 2) {
        const float* lam_re = P.in[3]; const float* lam_im = P.in[4]; const float* log_step = P.in[5];
        const float* b_re = P.in[6]; const float* b_im = P.in[7]; const float* c_re = P.in[8]; const float* c_im = P.in[9];
        float* pw_re = (float*)lds_raw;
        float* pw_im = pw_re + 64 * 33;
        float* bb_re = pw_im + 64 * 33;
        float* bb_im = bb_re + 1024;
        float* cc_re = bb_im + 1024;
        float* cc_im = cc_re + 64;
        float* Km = cc_im + 64;
        bf16_t* TgT = (bf16_t*)(ws + OFF_TGT); bf16_t* EgT = (bf16_t*)(ws + OFF_EGT); bf16_t* FgT = (bf16_t*)(ws + OFF_FGT);
        float* lam32 = (float*)(ws + OFF_LAM32);
        for (int u = bid; u < 512; u += G) {
            const int g = u >> 4, h = u & 15;
            const float step = expf(log_step[g]);
            __syncthreads();
            if (tid < 64) {
                const int p = tid;
                float ar, ai; cpow(lam_re[g * 64 + p], lam_im[g * 64 + p], step, 1, ar, ai);
                float zr = 1.f, zi = 0.f;
                for (int tau = 0; tau <= 32; ++tau) {
                    pw_re[p * 33 + tau] = zr; pw_im[p * 33 + tau] = zi;
                    const float nr = zr * ar - zi * ai, ni = zr * ai + zi * ar; zr = nr; zi = ni;
                }
                cc_re[tid] = c_re[(g * 16 + h) * 64 + tid]; cc_im[tid] = c_im[(g * 16 + h) * 64 + tid];
            }
            __syncthreads();
            for (int idx = tid; idx < 1024; idx += NTHREADS) {
                const int p = idx >> 4, hp = idx & 15;
                const float lr = lam_re[g * 64 + p], li = lam_im[g * 64 + p];
                const float re = pw_re[p * 33 + 1], im = pw_im[p * 33 + 1];
                const float nr = re - 1.f, ni = im, den = lr * lr + li * li;
                const float qr = (nr * lr + ni * li) / den, qi = (ni * lr - nr * li) / den;
                const float br = b_re[(g * 64 + p) * 16 + hp], bi = b_im[(g * 64 + p) * 16 + hp];
                bb_re[idx] = qr * br - qi * bi; bb_im[idx] = qr * bi + qi * br;
            }
            __syncthreads();
            {
                const int tau = tid >> 4, hp = tid & 15;
                float s = 0.f;
                for (int p = 0; p < 64; ++p) {
                    const float zr = cc_re[p] * pw_re[p * 33 + tau] - cc_im[p] * pw_im[p * 33 + tau];
                    const float zi = cc_re[p] * pw_im[p * 33 + tau] + cc_im[p] * pw_re[p * 33 + tau];
                    s += zr * bb_re[p * 16 + hp] - zi * bb_im[p * 16 + hp];
                }
                Km[tid] = s;
            }
            __syncthreads();
            for (int it = tid; it < 2048; it += NTHREADS) {
                const int t = it >> 6, q = it & 63, k = q >> 1, hp0 = (q & 1) * 8;
                u32x4 o = {0u, 0u, 0u, 0u};
                if (t >= k) { const float* km = Km + (t - k) * 16 + hp0; o.x = pk2(km[0], km[1]); o.y = pk2(km[2], km[3]); o.z = pk2(km[4], km[5]); o.w = pk2(km[6], km[7]); }
                *(u32x4*)(TgT + ((size_t)g * 512 + t * 16 + h) * 512 + q * 8) = o;
            }
            {
                const int t = tid >> 4, c = tid & 15;
                float f[8];
#pragma unroll
                for (int j = 0; j < 4; ++j) {
                    const int p = 4 * c + j;
                    const float zr = cc_re[p] * pw_re[p * 33 + t + 1] - cc_im[p] * pw_im[p * 33 + t + 1];
                    const float zi = cc_re[p] * pw_im[p * 33 + t + 1] + cc_im[p] * pw_re[p * 33 + t + 1];
                    f[2 * j] = zr; f[2 * j + 1] = -zi;
                }
                u32x4 o; o.x = pk2(f[0], f[1]); o.y = pk2(f[2], f[3]); o.z = pk2(f[4], f[5]); o.w = pk2(f[6], f[7]);
                *(u32x4*)(FgT + ((size_t)g * 512 + t * 16 + h) * 128 + c * 8) = o;
            }
            {
                const int nl = tid >> 6, q = tid & 63, p = 4 * h + (nl >> 1), ri = nl & 1, k = q >> 1, hp0 = (q & 1) * 8;
                const float ar = pw_re[p * 33 + 31 - k], ai = pw_im[p * 33 + 31 - k];
                float f[8];
#pragma unroll
                for (int j = 0; j < 8; ++j) {
                    const float br = bb_re[p * 16 + hp0 + j], bi = bb_im[p * 16 + hp0 + j];
                    f[j] = ri ? (ar * bi + ai * br) : (ar * br - ai * bi);
                }
                u32x4 o; o.x = pk2(f[0], f[1]); o.y = pk2(f[2], f[3]); o.z = pk2(f[4], f[5]); o.w = pk2(f[6], f[7]);
                *(u32x4*)(EgT + ((size_t)g * 128 + 2 * p + ri) * 512 + q * 8) = o;
            }
            if (h == 0 && tid < 64) { lam32[(g * 64 + tid) * 2] = pw_re[tid * 33 + 32]; lam32[(g * 64 + tid) * 2 + 1] = pw_im[tid * 33 + 32]; }
        }
        __syncthreads();
    }
    if (xmode == 0 || xmode == 3) {
        float* red = (float*)lds_raw;
        float* biasp = (float*)(ws + OFF_BIASP);
        for (int u = bid; u < 32; u += G) {
            const int kv = u >> 4, part = u & 15;
            const float* pos = P.in[kv ? 18 : 17]; const float* w1 = P.in[kv ? 21 : 19];
            const int n = tid & 255, half = tid >> 8;
            float s = 0.f;
            const int k0 = part * 128 + half * 64;
            for (int kk = k0; kk < k0 + 64; ++kk) s += pos[kk] * w1[(size_t)kk * 256 + n];
            __syncthreads();
            red[tid] = s;
            __syncthreads();
            if (tid < 256) biasp[(kv * 16 + part) * 256 + tid] = red[tid] + red[tid + 256];
        }
        __syncthreads();
    }
    if (xmode == 0 || xmode == 4) {
        const long gt = (long)bid * NTHREADS + tid, gs = (long)G * NTHREADS;
        tconv(P.in[2], 0, 1816, 1024, 1816, (bf16_t*)(ws + OFF_WINT), 0, 1024, 1, RowId(), 0, gt, gs);
        tconv(P.in[11], 0, 512, 512, 512, (bf16_t*)(ws + OFF_WGLUT), 0, 512, 1, RowId(), 0, gt, gs);
        tconv(P.in[19], (long)1024 * 256, 256, 1024, 256, (bf16_t*)(ws + OFF_WC1T), (long)256 * 1024, 1024, 2, RowId(), 0, gt, gs);
        tconv(P.in[21], (long)1024 * 256, 256, 1024, 256, (bf16_t*)(ws + OFF_WC1T) + (size_t)2 * 256 * 1024, (long)256 * 1024, 1024, 2, RowId(), 0, gt, gs);
        tconv(P.in[25], 0, 1024, 1024, 1024, (bf16_t*)(ws + OFF_WOUTT), 0, 1024, 1, RowId(), 0, gt, gs, P.in[23], P.in[24]);
        { float* ssq = (float*)(ws + OFF_SSQ); for (long i = gt; i < (long)T * 2; i += gs) ssq[i] = 0.f; }
        tconv(P.in[27], 0, 4, 1024, 4, (bf16_t*)(ws + OFF_WRT), 0, 1024, 1, RowId(), 0, gt, gs);
        tconv(P.in[29], 0, 32, 1024, 32, (bf16_t*)(ws + OFF_WRT), 0, 1024, 1, RowOff{4}, 0, gt, gs);
        tconv(P.in[27], 0, 4, 1024, 4, (bf16_t*)(ws + OFF_WRT) + 40 * 1024, 0, 1024, 1, RowId(), 1, gt, gs);
        tconv(P.in[29], 0, 32, 1024, 32, (bf16_t*)(ws + OFF_WRT) + 40 * 1024, 0, 1024, 1, RowOff{4}, 1, gt, gs);
    }
}

DI void epi_inproj(const Params& P, const float* Ct, int m0, int nt, int tid) {
    unsigned char* ws = P.ws;
    const int n0 = nt * 128;
    if (n0 < 512) {
        bf16_t* U = (bf16_t*)(ws + OFF_U);
        for (int it = tid; it < 2048; it += NTHREADS) {
            const int row = it >> 3, gi = it & 7;
            const float* s = Ct + row * CT_STRIDE + gi * 16;
            u32x4 o0, o1;
            o0.x = pk2(s[0], s[1]); o0.y = pk2(s[2], s[3]); o0.z = pk2(s[4], s[5]); o0.w = pk2(s[6], s[7]);
            o1.x = pk2(s[8], s[9]); o1.y = pk2(s[10], s[11]); o1.z = pk2(s[12], s[13]); o1.w = pk2(s[14], s[15]);
            bf16_t* d = U + ((size_t)((n0 >> 4) + gi) * T + m0 + row) * 16;
            *(u32x4*)d = o0; *(u32x4*)(d + 8) = o1;
        }
    } else if (n0 < 1792) {
        const int row = tid & 255, seg = tid >> 8;
        const int grow = m0 + row, b = grow >> 12, l = grow & 4095;
        const float* s = Ct + row * CT_STRIDE + seg * 64;
        const int kind = n0 < 1024 ? 0 : 1 + ((n0 - 1024) >> 7);
        if (kind == 4 || kind == 6) {
            bf16_t* dst = (bf16_t*)(ws + (kind == 4 ? OFF_VST : OFF_VWT));
            const int rl = tid & 63, cq = tid >> 6;
#pragma unroll 1
            for (int rr = 0; rr < 4; ++rr) {
                const int r2 = rl + 64 * rr, gr = m0 + r2, b2 = gr >> 12, l2 = gr & 4095;
#pragma unroll
                for (int cc = 0; cc < 16; ++cc) {
                    const int col = cq * 16 + cc, g = col >> 6, d = col & 63;
                    dst[((size_t)((b2 * 2 + g) * 64 + d)) * 4096 + l2] = (bf16_t)f2bf(Ct[r2 * CT_STRIDE + col]);
                }
            }
        } else {
            float scale = 1.f; const float* gw = nullptr; bf16_t* dst;
            if (kind == 0) { gw = P.in[13]; dst = (bf16_t*)(ws + OFF_QN) + (size_t)grow * 512 + (n0 - 512) + seg * 64; scale = 0.125f * 1.4426950408889634f; }
            else {
                const size_t off = kind == 1 ? OFF_KC : kind == 2 ? OFF_VC : kind == 3 ? OFF_KSN : OFF_KWN;
                dst = (bf16_t*)(ws + off) + ((size_t)((b * 2 + seg) * 4096 + l)) * 64;
                if (kind == 3) gw = P.in[15]; else if (kind == 5) gw = P.in[16];
            }
            float rs = 1.f;
            if (gw) {
                float ss = 0.f;
#pragma unroll
                for (int c4 = 0; c4 < 16; ++c4) { const f32x4 v = *(const f32x4*)(s + c4 * 4); ss += v.x * v.x + v.y * v.y + v.z * v.z + v.w * v.w; }
                rs = rsqrtf(ss * (1.f / 64.f) + EPS) * scale;
            }
#pragma unroll
            for (int c8 = 0; c8 < 8; ++c8) {
                f32x4 v0 = *(const f32x4*)(s + c8 * 8), v1 = *(const f32x4*)(s + c8 * 8 + 4);
                if (gw) {
                    const f32x4 g0 = *(const f32x4*)(gw + c8 * 8), g1 = *(const f32x4*)(gw + c8 * 8 + 4);
                    v0 = v0 * g0 * rs; v1 = v1 * g1 * rs;
                }
                u32x4 o; o.x = pk2(v0.x, v0.y); o.y = pk2(v0.z, v0.w); o.z = pk2(v1.x, v1.y); o.w = pk2(v1.z, v1.w);
                *(u32x4*)(dst + c8 * 8) = o;
            }
        }
    } else {
        if (tid < 256) {
            float* gates = (float*)(ws + OFF_GATES) + (size_t)(m0 + tid) * 24;
            const float* s = Ct + tid * CT_STRIDE;
#pragma unroll
            for (int c = 0; c < 24; ++c) gates[c] = sigmoidf(s[c]);
        }
    }
}
DI void phase1(const Params& P, unsigned char* lds_raw, int tid, int xmode = 0) {
    bf16_t* lds = (bf16_t*)lds_raw; float* Ct = (float*)lds_raw;
    const bf16_t* xn = (const bf16_t*)(P.ws + OFF_XN);
    const bf16_t* WinT = (const bf16_t*)(P.ws + OFF_WINT);
    for (int u = vbid(); u < 64 * 8; u += gridDim.x) {
        const int mt = u >> 3, nt2 = u & 7, m0 = mt * 256;
        f32x16 acc[2][4]; zero_acc2(acc);
        const ASrc A = make_a(xn, 1024, nullptr, T, m0, tid);
        const BSrc2 bs = make_b2(WinT, 1024, DIN, nt2 * 256, tid);
        __syncthreads();
        if (xmode != 4) gemm_mainloop2(acc, A, bs, 1024, lds, tid);
#pragma unroll 1
        for (int half = 0; half < 2; ++half) {
            const int nt = nt2 * 2 + half;
            if (nt * 128 >= DIN) break;
            if (xmode == 5) { if (tid == 0 && acc[0][0][0] + acc[1][3][5] + acc[0][1][1] + acc[1][2][7] + acc[0][2][3] + acc[0][3][9] + acc[1][0][4] + acc[1][1][2] == 12345.f) ((float*)P.ws)[1] = 1.f; continue; }
            dump_acc2(acc, Ct, tid, half);
            __syncthreads();
            epi_inproj(P, Ct, m0, nt, tid);
            __syncthreads();
        }
    }
    __syncthreads();
}

DI void st_wt8(void* p, u32x2 v) { asm volatile("global_store_dwordx2 %0, %1, off sc1\n\ts_nop 1" :: "v"(p), "v"(v) : "memory"); }
DI void st_wt16f(void* p, f32x4 v) { asm volatile("global_store_dwordx4 %0, %1, off sc1\n\ts_nop 1" :: "v"(p), "v"(v) : "memory"); }
DI void unit_signal(unsigned* ctr, int tid) {
    asm volatile("s_waitcnt vmcnt(0)" ::: "memory");
    __syncthreads();
    if (tid == 0) __hip_atomic_fetch_add(ctr, 1u, __ATOMIC_RELAXED, __HIP_MEMORY_SCOPE_AGENT);
}
DI void unit_wait2(unsigned* ctr, unsigned target, unsigned* ctr2, unsigned target2, int tid) {
    if (tid == 0) {
        unsigned sp = 0;
        while (__hip_atomic_load(ctr, __ATOMIC_RELAXED, __HIP_MEMORY_SCOPE_AGENT) < target) { __builtin_amdgcn_s_sleep(4); if (++sp > (1u << 22)) break; }
        if (ctr2) { sp = 0; while (__hip_atomic_load(ctr2, __ATOMIC_RELAXED, __HIP_MEMORY_SCOPE_AGENT) < target2) { __builtin_amdgcn_s_sleep(4); if (++sp > (1u << 22)) break; } }
        __builtin_amdgcn_fence(__ATOMIC_ACQUIRE, "agent");
        asm volatile("s_waitcnt vmcnt(0)" ::: "memory");
    }
    __syncthreads();
}
DI void unit_wait(unsigned* ctr, unsigned target, int tid) {
    if (tid == 0) {
        unsigned sp = 0;
        while (__hip_atomic_load(ctr, __ATOMIC_RELAXED, __HIP_MEMORY_SCOPE_AGENT) < target) { __builtin_amdgcn_s_sleep(4); if (++sp > (1u << 22)) break; }
        __builtin_amdgcn_fence(__ATOMIC_ACQUIRE, "agent");
        asm volatile("s_waitcnt vmcnt(0)" ::: "memory");
    }
    __syncthreads();
}
DI void mlp2_unit(const Params& P, unsigned char* lds_raw, int u, int tid) {
    unsigned char* ws = P.ws;
    {
        unit_wait((unsigned*)(ws + OFF_CTL) + CW_PDONE + (u >> 3), 4u, tid);
            const int idx = u, rc = idx & 7, bg = (idx >> 3) & 7, kv = idx >> 6;
            float* Hs = (float*)lds_raw;
            const float* Pt = (const float*)(ws + OFF_P) + ((size_t)((kv * 8 + bg) * 2 + 0) * 256) * 256;
            const float* Pb = (const float*)(ws + OFF_P) + ((size_t)((kv * 8 + bg) * 2 + 1) * 256) * 256;
            const float* biasp = (const float*)(ws + OFF_BIASP) + kv * 16 * 256;
            const int n = tid & 255;
            float bias = 0.f;
#pragma unroll
            for (int pp = 0; pp < 16; ++pp) bias += biasp[pp * 256 + n];
            for (int it = tid; it < 8192; it += NTHREADS) {
                const int rr = it >> 8, j = rc * 32 + rr;
                float hv = 0.f;
                if (j < 255) hv = gelu_tanh(Pt[j * 256 + n] + Pb[(j + 1) * 256 + n] + bias);
                Hs[rr * 256 + n] = hv;
            }
            __syncthreads();
            const int rr = tid >> 4, dq = tid & 15, j = rc * 32 + rr;
            const float* w2 = P.in[kv ? 22 : 20];
            f32x4 a = {0.f, 0.f, 0.f, 0.f};
            for (int k = 0; k < 256; ++k) {
                const float hv = Hs[rr * 256 + k];
                const f32x4 w = *(const f32x4*)(w2 + k * 64 + dq * 4);
                a = a + w * hv;
            }
            if (kv == 0) {
                float ss = a.x * a.x + a.y * a.y + a.z * a.z + a.w * a.w;
                ss += __shfl_xor(ss, 1); ss += __shfl_xor(ss, 2); ss += __shfl_xor(ss, 4); ss += __shfl_xor(ss, 8);
                const float rs = rsqrtf(ss * (1.f / 64.f) + EPS);
                const f32x4 g = *(const f32x4*)(P.in[14] + dq * 4);
                u32x2 o; o.x = pk2(a.x * rs * g.x, a.y * rs * g.y); o.y = pk2(a.z * rs * g.z, a.w * rs * g.w);
                if (j == 255) { o.x = 0u; o.y = 0u; }
                *(u32x2*)((bf16_t*)(ws + OFF_KCMP) + ((size_t)bg * 256 + j) * 64 + dq * 4) = o;
            } else {
                bf16_t* vt = (bf16_t*)(ws + OFF_VCMPT) + (size_t)bg * 64 * 256;
                if (j == 255) a = (f32x4){0.f, 0.f, 0.f, 0.f};
                vt[(dq * 4 + 0) * 256 + j] = (bf16_t)f2bf(a.x); vt[(dq * 4 + 1) * 256 + j] = (bf16_t)f2bf(a.y);
                vt[(dq * 4 + 2) * 256 + j] = (bf16_t)f2bf(a.z); vt[(dq * 4 + 3) * 256 + j] = (bf16_t)f2bf(a.w);
            }
    }
    __syncthreads();
}
DI void phase2(const Params& P, unsigned char* lds_raw, int tid) {
    bf16_t* lds = (bf16_t*)lds_raw; float* Ct = (float*)lds_raw;
    unsigned char* ws = P.ws;
    {
        const int G = gridDim.x, nh = G > 128 ? G - 128 : G, hid = G > 128 ? vbid() - 128 : vbid();
        if (hid >= 0) {
            const long gt = (long)hid * NTHREADS + tid, gs = (long)nh * NTHREADS;
            tconv(P.in[31], (long)1024 * 256, 256, 1024, 256, (bf16_t*)(ws + OFF_WGUT), (long)512 * 1024, 1024, 32, RowGU{0}, 0, gt, gs);
            tconv(P.in[32], (long)1024 * 256, 256, 1024, 256, (bf16_t*)(ws + OFF_WGUT), (long)512 * 1024, 1024, 32, RowGU{1}, 0, gt, gs);
            tconv(P.in[33], (long)256 * 1024, 1024, 256, 1024, (bf16_t*)(ws + OFF_WDT), (long)1024 * 256, 256, 32, RowId(), 0, gt, gs);
        }
    }
    for (int u = vbid(); u < 128; u += gridDim.x) {
        f32x16 acc[2][2]; zero_acc(acc);
        if (u < 64) {
            const int g = u >> 1, mt = u & 1, m0 = mt * 256;
            const bf16_t* A = (const bf16_t*)(ws + OFF_U) + (size_t)g * T * 16;
            const ASrc As = make_a(A, 512, nullptr, 512, m0, tid);
            const BSrcBf bs = make_bbf((const bf16_t*)(ws + OFF_EGT) + (size_t)g * 128 * 512, 512, 128, 0, tid);
            __syncthreads();
            gemm_mainloop(acc, As, bs, 512, lds, tid);
            dump_acc(acc, Ct, tid);
            __syncthreads();
            if (tid < 128) {
                const int bb = tid >> 6, p = tid & 63;
                const float* lam32 = (const float*)(ws + OFF_LAM32) + (g * 64 + p) * 2;
                const float ar = lam32[0], ai = lam32[1];
                float sr = 0.f, si = 0.f;
                float* zp = Ct + (bb * 128) * CT_STRIDE + 2 * p;
                for (int c = 0; c < 128; ++c) {
                    const float zr = zp[c * CT_STRIDE], zi = zp[c * CT_STRIDE + 1];
                    zp[c * CT_STRIDE] = sr; zp[c * CT_STRIDE + 1] = si;
                    const float nr = ar * sr - ai * si + zr, ni = ar * si + ai * sr + zi;
                    sr = nr; si = ni;
                }
            }
            __syncthreads();
            bf16_t* Sin = (bf16_t*)(ws + OFF_SIN) + ((size_t)g * 512 + m0) * 128;
            for (int it = tid; it < 256 * 16; it += NTHREADS) {
                const int row = it >> 4, c8 = it & 15;
                const float* sp = Ct + row * CT_STRIDE + c8 * 8;
                u32x4 o; o.x = pk2(sp[0], sp[1]); o.y = pk2(sp[2], sp[3]); o.z = pk2(sp[4], sp[5]); o.w = pk2(sp[6], sp[7]);
                *(u32x4*)(Sin + row * 128 + c8 * 8) = o;
            }
        } else {
            const int idx = u - 64, nt = idx & 1, part = (idx >> 1) & 1, bg = (idx >> 2) & 7, kv = idx >> 5;
            const bf16_t* A = (const bf16_t*)(ws + (kv ? OFF_VC : OFF_KC)) + (size_t)bg * 4096 * 64;
            const ASrc As = make_a(A, 1024, nullptr, 256, 0, tid);
            const BSrcBf bs = make_bbf((const bf16_t*)(ws + OFF_WC1T) + (size_t)(kv * 2 + part) * 256 * 1024, 1024, 256, nt * 128, tid);
            __syncthreads();
            gemm_mainloop(acc, As, bs, 1024, lds, tid);
            dump_acc(acc, Ct, tid);
            __syncthreads();
            float* Pp = (float*)(ws + OFF_P) + ((size_t)((kv * 8 + bg) * 2 + part) * 256) * 256 + nt * 128;
            for (int it = tid; it < 256 * 32; it += NTHREADS) {
                const int row = it >> 5, c4 = it & 31;
                st_wt16f(Pp + row * 256 + c4 * 4, *(const f32x4*)(Ct + row * CT_STRIDE + c4 * 4));
            }
            unit_signal((unsigned*)(ws + OFF_CTL) + CW_PDONE + kv * 8 + bg, tid);
        }
    }
    for (int u = vbid(); u < 128; u += gridDim.x) mlp2_unit(P, lds_raw, u, tid);
    __syncthreads();
}

DI void s5_main_unit(const Params& P, unsigned char* lds_raw, int u, int tid) {
    bf16_t* lds = (bf16_t*)lds_raw; float* Ct = (float*)lds_raw;
    unsigned char* ws = P.ws;
    const int nt = u & 3, mt = (u >> 2) & 1, g = u >> 3, m0 = mt * 256, n0 = nt * 128;
    f32x16 acc[2][2]; zero_acc(acc);
    const bf16_t* Ug = (const bf16_t*)(ws + OFF_U) + (size_t)g * T * 16;
    {
        const ASrc As = make_a(Ug, 512, nullptr, 512, m0, tid);
        const BSrcBf bs = make_bbf((const bf16_t*)(ws + OFF_TGT) + (size_t)g * 512 * 512, 512, 512, n0, tid);
        __syncthreads();
        gemm_mainloop(acc, As, bs, 512, lds, tid);
    }
    {
        const bf16_t* S = (const bf16_t*)(ws + OFF_SIN) + (size_t)g * 512 * 128;
        const ASrc As = make_a(S, 128, nullptr, 512, m0, tid);
        const BSrcBf bs = make_bbf((const bf16_t*)(ws + OFF_FGT) + (size_t)g * 512 * 128, 128, 512, n0, tid);
        gemm_mainloop(acc, As, bs, 128, lds, tid);
    }
    dump_acc(acc, Ct, tid);
    __syncthreads();
    const float* dsk = P.in[10] + g * 16;
    bf16_t* y1 = (bf16_t*)(ws + OFF_Y1);
    for (int it = tid; it < 2048; it += NTHREADS) {
        const int row = it >> 3, tt = it & 7;
        const int token = 32 * (m0 + row) + (n0 >> 4) + tt;
        const float* s = Ct + row * CT_STRIDE + tt * 16;
        const u32x4 u0 = *(const u32x4*)(Ug + (size_t)token * 16), u1 = *(const u32x4*)(Ug + (size_t)token * 16 + 8);
        const unsigned uw[8] = {u0.x, u0.y, u0.z, u0.w, u1.x, u1.y, u1.z, u1.w};
        unsigned ow[8];
#pragma unroll
        for (int q = 0; q < 8; ++q) {
            const float ua = bf2f(uw[q] & 0xffffu), ub = bf2f(uw[q] >> 16);
            const float ya = gelu_tanh(s[2 * q] + dsk[2 * q] * ua), yb = gelu_tanh(s[2 * q + 1] + dsk[2 * q + 1] * ub);
            ow[q] = pk2(ya, yb);
        }
        bf16_t* d = y1 + (size_t)token * 512 + g * 16;
        *(u32x4*)d = (u32x4){ow[0], ow[1], ow[2], ow[3]}; *(u32x4*)(d + 8) = (u32x4){ow[4], ow[5], ow[6], ow[7]};
    }
}

constexpr int KSTR = 72, VSTR = 68;
constexpr int KSLOT = 64 * KSTR, VSLOT = 64 * VSTR;
constexpr int AT_KBUF = 0;
constexpr int AT_VBUF = AT_KBUF + 3 * KSLOT * 2;
constexpr int VCSTR = 260;
constexpr int AT_CK   = 0;
constexpr int AT_CV   = AT_CK + 256 * KSTR * 2;
constexpr int AT_RING_END = AT_VBUF + 3 * VSLOT * 2;
constexpr int AT_CEND = AT_CV + 64 * VCSTR * 2;
constexpr int AT_IMP  = (AT_CEND > AT_RING_END ? AT_CEND : AT_RING_END);
constexpr int IMPS = 65;
constexpr int AT_MASK = AT_IMP + 4 * 64 * IMPS * 4;
constexpr int AT_INVL = AT_MASK + 64 * 8;
constexpr int AT_END  = AT_INVL + 256 * 4;

struct KVRegs { u32x4 k; u32x4 v; };
DI void kv_load(KVRegs& r, const bf16_t* Kt, const bf16_t* Vt, long ldv, int tid) {
    r.k = *(const u32x4*)(Kt + (tid >> 3) * 64 + (tid & 7) * 8);
    r.v = *(const u32x4*)(Vt + (long)(tid >> 3) * ldv + (tid & 7) * 8);
}
DI void kv_store(const KVRegs& r, bf16_t* Kb, bf16_t* Vb, int tid) {
    *(u32x4*)(Kb + (tid >> 3) * KSTR + (tid & 7) * 8) = r.k;
    u32x2 lo, hi; lo.x = r.v.x; lo.y = r.v.y; hi.x = r.v.z; hi.y = r.v.w;
    *(u32x2*)(Vb + (tid >> 3) * VSTR + (tid & 7) * 8) = lo;
    *(u32x2*)(Vb + (tid >> 3) * VSTR + (tid & 7) * 8 + 4) = hi;
}
DI bf16x8 pack8(const f32x16& x, int s) {
    u32x4 p;
    p.x = pk2(x[8 * s], x[8 * s + 1]); p.y = pk2(x[8 * s + 2], x[8 * s + 3]); p.z = pk2(x[8 * s + 4], x[8 * s + 5]); p.w = pk2(x[8 * s + 6], x[8 * s + 7]);
    return __builtin_bit_cast(bf16x8, p);
}
DI void qk_tile(f32x16 (&S)[2], const bf16_t* Kb, const bf16x8 (&qf)[4], int r, int h, bool edge, int d0, int dmax, int pm) {
    const int NEGB = __builtin_bit_cast(int, -1e30f);
    if (edge) {
#pragma unroll
        for (int kh = 0; kh < 2; ++kh)
#pragma unroll
            for (int i = 0; i < 16; ++i) {
                const int d = d0 - (32 * kh + (i & 3) + 8 * (i >> 2));
                const int m = (d >> 31) | ((dmax - d) >> 31) | pm;
                S[kh][i] = __builtin_bit_cast(float, m & NEGB);
            }
    } else {
        const float iv = __builtin_bit_cast(float, pm & NEGB);
#pragma unroll
        for (int kh = 0; kh < 2; ++kh)
#pragma unroll
            for (int i = 0; i < 16; ++i) S[kh][i] = iv;
    }
    bf16x8 kf[2][4];
#pragma unroll
    for (int kh = 0; kh < 2; ++kh)
#pragma unroll
        for (int s = 0; s < 4; ++s) kf[kh][s] = *(const bf16x8*)(Kb + (32 * kh + r) * KSTR + 16 * s + 8 * h);
    asm volatile("" ::: "memory");
#pragma unroll
    for (int s = 0; s < 4; ++s)
#pragma unroll
        for (int kh = 0; kh < 2; ++kh) S[kh] = MFMA32(kf[kh][s], qf[s], S[kh]);
}
#ifndef AT_X
#define AT_X 0
#endif
DI void softmax_tile(f32x16 (&S)[2], float& lsum, int ax = 0) {
    float ls = 0.f;
#pragma unroll
    for (int kh = 0; kh < 2; ++kh)
#pragma unroll
        for (int i = 0; i < 16; ++i) { const float p = (ax == 1) ? S[kh][i] * 0.001f : __builtin_amdgcn_exp2f(S[kh][i]); S[kh][i] = p; ls += p; }
    lsum += ls;
}
DI void pv_tile(f32x16 (&O)[2], const f32x16 (&Pm)[2], const bf16_t* Vb, int r, int h) {
    bf16x8 vf[2][2][2];
#pragma unroll
    for (int kh = 0; kh < 2; ++kh)
#pragma unroll
        for (int sp = 0; sp < 2; ++sp)
#pragma unroll
            for (int dh = 0; dh < 2; ++dh) {
                const bf16_t* vp = Vb + (32 * dh + r) * VSTR + 32 * kh + 16 * sp + 4 * h;
                const s16x4 lo = *(const s16x4*)vp, hi = *(const s16x4*)(vp + 8);
                vf[kh][sp][dh] = __builtin_shufflevector(lo, hi, 0, 1, 2, 3, 4, 5, 6, 7);
            }
    asm volatile("" ::: "memory");
#pragma unroll
    for (int kh = 0; kh < 2; ++kh)
#pragma unroll
        for (int sp = 0; sp < 2; ++sp) {
            const bf16x8 pf = pack8(Pm[kh], sp);
#pragma unroll
            for (int dh = 0; dh < 2; ++dh) O[dh] = MFMA32(vf[kh][sp][dh], pf, O[dh]);
        }
}
DI void pv_tile_c(f32x16 (&O)[2], const f32x16 (&Pm)[2], const bf16_t* Vc, int kt, int r, int h) {
    bf16x8 vf[2][2][2];
#pragma unroll
    for (int kh = 0; kh < 2; ++kh)
#pragma unroll
        for (int sp = 0; sp < 2; ++sp)
#pragma unroll
            for (int dh = 0; dh < 2; ++dh) {
                const bf16_t* vp = Vc + (32 * dh + r) * VCSTR + 64 * kt + 32 * kh + 16 * sp + 4 * h;
                const s16x4 lo = *(const s16x4*)vp, hi = *(const s16x4*)(vp + 8);
                vf[kh][sp][dh] = __builtin_shufflevector(lo, hi, 0, 1, 2, 3, 4, 5, 6, 7);
            }
    asm volatile("" ::: "memory");
#pragma unroll
    for (int kh = 0; kh < 2; ++kh)
#pragma unroll
        for (int sp = 0; sp < 2; ++sp) {
            const bf16x8 pf = pack8(Pm[kh], sp);
#pragma unroll
            for (int dh = 0; dh < 2; ++dh) O[dh] = MFMA32(vf[kh][sp][dh], pf, O[dh]);
        }
}
struct SeqBits { unsigned long long rem; DI int pop() { if (rem == 0ull) return -1; const int k = __builtin_ctzll(rem); rem &= rem - 1; return k; } };
struct SeqDown { int cur, lo; DI int pop() { if (cur < lo) return -1; return cur--; } };
template <int BR, class Seq>
DI void attn_stream(f32x16 (&O)[2], float& lsum, Seq seq, const bf16_t* Kg, const bf16_t* Vg, bf16_t* Kbuf, bf16_t* Vbuf,
                    const bf16x8 (&qf)[4], int qt, int tq, unsigned long long mymask, int r, int h, int tid, int ax = 0) {
#define AT_QK(SREG, T, SLOT) do { const int _t = (T); const bool _edge = (_t == qt) || (BR == 2 && _t == qt - 8); \
        const int _pm = (BR == 1) ? ((int)((mymask >> _t) & 1ull) - 1) : 0; int _d0 = tq - 64 * _t - 4 * h; asm volatile("" : "+v"(_d0)); \
        qk_tile(SREG, Kbuf + (SLOT) * KSLOT, qf, r, h, _edge, _d0, BR == 2 ? 511 : 0x3fffffff, _pm); } while (0)
    int t0 = seq.pop(), t1 = seq.pop(), t2 = seq.pop();
    KVRegs R0;
    {
        KVRegs R1;
        kv_load(R0, Kg + (size_t)t0 * 64 * 64, Vg + t0 * 64, 4096, tid);
        if (t1 >= 0) kv_load(R1, Kg + (size_t)t1 * 64 * 64, Vg + t1 * 64, 4096, tid);
        kv_store(R0, Kbuf, Vbuf, tid);
        if (t1 >= 0) kv_store(R1, Kbuf + KSLOT, Vbuf + VSLOT, tid);
    }
    __syncthreads();
    f32x16 Sc[2], Sn[2];
    AT_QK(Sc, t0, 0);
    int sl = 0;
    while (true) {
        const int s1 = sl == 2 ? 0 : sl + 1, s2 = s1 == 2 ? 0 : s1 + 1;
        if (t2 >= 0 && ax != 3 && ax < 7) kv_load(R0, Kg + (size_t)t2 * 64 * 64, Vg + t2 * 64, 4096, tid);
        if (ax == 7) { lsum += (float)t0; }
        else if (ax == 8) { if (t1 >= 0) AT_QK(Sn, t1, s1); lsum += Sn[0][0] + Sn[1][5]; }
        else if (ax == 9) { softmax_tile(Sc, lsum, 0); pv_tile(O, Sc, Vbuf + sl * VSLOT, r, h); Sn[0] = Sc[0]; Sn[1] = Sc[1]; }
        else {
        if (t1 >= 0) AT_QK(Sn, t1, s1);
        softmax_tile(Sc, lsum, ax);
        if (ax != 2) pv_tile(O, Sc, Vbuf + sl * VSLOT, r, h);
        else { O[0][0] += Sc[0][3] + Sc[1][7]; }
        }
        if (t2 >= 0 && ax < 7) kv_store(R0, Kbuf + s2 * KSLOT, Vbuf + s2 * VSLOT, tid);
        if (ax != 5 && ax < 7) __syncthreads();
        if (t1 < 0) break;
#pragma unroll
        for (int kh = 0; kh < 2; ++kh) Sc[kh] = Sn[kh];
        t0 = t1; t1 = t2; t2 = seq.pop(); sl = s1;
    }
#undef AT_QK
}

DI void attn_unit(const Params& P, unsigned char* lds_raw, int a, int tid, bool dry = false, int ax = 0) {
    unsigned char* ws = P.ws;
    const int qt = 63 - (a >> 3), bg = a & 7, b = bg >> 1, g = bg & 1;
    const int lane = tid & 63, w = tid >> 6, r = lane & 31, h = lane >> 5;
    const int hh = w >> 1, th = w & 1;
    const int t0 = qt * 64;
    const int tql = 32 * th + r;
    const int tq = t0 + tql;
    const size_t tqg = (size_t)b * 4096 + tq;
    bf16_t* Kbuf = (bf16_t*)(lds_raw + AT_KBUF);
    bf16_t* Vbuf = (bf16_t*)(lds_raw + AT_VBUF);
    float* imp = (float*)(lds_raw + AT_IMP);
    unsigned long long* selm = (unsigned long long*)(lds_raw + AT_MASK);
    float* invl = (float*)(lds_raw + AT_INVL);

    bf16x8 qf[4];
    {
        const bf16_t* qp = (const bf16_t*)(ws + OFF_QN) + tqg * 512 + g * 256 + hh * 64 + 8 * h;
#pragma unroll
        for (int s = 0; s < 4; ++s) qf[s] = *(const bf16x8*)(qp + 16 * s);
    }
    const float* gp = (const float*)(ws + OFF_GATES) + tqg * 24 + g * 12 + hh * 3;
    const float gate_c = gp[0], gate_s = gp[1], gate_w = gp[2];

    const bf16_t* Kc = (const bf16_t*)(ws + OFF_KCMP) + (size_t)bg * 256 * 64;
    const bf16_t* Vc = (const bf16_t*)(ws + OFF_VCMPT) + (size_t)bg * 64 * 256;
    int ncmp = (4 * qt + 2) / 64 + 1; if (ncmp > 4) ncmp = 4;
    u32x4 kq[4], vq[4];
#pragma unroll
    for (int i = 0; i < 4; ++i) if (i < ncmp) {
        kq[i] = *(const u32x4*)(Kc + (size_t)(64 * i + (tid >> 3)) * 64 + (tid & 7) * 8);
        vq[i] = *(const u32x4*)(Vc + (size_t)(tid >> 3) * 256 + 64 * i + (tid & 7) * 8);
    }
    __syncthreads();
    float* impw = imp + ((hh * 64 + 32 * th) * IMPS);
    for (int i = lane; i < 32 * IMPS; i += 64) impw[i] = 0.f;
    f32x16 O[2];
#pragma unroll
    for (int dh = 0; dh < 2; ++dh)
#pragma unroll
        for (int i = 0; i < 16; ++i) O[dh][i] = 0.f;
    float inv_c;
    {
        float lsum = 0.f;
        bf16_t* Kcl = (bf16_t*)(lds_raw + AT_CK); bf16_t* Vcl = (bf16_t*)(lds_raw + AT_CV);
        {
#pragma unroll
            for (int i = 0; i < 4; ++i) if (i < ncmp) {
                *(u32x4*)(Kcl + (64 * i + (tid >> 3)) * KSTR + (tid & 7) * 8) = kq[i];
                bf16_t* vd = Vcl + (tid >> 3) * VCSTR + 64 * i + (tid & 7) * 8;
                u32x2 t; t.x = vq[i].x; t.y = vq[i].y; *(u32x2*)vd = t; t.x = vq[i].z; t.y = vq[i].w; *(u32x2*)(vd + 4) = t;
            }
        }
        __syncthreads();
        int jmax = tq >= 31 ? ((tq - 31) >> 4) : -1; jmax = jmax < 254 ? jmax : 254;
        for (int kt = 0; kt < ncmp; ++kt) {
            f32x16 S[2];
            qk_tile(S, Kcl + kt * 64 * KSTR, qf, r, h, true, jmax - 64 * kt - 4 * h, 0x3fffffff, 0);
            softmax_tile(S, lsum);
            float* ir = impw + r * IMPS + 16 * kt + h;
#pragma unroll
            for (int kh = 0; kh < 2; ++kh)
#pragma unroll
                for (int gq = 0; gq < 4; ++gq)
                    ir[8 * kh + 2 * gq] += (S[kh][4 * gq] + S[kh][4 * gq + 1]) + (S[kh][4 * gq + 2] + S[kh][4 * gq + 3]);
            asm volatile("s_waitcnt lgkmcnt(0)" ::: "memory");
#pragma unroll
            for (int kh = 0; kh < 2; ++kh)
#pragma unroll
                for (int gq = 0; gq < 4; ++gq) {
                    const int sl = 8 * kh + 2 * gq + 1;
                    if (16 * kt + h + sl < 64) ir[sl] += S[kh][4 * gq + 3];
                }
            asm volatile("s_waitcnt lgkmcnt(0)" ::: "memory");
            pv_tile_c(O, S, Vcl, kt, r, h);
        }
        lsum += __shfl_xor(lsum, 32);
        inv_c = lsum > 0.f ? 1.f / lsum : 0.f;
        if (h == 0) invl[hh * 64 + tql] = inv_c;
    }
    __syncthreads();
    {
        const int cur = qt;
        const bool forced = (lane == 0) || (lane == cur) || (lane == cur - 1);
        const bool valid = lane <= cur;
        unsigned key[8]; unsigned thr[8];
#pragma unroll
        for (int i = 0; i < 8; ++i) {
            const int tl = w * 8 + i;
            const float v = (imp[(0 * 64 + tl) * IMPS + lane] * invl[tl] + imp[(1 * 64 + tl) * IMPS + lane] * invl[64 + tl]) + (imp[(2 * 64 + tl) * IMPS + lane] * invl[128 + tl] + imp[(3 * 64 + tl) * IMPS + lane] * invl[192 + tl]);
            key[i] = forced ? 0xFFFFFFFFu : (valid ? __builtin_bit_cast(unsigned, v) : 0u);
            thr[i] = 0u;
        }
#pragma unroll 1
        for (int bit = 30; bit >= 0; --bit) {
#pragma unroll
            for (int i = 0; i < 8; ++i) {
                const unsigned cand = thr[i] | (1u << bit);
                if (__popcll(__ballot(key[i] >= cand)) >= 16) thr[i] = cand;
            }
        }
#pragma unroll
        for (int i = 0; i < 8; ++i) {
            const int tl = w * 8 + i;
            const unsigned long long gtm = __ballot(key[i] > thr[i]), eqm = __ballot(key[i] == thr[i]);
            const int need = 16 - __popcll(gtm);
            const bool sel = (key[i] > thr[i]) || ((key[i] == thr[i]) && (__popcll(eqm & ((1ull << lane) - 1ull)) < need));
            const unsigned long long mask = __ballot(sel);
            if (lane == 0) selm[tl] = mask;
        }
    }
    __syncthreads();
    float* accw = imp + (w * 32) * 64 + lane;
    {
        const float g_cmp = gate_c * inv_c;
#pragma unroll
        for (int dh = 0; dh < 2; ++dh)
#pragma unroll
            for (int i = 0; i < 16; ++i) accw[(dh * 16 + i) * 64] = g_cmp * O[dh][i];
    }
    const unsigned long long mymask = selm[tql];
    unsigned long long ormask = selm[lane];
#pragma unroll
    for (int o = 1; o < 64; o <<= 1) ormask |= __shfl_xor(ormask, o);
    ormask &= (qt >= 63) ? ~0ull : ((1ull << (qt + 1)) - 1ull);
    ormask |= 1ull;
    {
        const bf16_t* Ks = (const bf16_t*)(ws + OFF_KSN) + (size_t)bg * 4096 * 64;
        const bf16_t* Vs = (const bf16_t*)(ws + OFF_VST) + (size_t)bg * 64 * 4096;
#pragma unroll
        for (int dh = 0; dh < 2; ++dh)
#pragma unroll
            for (int i = 0; i < 16; ++i) O[dh][i] = 0.f;
        float l = 0.f;
        if (ax != 4) attn_stream<1>(O, l, SeqBits{ormask}, Ks, Vs, Kbuf, Vbuf, qf, qt, tq, mymask, r, h, tid, ax); else l = 1.f;
        l += __shfl_xor(l, 32);
        const float sc = gate_s / l;
#pragma unroll
        for (int dh = 0; dh < 2; ++dh)
#pragma unroll
            for (int i = 0; i < 16; ++i) accw[(dh * 16 + i) * 64] += sc * O[dh][i];
    }
    {
        const bf16_t* Kw = (const bf16_t*)(ws + OFF_KWN) + (size_t)bg * 4096 * 64;
        const bf16_t* Vw = (const bf16_t*)(ws + OFF_VWT) + (size_t)bg * 64 * 4096;
#pragma unroll
        for (int dh = 0; dh < 2; ++dh)
#pragma unroll
            for (int i = 0; i < 16; ++i) O[dh][i] = 0.f;
        float l = 0.f;
        if (ax != 4) attn_stream<2>(O, l, SeqDown{qt, qt >= 8 ? qt - 8 : 0}, Kw, Vw, Kbuf, Vbuf, qf, qt, tq, 0ull, r, h, tid, ax); else l = 1.f;
        l += __shfl_xor(l, 32);
        const float sc = gate_w / l;
        bf16_t* dst = (bf16_t*)(ws + OFF_XN) + tqg * 1024 + 512 + g * 256 + hh * 64;
        float sq = 0.f;
#pragma unroll
        for (int dh = 0; dh < 2; ++dh)
#pragma unroll
            for (int gq = 0; gq < 4; ++gq) {
                const float o0 = accw[(dh * 16 + 4 * gq + 0) * 64] + sc * O[dh][4 * gq + 0];
                const float o1 = accw[(dh * 16 + 4 * gq + 1) * 64] + sc * O[dh][4 * gq + 1];
                const float o2 = accw[(dh * 16 + 4 * gq + 2) * 64] + sc * O[dh][4 * gq + 2];
                const float o3 = accw[(dh * 16 + 4 * gq + 3) * 64] + sc * O[dh][4 * gq + 3];
                u32x2 o; o.x = pk2(o0, o1); o.y = pk2(o2, o3);
                if (ax == 0 || o.x == 0x12345678u) *(u32x2*)(dst + 32 * dh + 8 * gq + 4 * h) = o;
                sq += (o0 * o0 + o1 * o1) + (o2 * o2 + o3 * o3);
            }
        sq += __shfl_xor(sq, 32);
        if (h == 0 && !dry) __hip_atomic_fetch_add((float*)(ws + OFF_SSQ) + tqg * 2 + 1, sq, __ATOMIC_RELAXED, __HIP_MEMORY_SCOPE_AGENT);
    }
}
DI void phase4(const Params& P, unsigned char* lds_raw, int tid, int xmode = 0) {
    for (int b = blockIdx.x; b < 256; b += gridDim.x) {
        if (xmode == 2) break;
        attn_unit(P, lds_raw, b, tid, xmode != 0, xmode >= 10 ? xmode - 10 : 0);
        attn_unit(P, lds_raw, 504 - 8 * (b >> 3) + (b & 7), tid, xmode != 0, xmode >= 10 ? xmode - 10 : 0);
    }
    if (xmode != 1 && xmode < 10) for (int u = vbid(); u < 256; u += gridDim.x) s5_main_unit(P, lds_raw, u, tid);
    __syncthreads();
}

DI void phase5(const Params& P, unsigned char* lds_raw, int tid) {
    bf16_t* lds = (bf16_t*)lds_raw; float* Ct = (float*)lds_raw;
    unsigned char* ws = P.ws;
    const bf16_t* y1 = (const bf16_t*)(ws + OFF_Y1);
    for (int u = vbid(); u < 256; u += gridDim.x) {
        const int mt = u >> 2, nt = u & 3, m0 = mt * 256, n0 = nt * 128;
        f32x16 acc[2][2]; zero_acc(acc);
        const ASrc As = make_a(y1, 512, nullptr, T, m0, tid);
        const BSrcBf bs = make_bbf((const bf16_t*)(ws + OFF_WGLUT), 512, 512, n0, tid);
        __syncthreads();
        gemm_mainloop(acc, As, bs, 512, lds, tid);
        dump_acc(acc, Ct, tid);
        __syncthreads();
        const float* bglu = P.in[12];
        bf16_t* mix = (bf16_t*)(ws + OFF_XN);
        for (int it = tid; it < 256 * 32; it += NTHREADS) {
            const int row = it >> 5, c4 = it & 31, n = n0 + c4 * 4;
            const f32x4 v = *(const f32x4*)(Ct + row * CT_STRIDE + c4 * 4);
            const f32x4 bb = *(const f32x4*)(bglu + n);
            const u32x2 yy = *(const u32x2*)(y1 + (size_t)(m0 + row) * 512 + n);
            const float y0 = bf2f(yy.x & 0xffffu), y1v = bf2f(yy.x >> 16), y2 = bf2f(yy.y & 0xffffu), y3 = bf2f(yy.y >> 16);
            const float o0 = y0 * sigmoidf(v.x + bb.x), o1 = y1v * sigmoidf(v.y + bb.y), o2 = y2 * sigmoidf(v.z + bb.z), o3 = y3 * sigmoidf(v.w + bb.w);
            u32x2 o; o.x = pk2(o0, o1); o.y = pk2(o2, o3);
            *(u32x2*)(mix + (size_t)(m0 + row) * 1024 + n) = o;
            float sq = (o0 * o0 + o1 * o1) + (o2 * o2 + o3 * o3);
            sq += __shfl_xor(sq, 1); sq += __shfl_xor(sq, 2); sq += __shfl_xor(sq, 4); sq += __shfl_xor(sq, 8); sq += __shfl_xor(sq, 16);
            if ((tid & 31) == 0) __hip_atomic_fetch_add((float*)(ws + OFF_SSQ) + (size_t)(m0 + row) * 2, sq, __ATOMIC_RELAXED, __HIP_MEMORY_SCOPE_AGENT);
        }
    }
    __syncthreads();
}
DI void phase6(const Params& P, int tid, bool dry = false) {
    const int lane = tid & 63, wv = tid >> 6;
    bf16_t* mix = (bf16_t*)(P.ws + OFF_XN);
    for (int row = blockIdx.x * 8 + wv; row < T; row += gridDim.x * 8) {
#pragma unroll
        for (int seg = 0; seg < 2; ++seg) {
            bf16_t* p = mix + (size_t)row * 1024 + seg * 512 + lane * 8;
            const u32x4 v = *(const u32x4*)p;
            float f[8] = {bf2f(v.x & 0xffffu), bf2f(v.x >> 16), bf2f(v.y & 0xffffu), bf2f(v.y >> 16), bf2f(v.z & 0xffffu), bf2f(v.z >> 16), bf2f(v.w & 0xffffu), bf2f(v.w >> 16)};
            float s = 0.f;
#pragma unroll
            for (int i = 0; i < 8; ++i) s += f[i] * f[i];
            s = wave_sum(s);
            const float rs = rsqrtf(s * (1.f / 512.f) + EPS);
            const float* gw = P.in[seg ? 24 : 23] + lane * 8;
            const f32x4 g0 = *(const f32x4*)gw, g1 = *(const f32x4*)(gw + 4);
            u32x4 o; o.x = pk2(f[0] * rs * g0.x, f[1] * rs * g0.y); o.y = pk2(f[2] * rs * g0.z, f[3] * rs * g0.w);
            o.z = pk2(f[4] * rs * g1.x, f[5] * rs * g1.y); o.w = pk2(f[6] * rs * g1.z, f[7] * rs * g1.w);
            if (dry) o = v;
            *(u32x4*)p = o;
        }
    }
}
DI void phase7(const Params& P, unsigned char* lds_raw, int tid, int xmode = 0) {
    bf16_t* lds = (bf16_t*)lds_raw; float* Ct = (float*)lds_raw;
    const bf16_t* mix = (const bf16_t*)(P.ws + OFF_XN);
    const float* x = P.in[0];
    for (int u = vbid(); u < 256; u += gridDim.x) {
        const int mt = u >> 2, nt2 = u & 3, m0 = mt * 256;
        f32x16 acc[2][4]; zero_acc2(acc);
        const ASrc As = make_a(mix, 1024, nullptr, T, m0, tid);
        const BSrc2 bs = make_b2((const bf16_t*)(P.ws + OFF_WOUTT), 1024, 1024, nt2 * 256, tid);
        __syncthreads();
        float sc[8];
        {
            const float* ssq = (const float*)(P.ws + OFF_SSQ);
#pragma unroll
            for (int i = 0; i < 4; ++i) {
                const int row = m0 + (tid >> 3) + 64 * i;
                sc[i] = rsqrtf(ssq[(size_t)row * 2] * (1.f / 512.f) + EPS);
                sc[4 + i] = rsqrtf(ssq[(size_t)row * 2 + 1] * (1.f / 512.f) + EPS);
            }
        }
        if (xmode != 4) gemm_mainloop2s(acc, As, bs, 1024, lds, tid, sc);
        float* outp = xmode ? (float*)(P.ws + OFF_U) : P.out;
#pragma unroll 1
        for (int half = 0; half < 2; ++half) {
            const int n0 = nt2 * 256 + half * 128;
            if (xmode == 3) { if (tid == 0) outp[(size_t)m0 * 1024 + n0] = acc[0][0][0] + acc[1][3][5]; continue; }
            dump_acc2(acc, Ct, tid, half);
            __syncthreads();
            {
                const int c4 = tid & 31, r0 = tid >> 5;
#pragma unroll 1
                for (int jb = 0; jb < 16; jb += 4) {
                    f32x4 xv[4];
#pragma unroll
                    for (int j = 0; j < 4; ++j) xv[j] = *(const f32x4*)(x + (size_t)(m0 + r0 + 16 * (jb + j)) * 1024 + n0 + c4 * 4);
#pragma unroll
                    for (int j = 0; j < 4; ++j) {
                        const int row = r0 + 16 * (jb + j);
                        const f32x4 v = *(const f32x4*)(Ct + row * CT_STRIDE + c4 * 4);
                        *(f32x4*)(outp + (size_t)(m0 + row) * 1024 + n0 + c4 * 4) = xv[j] + v;
                    }
                }
            }
            __syncthreads();
        }
    }
    __syncthreads();
}
constexpr int RSTR = 264;
constexpr int R_AHI = 0, R_ALO = 64 * RSTR * 2, R_WHI = 2 * 64 * RSTR * 2, R_WLO = R_WHI + 40 * RSTR * 2, R_END = R_WLO + 40 * RSTR * 2;
struct RtRegs { f32x4 x[8]; u32x4 w[5]; };
DI void rt_load(RtRegs& R, const float* x1, const bf16_t* WrT, int m0, int c, int tid) {
    const int lane = tid & 63, w = tid >> 6;
#pragma unroll
    for (int i = 0; i < 8; ++i) R.x[i] = *(const f32x4*)(x1 + (size_t)(m0 + w * 8 + i) * 1024 + c * 256 + lane * 4);
#pragma unroll
    for (int i = 0; i < 5; ++i) { const int ch = tid + 512 * i, rw = ch >> 5, c16 = ch & 31;
        R.w[i] = *(const u32x4*)(WrT + (size_t)rw * 1024 + c * 256 + c16 * 8); }
}
DI void phase8(const Params& P, unsigned char* lds_raw, int tid, bool dry = false) {
    unsigned char* ws = P.ws;
    const float* x1 = P.out; const float* g2 = P.in[26];
    bf16_t* xg = (bf16_t*)(ws + (dry ? OFF_XN : OFF_H2HI));
    const bf16_t* WrT = (const bf16_t*)(ws + OFF_WRT);
    float* rs2 = (float*)(ws + OFF_RS2);
    unsigned* cnt = (unsigned*)(ws + OFF_CTL) + CW_CNT + (dry ? 64 * CNT_STRIDE : 0);
    int* list = (int*)(ws + (dry ? OFF_ACT : OFF_LIST)); float* listw = (float*)(ws + (dry ? OFF_ACT + (size_t)64 * T * 4 : OFF_LISTW));
    bf16_t* Ahi = (bf16_t*)(lds_raw + R_AHI); bf16_t* Alo = (bf16_t*)(lds_raw + R_ALO);
    bf16_t* Whi = (bf16_t*)(lds_raw + R_WHI);
    float* part = (float*)lds_raw;
    float* ssqp = (float*)(lds_raw + R_END);
    unsigned* hist = (unsigned*)(lds_raw + R_END + 256);
    unsigned* lbase = hist + 64;
    const int lane = tid & 63, w = tid >> 6, r = lane & 31, h = lane >> 5, mh = w & 1, ks = w >> 1;
    const int n0 = r, n1 = 32 + r < 40 ? 32 + r : 39;
    for (int u = blockIdx.x; u < 256; u += gridDim.x) {
        const int m0 = u * 64;
        f32x16 acc0, acc1;
#pragma unroll
        for (int i = 0; i < 16; ++i) { acc0[i] = 0.f; acc1[i] = 0.f; }
        float ssq[8];
#pragma unroll
        for (int i = 0; i < 8; ++i) ssq[i] = 0.f;
        RtRegs R;
        rt_load(R, x1, WrT, m0, 0, tid);
        __syncthreads();
#pragma unroll 1
        for (int c = 0; c < 4; ++c) {
            {
                const f32x4 g = *(const f32x4*)(g2 + c * 256 + lane * 4);
#pragma unroll
                for (int i = 0; i < 8; ++i) {
                    f32x4 v = R.x[i];
                    ssq[i] += (v.x * v.x + v.y * v.y) + (v.z * v.z + v.w * v.w);
                    v = v * g;
                    u32x2 hv; hv.x = pk2(v.x, v.y); hv.y = pk2(v.z, v.w);
                    u32x2 lv; lv.x = pk2(v.x - bf2f(hv.x & 0xffffu), v.y - bf2f(hv.x >> 16)); lv.y = pk2(v.z - bf2f(hv.y & 0xffffu), v.w - bf2f(hv.y >> 16));
                    const int row = w * 8 + i;
                    *(u32x2*)(Ahi + row * RSTR + lane * 4) = hv;
                    *(u32x2*)(Alo + row * RSTR + lane * 4) = lv;
                    *(u32x2*)(xg + (size_t)(m0 + row) * 1024 + c * 256 + lane * 4) = hv;
                }
#pragma unroll
                for (int i = 0; i < 5; ++i) { const int ch = tid + 512 * i, rw = ch >> 5, c16 = ch & 31; *(u32x4*)(Whi + rw * RSTR + c16 * 8) = R.w[i]; }
            }
            if (c < 3) rt_load(R, x1, WrT, m0, c + 1, tid);
            __syncthreads();
#pragma unroll 2
            for (int s4 = 0; s4 < 4; ++s4) {
                const int ko = (ks * 4 + s4) * 16 + 8 * h;
                const bf16x8 ah = *(const bf16x8*)(Ahi + (32 * mh + r) * RSTR + ko), al = *(const bf16x8*)(Alo + (32 * mh + r) * RSTR + ko);
                const bf16x8 wh0 = *(const bf16x8*)(Whi + n0 * RSTR + ko), wh1 = *(const bf16x8*)(Whi + n1 * RSTR + ko);
                const bf16x8 wl0 = *(const bf16x8*)(Whi + (40 + n0) * RSTR + ko), wl1 = *(const bf16x8*)(Whi + (40 + n1) * RSTR + ko);
                acc0 = MFMA32(ah, wh0, acc0); acc1 = MFMA32(ah, wh1, acc1);
                acc0 = MFMA32(ah, wl0, acc0); acc1 = MFMA32(ah, wl1, acc1);
                acc0 = MFMA32(al, wh0, acc0); acc1 = MFMA32(al, wh1, acc1);
            }
            __syncthreads();
        }
#pragma unroll
        for (int i = 0; i < 16; ++i) {
            float* d = part + ((ks * 64) + 32 * mh + crow(i, h)) * 64 + r;
            d[0] = acc0[i]; d[32] = acc1[i];
        }
#pragma unroll
        for (int i = 0; i < 8; ++i) { const float sv = wave_sum(ssq[i]); if (lane == 0) ssqp[w * 8 + i] = sv; }
        if (tid < 64) hist[tid] = 0u;
        __syncthreads();
        int vl0 = 0, vl1 = 0; unsigned lr0 = 0, lr1 = 0; float w0 = 0.f, w1 = 0.f;
        if (tid < 64) {
            const int t = tid, grow = m0 + t;
            const float rs = rsqrtf(ssqp[t] * (1.f / 1024.f) + EPS);
            const float* b_grp = P.in[28]; const float* b_exp = P.in[30];
            float gl[4]; int gsel = 0; float gmax = -3e38f;
#pragma unroll
            for (int j = 0; j < 4; ++j) {
                gl[j] = rs * ((part[t * 64 + j] + part[(64 + t) * 64 + j]) + (part[(128 + t) * 64 + j] + part[(192 + t) * 64 + j])) + b_grp[j];
                if (gl[j] > gmax) { gmax = gl[j]; gsel = j; }
            }
            float gsum = 0.f;
#pragma unroll
            for (int j = 0; j < 4; ++j) gsum += __expf(gl[j] - gmax);
            const float gprob = 1.f / gsum;
            float el[8]; float emax = -3e38f;
#pragma unroll
            for (int j = 0; j < 8; ++j) {
                const int cc = 4 + gsel * 8 + j;
                el[j] = rs * ((part[t * 64 + cc] + part[(64 + t) * 64 + cc]) + (part[(128 + t) * 64 + cc] + part[(192 + t) * 64 + cc])) + b_exp[gsel * 8 + j];
                emax = fmaxf(emax, el[j]);
            }
            int i0 = 0; float v0 = -3e38f;
#pragma unroll
            for (int j = 0; j < 8; ++j) if (el[j] > v0) { v0 = el[j]; i0 = j; }
            int i1 = 0; float v1 = -3e38f;
#pragma unroll
            for (int j = 0; j < 8; ++j) if (j != i0 && el[j] > v1) { v1 = el[j]; i1 = j; }
            const float p0 = __expf(v0 - emax), p1 = __expf(v1 - emax);
            w0 = p0 / (p0 + p1) * gprob; w1 = p1 / (p0 + p1) * gprob;
            vl0 = gsel * 8 + i0; vl1 = 32 + gsel * 8 + i1;
            if (!dry) rs2[grow] = rs;
            lr0 = atomicAdd(&hist[vl0], 1u);
            lr1 = atomicAdd(&hist[vl1], 1u);
        }
        __syncthreads();
        if (tid < 64) { const unsigned hc = hist[tid]; lbase[tid] = hc ? atomicAdd(&cnt[tid * CNT_STRIDE], hc) : 0u; }
        __syncthreads();
        if (tid < 64) {
            const int grow = m0 + tid;
            const unsigned q0 = lbase[vl0] + lr0, q1 = lbase[vl1] + lr1;
            list[(size_t)vl0 * T + q0] = grow; listw[(size_t)vl0 * T + q0] = w0;
            list[(size_t)vl1 * T + q1] = grow; listw[(size_t)vl1 * T + q1] = w1;
        }
    }
    __syncthreads();
}
DI bool moe_unit(const unsigned* cnt, int u, int ntn, int vlo, int vhi, int& v, int& mt, int& nt, int& base, int& M) {
    int acc = 0, b = 0;
    for (int vv = 0; vv < vhi; ++vv) {
        const int c = (int)cnt[vv * CNT_STRIDE];
        if (vv >= vlo) {
            const int nu = ((c + 255) >> 8) * ntn;
            if (u < acc + nu) { const int loc = u - acc; v = vv; mt = loc / ntn; nt = loc - mt * ntn; base = b; M = c; return true; }
            acc += nu;
        }
        b += c;
    }
    return false;
}
DI void phase9(const Params& P, unsigned char* lds_raw, int tid, float* outp, int mode = 0) {
    asm volatile("" : "+v"(tid));
    bf16_t* lds = (bf16_t*)lds_raw; float* Ct = (float*)lds_raw;
    unsigned char* ws = P.ws;
    unsigned* ctl = (unsigned*)(ws + OFF_CTL);
    const unsigned* cnt = ctl + CW_CNT;
    const bf16_t* hi = (const bf16_t*)(ws + OFF_H2HI);
    const int* list = (const int*)(ws + OFF_LIST); const float* listw = (const float*)(ws + OFF_LISTW);
    const float* rs2 = (const float*)(ws + OFF_RS2);
    bf16_t* act = (bf16_t*)(ws + OFF_ACT);
    float* rowf = (float*)(lds_raw + 147456);
    int* rowi = (int*)(lds_raw + 147456 + 1024);
    bf16_t* Y0 = (bf16_t*)(ws + OFF_XN);
    int* cntL = (int*)(lds_raw + 147456 + 2048); int* baseL = cntL + 64; int* mtp = baseL + 64;
    if (tid < 64) {
        const int c = (int)cnt[tid * CNT_STRIDE], m = (c + 255) >> 8;
        int ci = c, mi = m;
#pragma unroll
        for (int o = 1; o < 64; o <<= 1) { const int a = __shfl_up(ci, o), b = __shfl_up(mi, o); if (tid >= o) { ci += a; mi += b; } }
        cntL[tid] = c; baseL[tid] = ci - c; mtp[tid] = mi - m;
        if (tid == 63) mtp[64] = mi;
    }
    __syncthreads();
    const int lane_ = tid & 63;
    const int mlo = mtp[lane_], mhi = mtp[lane_ + 1];
    const int total1 = 2 * mtp[64], total2a = 4 * mtp[32], total = total1 + 4 * mtp[64];
    volatile unsigned* wq = (volatile unsigned*)(lds_raw + LDS_BYTES - 64) + 8;
    int u = vbid();
    while (u < total) {
        unsigned nxt = 0;
        if (tid == 0) nxt = gridDim.x + __hip_atomic_fetch_add(ctl + CW_WQ, 1u, __ATOMIC_RELAXED, __HIP_MEMORY_SCOPE_AGENT);
        int v, mt, nt, base, M;
        if ((mode == 2 && u >= total1) || (mode == 3 && u < total1)) {
        } else if (u < total1) {
            {
                const int q = u >> 1;
                v = __builtin_ctzll(__ballot(mlo <= q && q < mhi)); mt = q - mtp[v]; nt = u & 1; base = baseL[v]; M = cntL[v];
            }
            const int e = v & 31;
            const int m0 = mt * 256;
            const int* rows = list + (size_t)v * T;
            f32x16 acc[2][4]; zero_acc2(acc);
            const ASrc As = make_a(hi, 1024, rows, M, m0, tid);
            const BSrc2 bs = make_b2((const bf16_t*)(ws + OFF_WGUT) + (size_t)e * 512 * 1024, 1024, 512, nt * 256, tid);
            float rsr = 0.f;
            if (tid < 256 && m0 + tid < M) rsr = rs2[rows[m0 + tid]];
            __syncthreads();
            gemm_mainloop2(acc, As, bs, 1024, lds, tid);
            if (tid < 256) rowf[tid] = rsr;
#pragma unroll 1
            for (int half = 0; half < 2; ++half) {
                const int nq = nt * 2 + half;
                dump_acc2(acc, Ct, tid, half);
                __syncthreads();
                for (int it = tid; it < 256 * 16; it += NTHREADS) {
                    const int row = it >> 4, q = it & 15, wn_ = q >> 3, c = (q & 7) * 4;
                    if (m0 + row < M) {
                        const float rs = rowf[row];
                        const f32x4 gt = *(const f32x4*)(Ct + row * CT_STRIDE + wn_ * 64 + c) * rs;
                        const f32x4 up = *(const f32x4*)(Ct + row * CT_STRIDE + wn_ * 64 + 32 + c) * rs;
                        u32x2 o; o.x = pk2(gt.x * sigmoidf(gt.x) * up.x, gt.y * sigmoidf(gt.y) * up.y); o.y = pk2(gt.z * sigmoidf(gt.z) * up.z, gt.w * sigmoidf(gt.w) * up.w);
                        st_wt8(act + (size_t)(base + m0 + row) * 256 + nq * 64 + wn_ * 32 + c, o);
                    }
                }
                __syncthreads();
            }
            unit_signal(ctl + CW_DONE + v * 64 + mt, tid);
        } else {
            const bool slot1 = u >= total1 + total2a;
            {
                const int q = (u - total1) >> 2;
                v = __builtin_ctzll(__ballot(mlo <= q && q < mhi)); mt = q - mtp[v]; nt = (u - total1) & 3; base = baseL[v]; M = cntL[v];
            }
            const int e = v & 31;
            const int m0 = mt * 256;
            const bf16_t* A = act + (size_t)base * 256;
            f32x16 acc[2][4]; zero_acc2(acc);
            const ASrc As = make_a(A, 256, nullptr, M, m0, tid);
            const BSrc2 bs = make_b2((const bf16_t*)(ws + OFF_WDT) + (size_t)e * 1024 * 256, 256, 1024, nt * 256, tid);
            int tokr = 0; float wgtr = 0.f;
            if (tid < 256) { const int rr = m0 + tid < M ? m0 + tid : M - 1; tokr = list[(size_t)v * T + rr]; wgtr = listw[(size_t)v * T + rr]; }
            unit_wait2(ctl + CW_DONE + v * 64 + mt, 2u, slot1 ? ctl + CW_S0DONE : nullptr, (unsigned)total2a, tid);
            gemm_mainloop2(acc, As, bs, 256, lds, tid);
            if (tid < 256) { rowi[tid] = tokr; rowf[tid] = wgtr; }
#pragma unroll 1
            for (int half = 0; half < 2; ++half) {
                const int n0 = nt * 256 + half * 128;
                dump_acc2(acc, Ct, tid, half);
                __syncthreads();
                {
                    const int c4 = tid & 31, r0 = tid >> 5;
                    if (!slot1) {
#pragma unroll 4
                        for (int j = 0; j < 16; ++j) {
                            const int row = r0 + 16 * j;
                            if (m0 + row < M) {
                                const f32x4 cv = *(const f32x4*)(Ct + row * CT_STRIDE + c4 * 4) * rowf[row];
                                u32x2 o; o.x = pk2(cv.x, cv.y); o.y = pk2(cv.z, cv.w);
                                st_wt8(Y0 + (size_t)rowi[row] * 1024 + n0 + c4 * 4, o);
                            }
                        }
                    } else {
#pragma unroll 1
                        for (int jb = 0; jb < 16; jb += 8) {
                            f32x4 ov[8]; u32x2 yv[8];
#pragma unroll
                            for (int j = 0; j < 8; ++j) {
                                const size_t o = (size_t)rowi[r0 + 16 * (jb + j)] * 1024 + n0 + c4 * 4;
                                ov[j] = *(const f32x4*)(outp + o);
                                yv[j] = *(const u32x2*)(Y0 + o);
                            }
#pragma unroll
                            for (int j = 0; j < 8; ++j) {
                                const int row = r0 + 16 * (jb + j);
                                if (m0 + row < M) {
                                    const f32x4 cv = *(const f32x4*)(Ct + row * CT_STRIDE + c4 * 4) * rowf[row];
                                    f32x4 nv = ov[j] + cv;
                                    nv.x += bf2f(yv[j].x & 0xffffu); nv.y += bf2f(yv[j].x >> 16); nv.z += bf2f(yv[j].y & 0xffffu); nv.w += bf2f(yv[j].y >> 16);
                                    *(f32x4*)(outp + (size_t)rowi[row] * 1024 + n0 + c4 * 4) = nv;
                                }
                            }
                        }
                    }
                }
                __syncthreads();
            }
            if (!slot1) unit_signal(ctl + CW_S0DONE, tid);
        }
        if (tid == 0) wq[0] = nxt;
        __syncthreads();
        u = __builtin_amdgcn_readfirstlane((int)wq[0]);
    }
    __syncthreads();
}

constexpr int NPHASES = 10;
__global__ void __launch_bounds__(NTHREADS, 2) mk(Params P) {
    extern __shared__ __attribute__((aligned(16))) unsigned char lds_raw[];
    const int tid = threadIdx.x;
    volatile unsigned* misc = (volatile unsigned*)(lds_raw + LDS_BYTES - 64);
    if (tid < 2) misc[tid] = 0u;
    __syncthreads();
    XcdBarrier bar; bar.bar = nullptr; bar.x = 0; bar.st = nullptr;
    const bool multi = (P.ph_hi - P.ph_lo) > 1;
    if (multi) bar = xcd_barrier_post((unsigned*)(P.ws + OFF_CTL) + CW_BAR, misc);
    const int lo = P.ph_lo, hi = P.ph_hi;
#define IN(k) (lo <= (k) && (k) < hi)
#define SEAM(k) do { if (IN(k) && IN((k) + 1)) xcd_barrier(bar); } while (0)
#ifndef PROBE_PHASE
#define PROBE_PHASE -1
#endif
#ifndef PROBE_XMODE
#define PROBE_XMODE 0
#endif
#define RUN(k, call, calldry) do { if (IN(k)) { call; if (PROBE_PHASE == (k) || PROBE_PHASE == 100 + (k) / 4) { xcd_barrier(bar); calldry; } } } while (0)
    RUN(0, phase0(P, lds_raw, tid), phase0(P, lds_raw, tid, PROBE_XMODE));
    SEAM(0);
    RUN(1, phase1(P, lds_raw, tid), phase1(P, lds_raw, tid, PROBE_XMODE));
    SEAM(1);
    RUN(2, phase2(P, lds_raw, tid), phase2(P, lds_raw, tid));
    SEAM(2);
    RUN(4, phase4(P, lds_raw, tid), phase4(P, lds_raw, tid, PROBE_XMODE ? PROBE_XMODE : 3));
    SEAM(4);
    RUN(5, phase5(P, lds_raw, tid), phase5(P, lds_raw, tid));
    SEAM(5);
    RUN(7, phase7(P, lds_raw, tid), phase7(P, lds_raw, tid, PROBE_XMODE));
    SEAM(7);
    if (IN(8)) {
        if (PROBE_PHASE == 8) {
            phase8(P, lds_raw, tid); xcd_barrier(bar);
            if (blockIdx.x == 0 && tid < 64) ((unsigned*)(P.ws + OFF_CTL))[CW_CNT + tid * CNT_STRIDE] = 0u;
            xcd_barrier(bar);
        }
        phase8(P, lds_raw, tid);
    }
    SEAM(8);
    if (IN(9)) {
        if (PROBE_PHASE == 9) {
            unsigned* ctl = (unsigned*)(P.ws + OFF_CTL);
            phase9(P, lds_raw, tid, PROBE_XMODE == 0 ? (float*)(P.ws + OFF_KC) : P.out);
            xcd_barrier(bar);
            if (blockIdx.x == 0) {
                if (PROBE_XMODE == 0) { for (int i = tid; i < 4096; i += NTHREADS) ctl[CW_DONE + i] = 0u; if (tid == 0) ctl[CW_S0DONE] = 0u; }
                if (tid == 0) ctl[CW_WQ] = 0u;
            }
            xcd_barrier(bar);
            phase9(P, lds_raw, tid, PROBE_XMODE == 0 ? P.out : (float*)(P.ws + OFF_KC), PROBE_XMODE >= 2 ? PROBE_XMODE : 0);
        } else phase9(P, lds_raw, tid, P.out);
    }
#undef RUN
#undef IN
#undef SEAM
}

extern "C" void kernel_launch(void* const* d_in, const int* in_sizes, int n_in, void* d_out, int out_size, void* d_ws, size_t ws_size, hipStream_t stream) {
    static int grid = 0;
    if (grid == 0) {
        if (n_in != 34 || out_size != T * DM || ws_size < WS_END) {
            fprintf(stderr, "kernel_launch: unexpected shapes: n_in %d out %d ws %zu (need %zu)\n", n_in, out_size, ws_size, (size_t)WS_END);
            grid = -1; return;
        }
        int dev = 0, cus = 0;
        hipGetDevice(&dev);
        hipDeviceGetAttribute(&cus, hipDeviceAttributeMultiprocessorCount, dev);
        hipFuncSetAttribute((const void*)mk, hipFuncAttributeMaxDynamicSharedMemorySize, LDS_BYTES);
        int per_cu = 0;
        hipOccupancyMaxActiveBlocksPerMultiprocessor(&per_cu, (const void*)mk, NTHREADS, LDS_BYTES);
        (void)hipGetLastError();
        if (per_cu < 1) fprintf(stderr, "kernel_launch: occupancy query says %d blocks/CU\n", per_cu);
        grid = cus > 0 ? cus : 256;
    }
    if (grid < 0) return;
    hipMemsetAsync((char*)d_ws + OFF_CTL, 0, CTL_BYTES, stream);
    Params p{};
    for (int i = 0; i < 34; ++i) p.in[i] = (const float*)d_in[i];
    p.out = (float*)d_out; p.ws = (unsigned char*)d_ws;
#ifndef MK_ONE_LAUNCH
    for (int ph = 0; ph < NPHASES; ++ph) {
        p.ph_lo = ph; p.ph_hi = ph + 1;
        hipLaunchKernelGGL(mk, dim3(grid), dim3(NTHREADS), LDS_BYTES, stream, p);
    }
#else
    p.ph_lo = 0; p.ph_hi = NPHASES;
    hipLaunchKernelGGL(mk, dim3(grid), dim3(NTHREADS), LDS_BYTES, stream, p);
#endif
}
```

```cpp
#define MK_ONE_LAUNCH 1
#include <hip/hip_runtime.h>
#include <stdint.h>
#include <cstdio>

#define DI __device__ __forceinline__
typedef unsigned short bf16_t;
typedef short bf16x8 __attribute__((ext_vector_type(8)));
typedef short s16x4 __attribute__((ext_vector_type(4)));
typedef float f32x16 __attribute__((ext_vector_type(16)));
typedef float f32x4 __attribute__((ext_vector_type(4)));
typedef unsigned u32x4 __attribute__((ext_vector_type(4)));
typedef unsigned u32x2 __attribute__((ext_vector_type(2)));

constexpr int T = 16384, SEQ = 4096, NBATCH = 4, DM = 1024, DIN = 1816;
constexpr int NTHREADS = 512;
constexpr float EPS = 1e-6f;

constexpr size_t al256(size_t x) { return (x + 255) & ~(size_t)255; }
constexpr size_t OFF_CTL   = 0;
constexpr size_t CTL_BYTES = 65536;
constexpr size_t OFF_XN    = OFF_CTL + CTL_BYTES;
constexpr size_t OFF_U     = OFF_XN + (size_t)T * 1024 * 2;
constexpr size_t OFF_QN    = OFF_U + (size_t)T * 512 * 2;
constexpr size_t KV_BYTES  = (size_t)8 * 4096 * 64 * 2;
constexpr size_t OFF_KC    = OFF_QN + (size_t)T * 512 * 2;
constexpr size_t OFF_VC    = OFF_KC + KV_BYTES;
constexpr size_t OFF_KSN   = OFF_VC + KV_BYTES;
constexpr size_t OFF_KWN   = OFF_KSN + KV_BYTES;
constexpr size_t OFF_VST   = OFF_KWN + KV_BYTES;
constexpr size_t OFF_VWT   = OFF_VST + KV_BYTES;
constexpr size_t OFF_GATES = OFF_VWT + KV_BYTES;
constexpr size_t OFF_TGT   = OFF_GATES + (size_t)T * 24 * 4;
constexpr size_t OFF_EGT   = OFF_TGT + (size_t)32 * 512 * 512 * 2;
constexpr size_t OFF_FGT   = OFF_EGT + (size_t)32 * 128 * 512 * 2;
constexpr size_t OFF_LAM32 = OFF_FGT + (size_t)32 * 512 * 128 * 2;
constexpr size_t OFF_BIASP = OFF_LAM32 + 32 * 64 * 2 * 4;
constexpr size_t OFF_Z     = OFF_BIASP + 2 * 16 * 256 * 4;
constexpr size_t OFF_SIN   = OFF_Z + (size_t)32 * 512 * 128 * 4;
constexpr size_t OFF_P     = OFF_SIN + (size_t)32 * 512 * 128 * 2;
constexpr size_t OFF_KCMP  = OFF_P + (size_t)2 * 8 * 2 * 256 * 256 * 4;
constexpr size_t OFF_VCMPT = OFF_KCMP + 8 * 256 * 64 * 2;
constexpr size_t OFF_Y1    = OFF_VCMPT + 8 * 64 * 256 * 2;
constexpr size_t OFF_H2HI  = OFF_U;
constexpr size_t OFF_H2LO  = OFF_TGT;
constexpr size_t OFF_ACT   = OFF_Y1;
constexpr size_t OFF_LIST  = OFF_Y1 + (size_t)T * 512 * 2;
constexpr size_t OFF_LISTW = OFF_LIST + (size_t)64 * T * 4;
constexpr size_t OFF_RS2   = OFF_LISTW + (size_t)64 * T * 4;
constexpr size_t OFF_SSQ   = OFF_RS2 + (size_t)T * 4;
constexpr size_t OFF_WINT  = OFF_SSQ + (size_t)T * 2 * 4;
constexpr size_t OFF_WGLUT = OFF_WINT + (size_t)1816 * 1024 * 2;
constexpr size_t OFF_WC1T  = OFF_WGLUT + (size_t)512 * 512 * 2;
constexpr size_t OFF_WOUTT = OFF_WC1T + (size_t)4 * 256 * 1024 * 2;
constexpr size_t OFF_WRT   = OFF_WOUTT + (size_t)1024 * 1024 * 2;
constexpr size_t OFF_WGUT  = OFF_WRT + (size_t)2 * 40 * 1024 * 2;
constexpr size_t OFF_WDT   = OFF_WGUT + (size_t)32 * 512 * 1024 * 2;
constexpr size_t WS_END    = OFF_WDT + (size_t)32 * 1024 * 256 * 2;
static_assert(OFF_H2HI + (size_t)T * 1024 * 2 <= OFF_KC, "h2hi overlay");
static_assert(OFF_H2LO + (size_t)T * 1024 * 2 <= OFF_SIN, "h2lo overlay");
static_assert(WS_END <= (size_t)256 * 1024 * 1024, "workspace");

constexpr int CW_CNT = 8192;
constexpr int CNT_STRIDE = 32;
constexpr int CW_WQ = 4736;
constexpr int CW_S0DONE = 4608;
constexpr int CW_DONE = 12288;
constexpr int CW_PDONE = 4864;
constexpr int CW_BAR = 1024;

constexpr int LDS_BYTES = 151552;
constexpr int BM = 256, BN = 128, BK = 64;
constexpr int LSTR = 72;
constexpr int A_TILE = BM * LSTR;
constexpr int B_TILE = BN * LSTR;
constexpr int STAGE_ELEMS = A_TILE + B_TILE;
constexpr int CT_STRIDE = 132;
constexpr int STAGE2_ELEMS = (BM + 256) * LSTR;

struct Params {
    const float* in[34];
    float* out;
    unsigned char* ws;
    int ph_lo, ph_hi;
};

DI unsigned f2bf(float f) { unsigned u = __builtin_bit_cast(unsigned, f); return (u + 0x7fffu + ((u >> 16) & 1u)) >> 16; }
DI float bf2f(unsigned b) { return __builtin_bit_cast(float, b << 16); }
typedef float f32x2 __attribute__((ext_vector_type(2)));
typedef __bf16 bf16x2_t __attribute__((ext_vector_type(2)));
DI unsigned pk2(float lo, float hi) { f32x2 v = {lo, hi}; bf16x2_t b = __builtin_convertvector(v, bf16x2_t); return __builtin_bit_cast(unsigned, b); }
template <int CTRL> DI float dpp_add(float x) {
    const int xi = __builtin_bit_cast(int, x);
    const int y = __builtin_amdgcn_update_dpp(xi, xi, CTRL, 0xF, 0xF, false);
    return x + __builtin_bit_cast(float, y);
}
DI float wave_sum(float v) {
#pragma unroll
    for (int o = 1; o < 64; o <<= 1) v += __shfl_xor(v, o);
    return v;
}
DI float gelu_tanh(float x) {
    const float c0 = -2.f * 0.7978845608028654f * 1.4426950408889634f, c1 = c0 * 0.044715f;
    const float e = __builtin_amdgcn_exp2f(x * (c0 + c1 * x * x));
    return x * __builtin_amdgcn_rcpf(1.f + e);
}
DI float sigmoidf(float x) { return __builtin_amdgcn_rcpf(1.f + __expf(-x)); }
DI int vbid() { const int G = gridDim.x, b = blockIdx.x; return (G & 7) == 0 ? (b & 7) * (G >> 3) + (b >> 3) : b; }
DI int crow(int reg, int h) { return (reg & 3) + 8 * (reg >> 2) + 4 * h; }
#define MFMA32(a, b, c) __builtin_amdgcn_mfma_f32_32x32x16_bf16((a), (b), (c), 0, 0, 0)

#define XB_TMO      128
#define XB_XCNT(j)  (256  + 64 * (j))
#define XB_XSUB(j)  (1280 + 64 * (j))
#define XB_XGEN(j)  (2304 + 64 * (j))
#define XB_TOP      3328
#define XB_TOPGEN   3392
#define XCD_BAR_WORDS 3456
#define XB_SPIN_CAP (1u << 22)
DI unsigned xb_ld(unsigned* p)              { return __hip_atomic_load(p, __ATOMIC_RELAXED, __HIP_MEMORY_SCOPE_AGENT); }
DI unsigned xb_add(unsigned* p, unsigned v) { return __hip_atomic_fetch_add(p, v, __ATOMIC_RELAXED, __HIP_MEMORY_SCOPE_AGENT); }
DI unsigned xb_xcc_id() { return (unsigned)__builtin_amdgcn_s_getreg((3 << 11) | 20) & 0xFu; }
#define XB_SPIN(cond, bar) do { unsigned _sp = 0; while (cond) { __builtin_amdgcn_s_sleep(1); \
    if ((++_sp & 255u) == 0u) { if (xb_ld(&(bar)[XB_TMO])) break; if (_sp > XB_SPIN_CAP) { atomicAdd(&(bar)[XB_TMO], 1u); break; } } } } while (0)
struct XcdBarrier { unsigned* bar; unsigned x; volatile unsigned* st; };
DI XcdBarrier xcd_barrier_post(unsigned* bar, volatile unsigned* st) {
    XcdBarrier b; b.bar = bar; b.x = xb_xcc_id(); b.st = st;
    if (threadIdx.x == 0) (void)xb_add(&bar[XB_XCNT(b.x)], 1u);
    return b;
}
DI void xcd_barrier_complete(unsigned* bar, unsigned x, unsigned& nloc, unsigned& nx) {
    const unsigned G = gridDim.x;
    unsigned sum, cnt, mine, sp = 0u;
    for (;;) {
        sum = 0u; cnt = 0u; mine = 0u;
#pragma unroll
        for (unsigned j = 0; j < 16; ++j) { const unsigned c = xb_ld(&bar[XB_XCNT(j)]); sum += c; cnt += (c > 0u) ? 1u : 0u; mine = (j == x) ? c : mine; }
        if (sum == G) break;
        __builtin_amdgcn_s_sleep(1);
        if ((++sp & 255u) == 0u) { if (xb_ld(&bar[XB_TMO])) break; if (sp > XB_SPIN_CAP) { atomicAdd(&bar[XB_TMO], 1u); break; } }
    }
    nloc = mine > 0u ? mine : 1u; nx = cnt > 0u ? cnt : 1u;
}
DI void xcd_barrier(const XcdBarrier& b) {
    asm volatile("s_waitcnt vmcnt(0)" ::: "memory");
    __syncthreads();
    if (threadIdx.x == 0) {
        unsigned* bar = b.bar;
        __builtin_amdgcn_s_waitcnt(0);
        unsigned nloc = b.st[0], nx = b.st[1];
        if (nloc == 0u) { xcd_barrier_complete(bar, b.x, nloc, nx); b.st[0] = nloc; b.st[1] = nx; }
        const unsigned old = xb_add(&bar[XB_XSUB(b.x)], 1u);
        const unsigned gen = old / nloc;
        if (old + 1u == (gen + 1u) * nloc) {
            __builtin_amdgcn_fence(__ATOMIC_RELEASE, "agent");
            asm volatile("s_waitcnt vmcnt(0)" ::: "memory");
            const unsigned og = xb_add(&bar[XB_TOP], 1u);
            const unsigned tg = og / nx;
            if (og + 1u == (tg + 1u) * nx) xb_add(&bar[XB_TOPGEN], 1u);
            else XB_SPIN(xb_ld(&bar[XB_TOPGEN]) == tg, bar);
            xb_add(&bar[XB_XGEN(b.x)], 1u);
            __builtin_amdgcn_fence(__ATOMIC_ACQUIRE, "agent");
            asm volatile("s_waitcnt vmcnt(0)" ::: "memory");
        } else {
            XB_SPIN(xb_ld(&bar[XB_XGEN(b.x)]) == gen, bar);
            __builtin_amdgcn_fence(__ATOMIC_ACQUIRE, "agent");
            asm volatile("s_waitcnt vmcnt(0)" ::: "memory");
        }
    }
    __syncthreads();
}

struct BSrcBf { const bf16_t* p0; const bf16_t* p1; };
struct GRegs { u32x4 a0, a1, a2, a3, b0, b1; };
struct ASrc { const bf16_t* a0; const bf16_t* a1; const bf16_t* a2; const bf16_t* a3; };
DI void g_load(GRegs& r, const ASrc& A, const BSrcBf& B, int kb) {
    const int ko = kb * BK;
    r.a0 = *(const u32x4*)(A.a0 + ko); r.a1 = *(const u32x4*)(A.a1 + ko); r.a2 = *(const u32x4*)(A.a2 + ko); r.a3 = *(const u32x4*)(A.a3 + ko);
    r.b0 = *(const u32x4*)(B.p0 + ko); r.b1 = *(const u32x4*)(B.p1 + ko);
}
DI void g_store(const GRegs& r, bf16_t* st, int tid) {
    const int off = (tid >> 3) * LSTR + (tid & 7) * 8;
    *(u32x4*)(st + off) = r.a0; *(u32x4*)(st + off + 64 * LSTR) = r.a1; *(u32x4*)(st + off + 128 * LSTR) = r.a2; *(u32x4*)(st + off + 192 * LSTR) = r.a3;
    *(u32x4*)(st + A_TILE + off) = r.b0; *(u32x4*)(st + A_TILE + off + 64 * LSTR) = r.b1;
}
DI void g_compute(f32x16 (&acc)[2][2], const bf16_t* st, int wm, int wn, int r, int h) {
    const bf16_t* ab = st + (wm * 64 + r) * LSTR + h * 8;
    const bf16_t* bb = st + A_TILE + (wn * 64 + r) * LSTR + h * 8;
#pragma unroll
    for (int s = 0; s < 4; ++s) {
        const bf16x8 af0 = *(const bf16x8*)(ab + s * 16);
        const bf16x8 af1 = *(const bf16x8*)(ab + 32 * LSTR + s * 16);
        const bf16x8 bf0 = *(const bf16x8*)(bb + s * 16);
        const bf16x8 bf1 = *(const bf16x8*)(bb + 32 * LSTR + s * 16);
        acc[0][0] = MFMA32(af0, bf0, acc[0][0]);
        acc[0][1] = MFMA32(af0, bf1, acc[0][1]);
        acc[1][0] = MFMA32(af1, bf0, acc[1][0]);
        acc[1][1] = MFMA32(af1, bf1, acc[1][1]);
    }
}
DI void gemm_mainloop(f32x16 (&acc)[2][2], const ASrc& A, const BSrcBf& B, int K, bf16_t* lds, int tid, int xmode = 0) {
    const int lane = tid & 63, w = tid >> 6, r = lane & 31, h = lane >> 5;
    const int wm = w >> 1, wn = w & 1;
    const int nk = K / BK;
    GRegs RA, RB;
    g_load(RA, A, B, 0);
    g_store(RA, lds, tid);
    if (nk > 1) g_load(RA, A, B, 1);
    if (nk > 2) g_load(RB, A, B, 2);
    __syncthreads();
    for (int kb = 0; kb < nk; kb += 2) {
        if (xmode != 2) g_compute(acc, lds, wm, wn, r, h);
        if (kb + 1 < nk) g_store(RA, lds + STAGE_ELEMS, tid);
        if (kb + 3 < nk) g_load(RA, A, B, xmode == 1 ? 0 : kb + 3);
        __syncthreads();
        if (kb + 1 >= nk) break;
        if (xmode != 2) g_compute(acc, lds + STAGE_ELEMS, wm, wn, r, h);
        if (kb + 2 < nk) g_store(RB, lds, tid);
        if (kb + 4 < nk) g_load(RB, A, B, xmode == 1 ? 1 : kb + 4);
        __syncthreads();
    }
}

DI void zero_acc(f32x16 (&acc)[2][2]) {
#pragma unroll
    for (int a = 0; a < 2; ++a)
#pragma unroll
        for (int b = 0; b < 2; ++b)
#pragma unroll
            for (int i = 0; i < 16; ++i) acc[a][b][i] = 0.f;
}
DI void dump_acc(const f32x16 (&acc)[2][2], float* Ct, int tid) {
    const int lane = tid & 63, w = tid >> 6, r = lane & 31, h = lane >> 5;
    const int wm = w >> 1, wn = w & 1;
#pragma unroll
    for (int tm = 0; tm < 2; ++tm)
#pragma unroll
        for (int tn = 0; tn < 2; ++tn)
#pragma unroll
            for (int i = 0; i < 16; ++i)
                Ct[(wm * 64 + tm * 32 + crow(i, h)) * CT_STRIDE + wn * 64 + tn * 32 + r] = acc[tm][tn][i];
}
struct BSrc2 { const bf16_t* p0; const bf16_t* p1; const bf16_t* p2; const bf16_t* p3; };
struct GRegs2 { u32x4 a0, a1, a2, a3, b0, b1, b2, b3; };
DI void g2_load(GRegs2& r, const ASrc& A, const BSrc2& B, int kb) {
    const int ko = kb * BK;
    r.a0 = *(const u32x4*)(A.a0 + ko); r.a1 = *(const u32x4*)(A.a1 + ko); r.a2 = *(const u32x4*)(A.a2 + ko); r.a3 = *(const u32x4*)(A.a3 + ko);
    r.b0 = *(const u32x4*)(B.p0 + ko); r.b1 = *(const u32x4*)(B.p1 + ko); r.b2 = *(const u32x4*)(B.p2 + ko); r.b3 = *(const u32x4*)(B.p3 + ko);
}
DI void g2_store(const GRegs2& r, bf16_t* st, int tid) {
    const int off = (tid >> 3) * LSTR + (tid & 7) * 8;
    *(u32x4*)(st + off) = r.a0; *(u32x4*)(st + off + 64 * LSTR) = r.a1; *(u32x4*)(st + off + 128 * LSTR) = r.a2; *(u32x4*)(st + off + 192 * LSTR) = r.a3;
    bf16_t* sb = st + A_TILE;
    *(u32x4*)(sb + off) = r.b0; *(u32x4*)(sb + off + 64 * LSTR) = r.b1; *(u32x4*)(sb + off + 128 * LSTR) = r.b2; *(u32x4*)(sb + off + 192 * LSTR) = r.b3;
}
DI void g2_compute_b(f32x16 (&acc)[2][4], const bf16_t* st, int wm, int wn, int r, int h) {
    const bf16_t* ab = st + (wm * 64 + r) * LSTR + h * 8;
    const bf16_t* bb = st + A_TILE + (wn * 128 + r) * LSTR + h * 8;
#pragma unroll
    for (int s = 0; s < 4; ++s) {
        const bf16x8 af0 = *(const bf16x8*)(ab + s * 16);
        const bf16x8 af1 = *(const bf16x8*)(ab + 32 * LSTR + s * 16);
        bf16x8 bf[4];
#pragma unroll
        for (int tn = 0; tn < 4; ++tn) bf[tn] = *(const bf16x8*)(bb + tn * 32 * LSTR + s * 16);
        asm volatile("" ::: "memory");
#pragma unroll
        for (int tn = 0; tn < 4; ++tn) {
            acc[0][tn] = MFMA32(af0, bf[tn], acc[0][tn]);
            acc[1][tn] = MFMA32(af1, bf[tn], acc[1][tn]);
        }
    }
}
DI void g2_compute(f32x16 (&acc)[2][4], const bf16_t* st, int wm, int wn, int r, int h) {
    const bf16_t* ab = st + (wm * 64 + r) * LSTR + h * 8;
    const bf16_t* bb = st + A_TILE + (wn * 128 + r) * LSTR + h * 8;
#pragma unroll
    for (int s = 0; s < 4; ++s) {
        const bf16x8 af0 = *(const bf16x8*)(ab + s * 16);
        const bf16x8 af1 = *(const bf16x8*)(ab + 32 * LSTR + s * 16);
#pragma unroll
        for (int tn = 0; tn < 4; ++tn) {
            const bf16x8 bf = *(const bf16x8*)(bb + tn * 32 * LSTR + s * 16);
            acc[0][tn] = MFMA32(af0, bf, acc[0][tn]);
            acc[1][tn] = MFMA32(af1, bf, acc[1][tn]);
        }
    }
}
template <bool BATCH = false>
DI void gemm_mainloop2(f32x16 (&acc)[2][4], const ASrc& A, const BSrc2& B, int K, bf16_t* lds, int tid) {
    const int lane = tid & 63, w = tid >> 6, r = lane & 31, h = lane >> 5;
    const int wm = w >> 1, wn = w & 1;
    const int nk = K / BK;
    GRegs2 RA;
    g2_load(RA, A, B, 0);
    g2_store(RA, lds, tid);
    if (nk > 1) g2_load(RA, A, B, 1);
    __syncthreads();
    for (int kb = 0; kb < nk; ++kb) {
        if (BATCH) g2_compute_b(acc, lds + (kb & 1) * STAGE2_ELEMS, wm, wn, r, h); else g2_compute(acc, lds + (kb & 1) * STAGE2_ELEMS, wm, wn, r, h);
        if (kb + 1 < nk) g2_store(RA, lds + ((kb + 1) & 1) * STAGE2_ELEMS, tid);
        if (kb + 2 < nk) g2_load(RA, A, B, kb + 2);
        __syncthreads();
    }
}
DI u32x4 scale8(u32x4 v, float sc) {
    u32x4 o;
    o.x = pk2(__builtin_bit_cast(float, v.x << 16) * sc, __builtin_bit_cast(float, v.x & 0xffff0000u) * sc);
    o.y = pk2(__builtin_bit_cast(float, v.y << 16) * sc, __builtin_bit_cast(float, v.y & 0xffff0000u) * sc);
    o.z = pk2(__builtin_bit_cast(float, v.z << 16) * sc, __builtin_bit_cast(float, v.z & 0xffff0000u) * sc);
    o.w = pk2(__builtin_bit_cast(float, v.w << 16) * sc, __builtin_bit_cast(float, v.w & 0xffff0000u) * sc);
    return o;
}
DI void gemm_mainloop2s(f32x16 (&acc)[2][4], const ASrc& A, const BSrc2& B, int K, bf16_t* lds, int tid, const float (&sc)[8]) {
    const int lane = tid & 63, w = tid >> 6, r = lane & 31, h = lane >> 5;
    const int wm = w >> 1, wn = w & 1;
    const int nk = K / BK;
    GRegs2 RA;
    g2_load(RA, A, B, 0);
    { RA.a0 = scale8(RA.a0, sc[0]); RA.a1 = scale8(RA.a1, sc[1]); RA.a2 = scale8(RA.a2, sc[2]); RA.a3 = scale8(RA.a3, sc[3]); }
    g2_store(RA, lds, tid);
    if (nk > 1) g2_load(RA, A, B, 1);
    __syncthreads();
    for (int kb = 0; kb < nk; ++kb) {
        g2_compute(acc, lds + (kb & 1) * STAGE2_ELEMS, wm, wn, r, h);
        if (kb + 1 < nk) {
            const int o = ((kb + 1) * BK < 512) ? 0 : 4;
            RA.a0 = scale8(RA.a0, sc[o]); RA.a1 = scale8(RA.a1, sc[o + 1]); RA.a2 = scale8(RA.a2, sc[o + 2]); RA.a3 = scale8(RA.a3, sc[o + 3]);
            g2_store(RA, lds + ((kb + 1) & 1) * STAGE2_ELEMS, tid);
        }
        if (kb + 2 < nk) g2_load(RA, A, B, kb + 2);
        __syncthreads();
    }
}
DI void scale_rows(f32x16 (&acc)[2][4], const float* tab, int which, int wm, int h) {
#pragma unroll
    for (int tm = 0; tm < 2; ++tm)
#pragma unroll
        for (int i = 0; i < 16; ++i) {
            const float f = tab[(wm * 64 + tm * 32 + crow(i, h)) * 2 + which];
#pragma unroll
            for (int tn = 0; tn < 4; ++tn) acc[tm][tn][i] *= f;
        }
}
DI void gemm_mainloop2m(f32x16 (&acc)[2][4], const ASrc& A, const BSrc2& B, int K, bf16_t* lds, int tid, const float* tab) {
    const int lane = tid & 63, w = tid >> 6, r = lane & 31, h = lane >> 5;
    const int wm = w >> 1, wn = w & 1;
    const int nk = K / BK;
    GRegs2 RA;
    g2_load(RA, A, B, 0);
    g2_store(RA, lds, tid);
    if (nk > 1) g2_load(RA, A, B, 1);
    __syncthreads();
    for (int kb = 0; kb < nk; ++kb) {
        if (kb == (nk >> 1)) scale_rows(acc, tab, 0, wm, h);
        g2_compute_b(acc, lds + (kb & 1) * STAGE2_ELEMS, wm, wn, r, h);
        if (kb + 1 < nk) g2_store(RA, lds + ((kb + 1) & 1) * STAGE2_ELEMS, tid);
        if (kb + 2 < nk) g2_load(RA, A, B, kb + 2);
        __syncthreads();
    }
    scale_rows(acc, tab, 1, wm, h);
}
DI void zero_acc2(f32x16 (&acc)[2][4]) {
#pragma unroll
    for (int a = 0; a < 2; ++a)
#pragma unroll
        for (int b = 0; b < 4; ++b)
#pragma unroll
            for (int i = 0; i < 16; ++i) acc[a][b][i] = 0.f;
}
DI void dump_acc2(const f32x16 (&acc)[2][4], float* Ct, int tid, int half) {
    const int lane = tid & 63, w = tid >> 6, r = lane & 31, h = lane >> 5;
    const int wm = w >> 1, wn = w & 1;
    if (wn == half) {
#pragma unroll
        for (int tm = 0; tm < 2; ++tm)
#pragma unroll
            for (int tn = 0; tn < 4; ++tn)
#pragma unroll
                for (int i = 0; i < 16; ++i)
                    Ct[(wm * 64 + tm * 32 + crow(i, h)) * CT_STRIDE + tn * 32 + r] = acc[tm][tn][i];
    }
}
DI BSrc2 make_b2(const bf16_t* Bt, long ldb, int N, int n0, int tid) {
    BSrc2 s; const int c = (tid & 7) * 8;
    int n = n0 + (tid >> 3);
    int q0 = n < N ? n : N - 1, q1 = n + 64 < N ? n + 64 : N - 1, q2 = n + 128 < N ? n + 128 : N - 1, q3 = n + 192 < N ? n + 192 : N - 1;
    s.p0 = Bt + (long)q0 * ldb + c; s.p1 = Bt + (long)q1 * ldb + c; s.p2 = Bt + (long)q2 * ldb + c; s.p3 = Bt + (long)q3 * ldb + c; return s;
}
DI const bf16_t* a_ptr(const bf16_t* base, long lda, const int* rows, int M, int m0, int i, int tid) {
    int gm = m0 + (tid >> 3) + 64 * i;
    gm = gm < M ? gm : M - 1;
    const long src = rows ? (long)rows[gm] : (long)gm;
    return base + src * lda + (tid & 7) * 8;
}
DI ASrc make_a(const bf16_t* base, long lda, const int* rows, int M, int m0, int tid) {
    ASrc A; A.a0 = a_ptr(base, lda, rows, M, m0, 0, tid); A.a1 = a_ptr(base, lda, rows, M, m0, 1, tid);
    A.a2 = a_ptr(base, lda, rows, M, m0, 2, tid); A.a3 = a_ptr(base, lda, rows, M, m0, 3, tid); return A;
}
DI BSrcBf make_bbf(const bf16_t* Bt, long ldb, int N, int n0, int tid) {
    int n = n0 + (tid >> 3); int n1 = n + 64;
    n = n < N ? n : N - 1; n1 = n1 < N ? n1 : N - 1;
    BSrcBf s; s.p0 = Bt + (long)n * ldb + (tid & 7) * 8; s.p1 = Bt + (long)n1 * ldb + (tid & 7) * 8; return s;
}
template <class RM>
DI void tconv(const float* src, long sbatch, long sld, int K, int N, bf16_t* dst, long dbatch, long ldd, int nbatch, RM rm, int lo, long gtid, long gstride,
              const float* ks0 = nullptr, const float* ks1 = nullptr, int f0 = 0, int f1 = 16) {
    const long per = (long)N * (K >> 5), total = per * nbatch;
    const long iend = total * f1 / 16;
    for (long i = total * f0 / 16 + gtid; i < iend; i += gstride) {
        const int bi = (int)(i / per); const long rem = i - (long)bi * per;
        const int k32 = (int)(rem / N), n = (int)(rem - (long)k32 * N);
        const float* sp = src + bi * sbatch + (long)(k32 * 32) * sld + n;
        float f[32];
#pragma unroll
        for (int j = 0; j < 32; ++j) f[j] = sp[(long)j * sld];
        if (lo) {
#pragma unroll
            for (int j = 0; j < 32; ++j) f[j] = f[j] - bf2f(f2bf(f[j]));
        }
        if (ks0) {
            const float* kp = (k32 * 32 < 512) ? ks0 + k32 * 32 : ks1 + k32 * 32 - 512;
#pragma unroll
            for (int j = 0; j < 32; ++j) f[j] *= kp[j];
        }
        bf16_t* dp = dst + bi * dbatch + (long)rm(n) * ldd + k32 * 32;
#pragma unroll
        for (int q = 0; q < 4; ++q) {
            u32x4 o; o.x = pk2(f[8 * q], f[8 * q + 1]); o.y = pk2(f[8 * q + 2], f[8 * q + 3]); o.z = pk2(f[8 * q + 4], f[8 * q + 5]); o.w = pk2(f[8 * q + 6], f[8 * q + 7]);
            *(u32x4*)(dp + 8 * q) = o;
        }
    }
}
struct RowId { DI int operator()(int n) const { return n; } };
struct RowGU { int tn; DI int operator()(int n) const { return (n >> 6) * 128 + ((n >> 5) & 1) * 64 + tn * 32 + (n & 31); } };
struct RowOff { int off; DI int operator()(int n) const { return n + off; } };

DI void cpow(float lr, float li, float step, int tau, float& re, float& im) {
    const float mag = expf(lr * step * (float)tau);
    const double ang = (double)li * (double)step * (double)tau;
    const double k = rint(ang * 0.15915494309189535);
    const float red = (float)(ang - k * 6.283185307179586);
    float sn, cs; sn = sinf(red); cs = cosf(red);
    re = mag * cs; im = mag * sn;
}
DI void p0_xn(const Params& P, unsigned char* lds_raw, int tid, int xmode) {
    unsigned char* ws = P.ws;
    const int lane = tid & 63, wv = tid >> 6;
    const int G = gridDim.x, bid = blockIdx.x;
    (void)lane; (void)wv; (void)lds_raw; (void)ws;
    if (xmode == 0 || xmode == 1) {
        const float* x = P.in[0]; const float* g1 = P.in[1];
        bf16_t* xn = (bf16_t*)(ws + OFF_XN);
        for (int row0 = (bid * 8 + wv) * 2; row0 < T; row0 += G * 16) {
            f32x4 v[2][4]; float s0 = 0.f, s1 = 0.f;
#pragma unroll
            for (int q = 0; q < 2; ++q) {
                const f32x4* xr = (const f32x4*)(x + (size_t)(row0 + q) * 1024) + lane;
#pragma unroll
                for (int j = 0; j < 4; ++j) v[q][j] = xr[64 * j];
            }
#pragma unroll
            for (int j = 0; j < 4; ++j) {
                s0 += v[0][j].x * v[0][j].x + v[0][j].y * v[0][j].y + v[0][j].z * v[0][j].z + v[0][j].w * v[0][j].w;
                s1 += v[1][j].x * v[1][j].x + v[1][j].y * v[1][j].y + v[1][j].z * v[1][j].z + v[1][j].w * v[1][j].w;
            }
            s0 = wave_sum(s0); s1 = wave_sum(s1);
            const float rs0 = rsqrtf(s0 * (1.f / 1024.f) + EPS), rs1 = rsqrtf(s1 * (1.f / 1024.f) + EPS);
#pragma unroll
            for (int j = 0; j < 4; ++j) {
                const f32x4 g = ((const f32x4*)g1)[lane + 64 * j];
                u32x2 o; o.x = pk2(v[0][j].x * rs0 * g.x, v[0][j].y * rs0 * g.y); o.y = pk2(v[0][j].z * rs0 * g.z, v[0][j].w * rs0 * g.w);
                *(u32x2*)(xn + (size_t)row0 * 1024 + lane * 4 + 256 * j) = o;
                o.x = pk2(v[1][j].x * rs1 * g.x, v[1][j].y * rs1 * g.y); o.y = pk2(v[1][j].z * rs1 * g.z, v[1][j].w * rs1 * g.w);
                *(u32x2*)(xn + (size_t)(row0 + 1) * 1024 + lane * 4 + 256 * j) = o;
            }
        }
    }
}
DI void p0_s5(const Params& P, unsigned char* lds_raw, int tid, int xmode) {
    unsigned char* ws = P.ws;
    const int lane = tid & 63, wv = tid >> 6;
    const int G = gridDim.x, bid = blockIdx.x;
    (void)lane; (void)wv; (void)lds_raw; (void)ws;
    if (xmode == 0 || xmode == 2) {
        const float* lam_re = P.in[3]; const float* lam_im = P.in[4]; const float* log_step = P.in[5];
        const float* b_re = P.in[6]; const float* b_im = P.in[7]; const float* c_re = P.in[8]; const float* c_im = P.in[9];
        float* pw_re = (float*)lds_raw;
        float* pw_im = pw_re + 64 * 33;
        float* bb_re = pw_im + 64 * 33;
        float* bb_im = bb_re + 1024;
        float* cc_re = bb_im + 1024;
        float* cc_im = cc_re + 64;
        float* Km = cc_im + 64;
        bf16_t* TgT = (bf16_t*)(ws + OFF_TGT); bf16_t* EgT = (bf16_t*)(ws + OFF_EGT); bf16_t* FgT = (bf16_t*)(ws + OFF_FGT);
        float* lam32 = (float*)(ws + OFF_LAM32);
        for (int u = bid; u < 512; u += G) {
            const int g = u >> 4, h = u & 15;
            const float step = expf(log_step[g]);
            __syncthreads();
            if (tid < 64) {
                const int p = tid;
                float ar, ai; cpow(lam_re[g * 64 + p], lam_im[g * 64 + p], step, 1, ar, ai);
                float zr = 1.f, zi = 0.f;
                for (int tau = 0; tau <= 32; ++tau) {
                    pw_re[p * 33 + tau] = zr; pw_im[p * 33 + tau] = zi;
                    const float nr = zr * ar - zi * ai, ni = zr * ai + zi * ar; zr = nr; zi = ni;
                }
                cc_re[tid] = c_re[(g * 16 + h) * 64 + tid]; cc_im[tid] = c_im[(g * 16 + h) * 64 + tid];
            }
            __syncthreads();
            for (int idx = tid; idx < 1024; idx += NTHREADS) {
                const int p = idx >> 4, hp = idx & 15;
                const float lr = lam_re[g * 64 + p], li = lam_im[g * 64 + p];
                const float re = pw_re[p * 33 + 1], im = pw_im[p * 33 + 1];
                const float nr = re - 1.f, ni = im, den = lr * lr + li * li;
                const float qr = (nr * lr + ni * li) / den, qi = (ni * lr - nr * li) / den;
                const float br = b_re[(g * 64 + p) * 16 + hp], bi = b_im[(g * 64 + p) * 16 + hp];
                bb_re[idx] = qr * br - qi * bi; bb_im[idx] = qr * bi + qi * br;
            }
            __syncthreads();
            {
                const int tau = tid >> 4, hp = tid & 15;
                float s = 0.f;
                for (int p = 0; p < 64; ++p) {
                    const float zr = cc_re[p] * pw_re[p * 33 + tau] - cc_im[p] * pw_im[p * 33 + tau];
                    const float zi = cc_re[p] * pw_im[p * 33 + tau] + cc_im[p] * pw_re[p * 33 + tau];
                    s += zr * bb_re[p * 16 + hp] - zi * bb_im[p * 16 + hp];
                }
                Km[tid] = s;
            }
            __syncthreads();
            for (int it = tid; it < 2048; it += NTHREADS) {
                const int t = it >> 6, q = it & 63, k = q >> 1, hp0 = (q & 1) * 8;
                u32x4 o = {0u, 0u, 0u, 0u};
                if (t >= k) { const float* km = Km + (t - k) * 16 + hp0; o.x = pk2(km[0], km[1]); o.y = pk2(km[2], km[3]); o.z = pk2(km[4], km[5]); o.w = pk2(km[6], km[7]); }
                *(u32x4*)(TgT + ((size_t)g * 512 + t * 16 + h) * 512 + q * 8) = o;
            }
            {
                const int t = tid >> 4, c = tid & 15;
                float f[8];
#pragma unroll
                for (int j = 0; j < 4; ++j) {
                    const int p = 4 * c + j;
                    const float zr = cc_re[p] * pw_re[p * 33 + t + 1] - cc_im[p] * pw_im[p * 33 + t + 1];
                    const float zi = cc_re[p] * pw_im[p * 33 + t + 1] + cc_im[p] * pw_re[p * 33 + t + 1];
                    f[2 * j] = zr; f[2 * j + 1] = -zi;
                }
                u32x4 o; o.x = pk2(f[0], f[1]); o.y = pk2(f[2], f[3]); o.z = pk2(f[4], f[5]); o.w = pk2(f[6], f[7]);
                *(u32x4*)(FgT + ((size_t)g * 512 + t * 16 + h) * 128 + c * 8) = o;
            }
            {
                const int nl = tid >> 6, q = tid & 63, p = 4 * h + (nl >> 1), ri = nl & 1, k = q >> 1, hp0 = (q & 1) * 8;
                const float ar = pw_re[p * 33 + 31 - k], ai = pw_im[p * 33 + 31 - k];
                float f[8];
#pragma unroll
                for (int j = 0; j < 8; ++j) {
                    const float br = bb_re[p * 16 + hp0 + j], bi = bb_im[p * 16 + hp0 + j];
                    f[j] = ri ? (ar * bi + ai * br) : (ar * br - ai * bi);
                }
                u32x4 o; o.x = pk2(f[0], f[1]); o.y = pk2(f[2], f[3]); o.z = pk2(f[4], f[5]); o.w = pk2(f[6], f[7]);
                *(u32x4*)(EgT + ((size_t)g * 128 + 2 * p + ri) * 512 + q * 8) = o;
            }
            if (h == 0 && tid < 64) { lam32[(g * 64 + tid) * 2] = pw_re[tid * 33 + 32]; lam32[(g * 64 + tid) * 2 + 1] = pw_im[tid * 33 + 32]; }
        }
        __syncthreads();
    }
}
DI void p0_bias(const Params& P, unsigned char* lds_raw, int tid, int xmode) {
    unsigned char* ws = P.ws;
    const int lane = tid & 63, wv = tid >> 6;
    const int G = gridDim.x, bid = blockIdx.x;
    (void)lane; (void)wv; (void)lds_raw; (void)ws;
    if (xmode == 0 || xmode == 3) {
        float* red = (float*)lds_raw;
        float* biasp = (float*)(ws + OFF_BIASP);
        for (int u = bid; u < 32; u += G) {
            const int kv = u >> 4, part = u & 15;
            const float* pos = P.in[kv ? 18 : 17]; const float* w1 = P.in[kv ? 21 : 19];
            const int n = tid & 255, half = tid >> 8;
            float s = 0.f;
            const int k0 = part * 128 + half * 64;
            for (int kk = k0; kk < k0 + 64; ++kk) s += pos[kk] * w1[(size_t)kk * 256 + n];
            __syncthreads();
            red[tid] = s;
            __syncthreads();
            if (tid < 256) biasp[(kv * 16 + part) * 256 + tid] = red[tid] + red[tid + 256];
        }
        __syncthreads();
    }
}
DI void p0_wconv(const Params& P, unsigned char* lds_raw, int tid, int xmode) {
    unsigned char* ws = P.ws;
    const int lane = tid & 63, wv = tid >> 6;
    const int G = gridDim.x, bid = blockIdx.x;
    (void)lane; (void)wv; (void)lds_raw; (void)ws;
    if (xmode == 0 || xmode == 4) {
        const long gt = (long)bid * NTHREADS + tid, gs = (long)G * NTHREADS;
        tconv(P.in[2], 0, 1816, 1024, 1816, (bf16_t*)(ws + OFF_WINT), 0, 1024, 1, RowId(), 0, gt, gs);
        tconv(P.in[11], 0, 512, 512, 512, (bf16_t*)(ws + OFF_WGLUT), 0, 512, 1, RowId(), 0, gt, gs);
        tconv(P.in[19], (long)1024 * 256, 256, 1024, 256, (bf16_t*)(ws + OFF_WC1T), (long)256 * 1024, 1024, 2, RowId(), 0, gt, gs);
        tconv(P.in[21], (long)1024 * 256, 256, 1024, 256, (bf16_t*)(ws + OFF_WC1T) + (size_t)2 * 256 * 1024, (long)256 * 1024, 1024, 2, RowId(), 0, gt, gs);
        tconv(P.in[25], 0, 1024, 1024, 1024, (bf16_t*)(ws + OFF_WOUTT), 0, 1024, 1, RowId(), 0, gt, gs, P.in[23], P.in[24]);
        { float* ssq = (float*)(ws + OFF_SSQ); for (long i = gt; i < (long)T * 2; i += gs) ssq[i] = 0.f; }
        tconv(P.in[27], 0, 4, 1024, 4, (bf16_t*)(ws + OFF_WRT), 0, 1024, 1, RowId(), 0, gt, gs);
        tconv(P.in[29], 0, 32, 1024, 32, (bf16_t*)(ws + OFF_WRT), 0, 1024, 1, RowOff{4}, 0, gt, gs);
        tconv(P.in[27], 0, 4, 1024, 4, (bf16_t*)(ws + OFF_WRT) + 40 * 1024, 0, 1024, 1, RowId(), 1, gt, gs);
        tconv(P.in[29], 0, 32, 1024, 32, (bf16_t*)(ws + OFF_WRT) + 40 * 1024, 0, 1024, 1, RowOff{4}, 1, gt, gs);
    }
}
DI void phase0(const Params& P, unsigned char* lds_raw, int tid, int xmode = 0) {
    if ((blockIdx.x >> 3) & 1) {
        p0_s5(P, lds_raw, tid, xmode); p0_bias(P, lds_raw, tid, xmode); p0_xn(P, lds_raw, tid, xmode); p0_wconv(P, lds_raw, tid, xmode);
    } else {
        p0_xn(P, lds_raw, tid, xmode); p0_wconv(P, lds_raw, tid, xmode); p0_s5(P, lds_raw, tid, xmode); p0_bias(P, lds_raw, tid, xmode);
    }
}

constexpr int TC_P1 = 2, TC_SPLIT = 14;
DI int tc_p1_share(int G) { return (G > 128 && (G & 7) == 0) ? TC_P1 : 0; }
DI void epi_inproj(const Params& P, const float* Ct, int m0, int nt, int tid) {
    asm volatile("" : "+v"(tid));
    unsigned char* ws = P.ws;
    const int n0 = nt * 128;
    if (n0 < 512) {
        bf16_t* U = (bf16_t*)(ws + OFF_U);
        for (int it = tid; it < 2048; it += NTHREADS) {
            const int row = it >> 3, gi = it & 7;
            const float* s = Ct + row * CT_STRIDE + gi * 16;
            u32x4 o0, o1;
            o0.x = pk2(s[0], s[1]); o0.y = pk2(s[2], s[3]); o0.z = pk2(s[4], s[5]); o0.w = pk2(s[6], s[7]);
            o1.x = pk2(s[8], s[9]); o1.y = pk2(s[10], s[11]); o1.z = pk2(s[12], s[13]); o1.w = pk2(s[14], s[15]);
            bf16_t* d = U + ((size_t)((n0 >> 4) + gi) * T + m0 + row) * 16;
            *(u32x4*)d = o0; *(u32x4*)(d + 8) = o1;
        }
    } else if (n0 < 1792) {
        const int row = tid & 255, seg = tid >> 8;
        const int grow = m0 + row, b = grow >> 12, l = grow & 4095;
        const float* s = Ct + row * CT_STRIDE + seg * 64;
        const int kind = n0 < 1024 ? 0 : 1 + ((n0 - 1024) >> 7);
        if (kind == 4 || kind == 6) {
            bf16_t* dst = (bf16_t*)(ws + (kind == 4 ? OFF_VST : OFF_VWT));
            const int rl = tid & 63, cq = tid >> 6;
#pragma unroll 1
            for (int rr = 0; rr < 4; ++rr) {
                const int r2 = rl + 64 * rr, gr = m0 + r2, b2 = gr >> 12, l2 = gr & 4095;
#pragma unroll
                for (int cc = 0; cc < 16; ++cc) {
                    const int col = cq * 16 + cc, g = col >> 6, d = col & 63;
                    dst[((size_t)((b2 * 2 + g) * 64 + d)) * 4096 + l2] = (bf16_t)f2bf(Ct[r2 * CT_STRIDE + col]);
                }
            }
        } else {
            float scale = 1.f; const float* gw = nullptr;
            if (kind == 0) { gw = P.in[13]; scale = 0.125f * 1.4426950408889634f; }
            else if (kind == 3) gw = P.in[15]; else if (kind == 5) gw = P.in[16];
            const int c8 = tid & 7, sg = (tid >> 3) & 1;
            f32x4 g0 = {1.f, 1.f, 1.f, 1.f}, g1 = {1.f, 1.f, 1.f, 1.f};
            if (gw) { g0 = *(const f32x4*)(gw + c8 * 8); g1 = *(const f32x4*)(gw + c8 * 8 + 4); }
#pragma unroll 2
            for (int j = 0; j < 8; ++j) {
                const int rw = (tid >> 4) + 32 * j;
                const int gr = m0 + rw, bb = gr >> 12, ll = gr & 4095;
                const float* sp = Ct + rw * CT_STRIDE + sg * 64 + c8 * 8;
                f32x4 v0 = *(const f32x4*)sp, v1 = *(const f32x4*)(sp + 4);
                if (gw) {
                    float ss = (v0.x * v0.x + v0.y * v0.y) + (v0.z * v0.z + v0.w * v0.w) + (v1.x * v1.x + v1.y * v1.y) + (v1.z * v1.z + v1.w * v1.w);
                    ss = dpp_add<0xB1>(ss); ss = dpp_add<0x4E>(ss); ss = dpp_add<0x141>(ss);
                    const float rsv = rsqrtf(ss * (1.f / 64.f) + EPS) * scale;
                    v0 = v0 * g0 * rsv; v1 = v1 * g1 * rsv;
                }
                bf16_t* dp;
                if (kind == 0) dp = (bf16_t*)(ws + OFF_QN) + (size_t)gr * 512 + (n0 - 512) + sg * 64 + c8 * 8;
                else {
                    const size_t off = kind == 1 ? OFF_KC : kind == 2 ? OFF_VC : kind == 3 ? OFF_KSN : OFF_KWN;
                    dp = (bf16_t*)(ws + off) + ((size_t)((bb * 2 + sg) * 4096 + ll)) * 64 + c8 * 8;
                }
                u32x4 o; o.x = pk2(v0.x, v0.y); o.y = pk2(v0.z, v0.w); o.z = pk2(v1.x, v1.y); o.w = pk2(v1.z, v1.w);
                *(u32x4*)dp = o;
            }
        }
    } else {
        if (tid < 256) {
            float* gates = (float*)(ws + OFF_GATES) + (size_t)(m0 + tid) * 24;
            const float* s = Ct + tid * CT_STRIDE;
#pragma unroll
            for (int c = 0; c < 24; ++c) gates[c] = sigmoidf(s[c]);
        }
    }
}
DI void phase1(const Params& P, unsigned char* lds_raw, int tid, int xmode = 0) {
    bf16_t* lds = (bf16_t*)lds_raw; float* Ct = (float*)lds_raw;
    const bf16_t* xn = (const bf16_t*)(P.ws + OFF_XN);
    const bf16_t* WinT = (const bf16_t*)(P.ws + OFF_WINT);
    for (int u = vbid(); u < 64 * 8; u += gridDim.x) {
        const int mt = u >> 3, nt2 = u & 7, m0 = mt * 256;
        if (nt2 == 7) {
            f32x16 acc1[2][2]; zero_acc(acc1);
            const ASrc A1 = make_a(xn, 1024, nullptr, T, m0, tid);
            const BSrcBf b1 = make_bbf(WinT, 1024, DIN, 1792, tid);
            __syncthreads();
            gemm_mainloop(acc1, A1, b1, 1024, lds, tid);
            dump_acc(acc1, Ct, tid);
            __syncthreads();
            epi_inproj(P, Ct, m0, 14, tid);
            __syncthreads();
            continue;
        }
        f32x16 acc[2][4]; zero_acc2(acc);
        const ASrc A = make_a(xn, 1024, nullptr, T, m0, tid);
        const BSrc2 bs = make_b2(WinT, 1024, DIN, nt2 * 256, tid);
        __syncthreads();
        if (xmode != 4) gemm_mainloop2<true>(acc, A, bs, 1024, lds, tid);
#pragma unroll 1
        for (int half = 0; half < 2; ++half) {
            const int nt = nt2 * 2 + half;
            if (nt * 128 >= DIN) break;
            if (xmode == 5) { if (tid == 0 && acc[0][0][0] + acc[1][3][5] + acc[0][1][1] + acc[1][2][7] + acc[0][2][3] + acc[0][3][9] + acc[1][0][4] + acc[1][1][2] == 12345.f) ((float*)P.ws)[1] = 1.f; continue; }
            dump_acc2(acc, Ct, tid, half);
            __syncthreads();
            epi_inproj(P, Ct, m0, nt, tid);
            __syncthreads();
        }
    }
    {
        const int G = gridDim.x, sh = tc_p1_share(G);
        if (sh > 0 && (vbid() & 7) == 7) {
            unsigned char* ws = P.ws;
            const long gt = (long)(vbid() >> 3) * NTHREADS + tid, gs = (long)(G >> 3) * NTHREADS;
            tconv(P.in[31], (long)1024 * 256, 256, 1024, 256, (bf16_t*)(ws + OFF_WGUT), (long)512 * 1024, 1024, 32, RowGU{0}, 0, gt, gs, nullptr, nullptr, 0, sh);
            tconv(P.in[32], (long)1024 * 256, 256, 1024, 256, (bf16_t*)(ws + OFF_WGUT), (long)512 * 1024, 1024, 32, RowGU{1}, 0, gt, gs, nullptr, nullptr, 0, sh);
            tconv(P.in[33], (long)256 * 1024, 1024, 256, 1024, (bf16_t*)(ws + OFF_WDT), (long)1024 * 256, 256, 32, RowId(), 0, gt, gs, nullptr, nullptr, 0, sh);
        }
    }
    __syncthreads();
}

DI void st_wt8(void* p, u32x2 v) { asm volatile("global_store_dwordx2 %0, %1, off sc1\n\ts_nop 1" :: "v"(p), "v"(v) : "memory"); }
DI void st_wt16f(void* p, f32x4 v) { asm volatile("global_store_dwordx4 %0, %1, off sc1\n\ts_nop 1" :: "v"(p), "v"(v) : "memory"); }
DI void unit_signal(unsigned* ctr, int tid) {
    asm volatile("s_waitcnt vmcnt(0)" ::: "memory");
    __syncthreads();
    if (tid == 0) __hip_atomic_fetch_add(ctr, 1u, __ATOMIC_RELAXED, __HIP_MEMORY_SCOPE_AGENT);
}
DI void unit_wait2(unsigned* ctr, unsigned target, unsigned* ctr2, unsigned target2, int tid) {
    if (tid == 0) {
        unsigned sp = 0;
        while (__hip_atomic_load(ctr, __ATOMIC_RELAXED, __HIP_MEMORY_SCOPE_AGENT) < target) { __builtin_amdgcn_s_sleep(4); if (++sp > (1u << 22)) break; }
        if (ctr2) { sp = 0; while (__hip_atomic_load(ctr2, __ATOMIC_RELAXED, __HIP_MEMORY_SCOPE_AGENT) < target2) { __builtin_amdgcn_s_sleep(4); if (++sp > (1u << 22)) break; } }
        __builtin_amdgcn_fence(__ATOMIC_ACQUIRE, "agent");
        asm volatile("s_waitcnt vmcnt(0)" ::: "memory");
    }
    __syncthreads();
}
DI void unit_wait(unsigned* ctr, unsigned target, int tid) {
    if (tid == 0) {
        unsigned sp = 0;
        while (__hip_atomic_load(ctr, __ATOMIC_RELAXED, __HIP_MEMORY_SCOPE_AGENT) < target) { __builtin_amdgcn_s_sleep(4); if (++sp > (1u << 22)) break; }
        __builtin_amdgcn_fence(__ATOMIC_ACQUIRE, "agent");
        asm volatile("s_waitcnt vmcnt(0)" ::: "memory");
    }
    __syncthreads();
}
DI void mlp2_unit(const Params& P, unsigned char* lds_raw, int u, int tid) {
    unsigned char* ws = P.ws;
    {
            const int idx = u, rc = idx & 7, bg = (idx >> 3) & 7, kv = idx >> 6;
            const float* w2 = P.in[kv ? 22 : 20];
            f32x4 wq[8];
#pragma unroll
            for (int i = 0; i < 8; ++i) wq[i] = *(const f32x4*)(w2 + (size_t)(i * NTHREADS + tid) * 4);
        unit_wait((unsigned*)(ws + OFF_CTL) + CW_PDONE + (u >> 3), 4u, tid);
            float* Hs = (float*)lds_raw;
            float* W2s = (float*)(lds_raw + 32768);
#pragma unroll
            for (int i = 0; i < 8; ++i) *(f32x4*)(W2s + (size_t)(i * NTHREADS + tid) * 4) = wq[i];
            const float* Pt = (const float*)(ws + OFF_P) + ((size_t)((kv * 8 + bg) * 2 + 0) * 256) * 256;
            const float* Pb = (const float*)(ws + OFF_P) + ((size_t)((kv * 8 + bg) * 2 + 1) * 256) * 256;
            const float* biasp = (const float*)(ws + OFF_BIASP) + kv * 16 * 256;
            const int n = tid & 255;
            float bias = 0.f;
#pragma unroll
            for (int pp = 0; pp < 16; ++pp) bias += biasp[pp * 256 + n];
            for (int it = tid; it < 8192; it += NTHREADS) {
                const int rr = it >> 8, j = rc * 32 + rr;
                float hv = 0.f;
                if (j < 255) hv = gelu_tanh(Pt[j * 256 + n] + Pb[(j + 1) * 256 + n] + bias);
                Hs[rr * 256 + n] = hv;
            }
            __syncthreads();
            const int rr = tid >> 4, dq = tid & 15, j = rc * 32 + rr;
            f32x4 a = {0.f, 0.f, 0.f, 0.f};
#pragma unroll 8
            for (int k = 0; k < 256; ++k) {
                const float hv = Hs[rr * 256 + k];
                const f32x4 w = *(const f32x4*)(W2s + k * 64 + dq * 4);
                a = a + w * hv;
            }
            if (kv == 0) {
                float ss = a.x * a.x + a.y * a.y + a.z * a.z + a.w * a.w;
                ss += __shfl_xor(ss, 1); ss += __shfl_xor(ss, 2); ss += __shfl_xor(ss, 4); ss += __shfl_xor(ss, 8);
                const float rs = rsqrtf(ss * (1.f / 64.f) + EPS);
                const f32x4 g = *(const f32x4*)(P.in[14] + dq * 4);
                u32x2 o; o.x = pk2(a.x * rs * g.x, a.y * rs * g.y); o.y = pk2(a.z * rs * g.z, a.w * rs * g.w);
                if (j == 255) { o.x = 0u; o.y = 0u; }
                *(u32x2*)((bf16_t*)(ws + OFF_KCMP) + ((size_t)bg * 256 + j) * 64 + dq * 4) = o;
            } else {
                bf16_t* vt = (bf16_t*)(ws + OFF_VCMPT) + (size_t)bg * 64 * 256;
                if (j == 255) a = (f32x4){0.f, 0.f, 0.f, 0.f};
                vt[(dq * 4 + 0) * 256 + j] = (bf16_t)f2bf(a.x); vt[(dq * 4 + 1) * 256 + j] = (bf16_t)f2bf(a.y);
                vt[(dq * 4 + 2) * 256 + j] = (bf16_t)f2bf(a.z); vt[(dq * 4 + 3) * 256 + j] = (bf16_t)f2bf(a.w);
            }
    }
    __syncthreads();
}
DI int p2_id() {
    const int G = gridDim.x, b = blockIdx.x;
    if (G != 256) return vbid();
    const int x = b & 7, j = b >> 3;
    return j < 16 ? x * 16 + j : 128 + x * 16 + (j - 16);
}
DI void phase2(const Params& P, unsigned char* lds_raw, int tid) {
    bf16_t* lds = (bf16_t*)lds_raw; float* Ct = (float*)lds_raw;
    unsigned char* ws = P.ws;
    {
        const int G = gridDim.x, nh = G > 128 ? G - 128 : G, hid = G > 128 ? p2_id() - 128 : p2_id();
        if (hid >= 0) {
            const long gt = (long)hid * NTHREADS + tid, gs = (long)nh * NTHREADS;
            const int f0 = tc_p1_share(G), f1 = G > 128 ? TC_SPLIT : 16;
            tconv(P.in[31], (long)1024 * 256, 256, 1024, 256, (bf16_t*)(ws + OFF_WGUT), (long)512 * 1024, 1024, 32, RowGU{0}, 0, gt, gs, nullptr, nullptr, f0, f1);
            tconv(P.in[32], (long)1024 * 256, 256, 1024, 256, (bf16_t*)(ws + OFF_WGUT), (long)512 * 1024, 1024, 32, RowGU{1}, 0, gt, gs, nullptr, nullptr, f0, f1);
            tconv(P.in[33], (long)256 * 1024, 1024, 256, 1024, (bf16_t*)(ws + OFF_WDT), (long)1024 * 256, 256, 32, RowId(), 0, gt, gs, nullptr, nullptr, f0, f1);
        }
    }
    for (int u = p2_id(); u < 128; u += gridDim.x) {
        f32x16 acc[2][2]; zero_acc(acc);
        if (u < 64) {
            const int g = u >> 1, mt = u & 1, m0 = mt * 256;
            const bf16_t* A = (const bf16_t*)(ws + OFF_U) + (size_t)g * T * 16;
            const ASrc As = make_a(A, 512, nullptr, 512, m0, tid);
            const BSrcBf bs = make_bbf((const bf16_t*)(ws + OFF_EGT) + (size_t)g * 128 * 512, 512, 128, 0, tid);
            __syncthreads();
            gemm_mainloop(acc, As, bs, 512, lds, tid);
            dump_acc(acc, Ct, tid);
            __syncthreads();
            if (tid < 128) {
                const int bb = tid >> 6, p = tid & 63;
                const float* lam32 = (const float*)(ws + OFF_LAM32) + (g * 64 + p) * 2;
                const float ar = lam32[0], ai = lam32[1];
                float sr = 0.f, si = 0.f;
                float* zp = Ct + (bb * 128) * CT_STRIDE + 2 * p;
                for (int c = 0; c < 128; ++c) {
                    const float zr = zp[c * CT_STRIDE], zi = zp[c * CT_STRIDE + 1];
                    zp[c * CT_STRIDE] = sr; zp[c * CT_STRIDE + 1] = si;
                    const float nr = ar * sr - ai * si + zr, ni = ar * si + ai * sr + zi;
                    sr = nr; si = ni;
                }
            }
            __syncthreads();
            bf16_t* Sin = (bf16_t*)(ws + OFF_SIN) + ((size_t)g * 512 + m0) * 128;
            for (int it = tid; it < 256 * 16; it += NTHREADS) {
                const int row = it >> 4, c8 = it & 15;
                const float* sp = Ct + row * CT_STRIDE + c8 * 8;
                u32x4 o; o.x = pk2(sp[0], sp[1]); o.y = pk2(sp[2], sp[3]); o.z = pk2(sp[4], sp[5]); o.w = pk2(sp[6], sp[7]);
                *(u32x4*)(Sin + row * 128 + c8 * 8) = o;
            }
        } else {
            const int idx = u - 64, nt = idx & 1, part = (idx >> 1) & 1, bg = (idx >> 2) & 7, kv = idx >> 5;
            const bf16_t* A = (const bf16_t*)(ws + (kv ? OFF_VC : OFF_KC)) + (size_t)bg * 4096 * 64;
            const ASrc As = make_a(A, 1024, nullptr, 256, 0, tid);
            const BSrcBf bs = make_bbf((const bf16_t*)(ws + OFF_WC1T) + (size_t)(kv * 2 + part) * 256 * 1024, 1024, 256, nt * 128, tid);
            __syncthreads();
            gemm_mainloop(acc, As, bs, 1024, lds, tid);
            dump_acc(acc, Ct, tid);
            __syncthreads();
            float* Pp = (float*)(ws + OFF_P) + ((size_t)((kv * 8 + bg) * 2 + part) * 256) * 256 + nt * 128;
            for (int it = tid; it < 256 * 32; it += NTHREADS) {
                const int row = it >> 5, c4 = it & 31;
                st_wt16f(Pp + row * 256 + c4 * 4, *(const f32x4*)(Ct + row * CT_STRIDE + c4 * 4));
            }
            unit_signal((unsigned*)(ws + OFF_CTL) + CW_PDONE + kv * 8 + bg, tid);
        }
    }
    for (int u = p2_id(); u < 128; u += gridDim.x) mlp2_unit(P, lds_raw, u, tid);
    if (gridDim.x > 128 && p2_id() < 128) {
        const long gt = (long)p2_id() * NTHREADS + tid, gs = (long)128 * NTHREADS;
        tconv(P.in[31], (long)1024 * 256, 256, 1024, 256, (bf16_t*)(ws + OFF_WGUT), (long)512 * 1024, 1024, 32, RowGU{0}, 0, gt, gs, nullptr, nullptr, TC_SPLIT, 16);
        tconv(P.in[32], (long)1024 * 256, 256, 1024, 256, (bf16_t*)(ws + OFF_WGUT), (long)512 * 1024, 1024, 32, RowGU{1}, 0, gt, gs, nullptr, nullptr, TC_SPLIT, 16);
        tconv(P.in[33], (long)256 * 1024, 1024, 256, 1024, (bf16_t*)(ws + OFF_WDT), (long)1024 * 256, 256, 32, RowId(), 0, gt, gs, nullptr, nullptr, TC_SPLIT, 16);
    }
    __syncthreads();
}

DI void s5_main_unit(const Params& P, unsigned char* lds_raw, int u, int tid) {
    bf16_t* lds = (bf16_t*)lds_raw; float* Ct = (float*)lds_raw;
    unsigned char* ws = P.ws;
    const int nt = u & 3, mt = (u >> 2) & 1, g = u >> 3, m0 = mt * 256, n0 = nt * 128;
    f32x16 acc[2][2]; zero_acc(acc);
    const bf16_t* Ug = (const bf16_t*)(ws + OFF_U) + (size_t)g * T * 16;
    {
        const ASrc As = make_a(Ug, 512, nullptr, 512, m0, tid);
        const BSrcBf bs = make_bbf((const bf16_t*)(ws + OFF_TGT) + (size_t)g * 512 * 512, 512, 512, n0, tid);
        __syncthreads();
        gemm_mainloop(acc, As, bs, 128 * (nt + 1), lds, tid);
    }
    {
        const bf16_t* S = (const bf16_t*)(ws + OFF_SIN) + (size_t)g * 512 * 128;
        const ASrc As = make_a(S, 128, nullptr, 512, m0, tid);
        const BSrcBf bs = make_bbf((const bf16_t*)(ws + OFF_FGT) + (size_t)g * 512 * 128, 128, 512, n0, tid);
        gemm_mainloop(acc, As, bs, 128, lds, tid);
    }
    dump_acc(acc, Ct, tid);
    __syncthreads();
    const float* dsk = P.in[10] + g * 16;
    bf16_t* y1 = (bf16_t*)(ws + OFF_Y1);
    for (int it = tid; it < 2048; it += NTHREADS) {
        const int row = it >> 3, tt = it & 7;
        const int token = 32 * (m0 + row) + (n0 >> 4) + tt;
        const float* s = Ct + row * CT_STRIDE + tt * 16;
        const u32x4 u0 = *(const u32x4*)(Ug + (size_t)token * 16), u1 = *(const u32x4*)(Ug + (size_t)token * 16 + 8);
        const unsigned uw[8] = {u0.x, u0.y, u0.z, u0.w, u1.x, u1.y, u1.z, u1.w};
        unsigned ow[8];
#pragma unroll
        for (int q = 0; q < 8; ++q) {
            const float ua = bf2f(uw[q] & 0xffffu), ub = bf2f(uw[q] >> 16);
            const float ya = gelu_tanh(s[2 * q] + dsk[2 * q] * ua), yb = gelu_tanh(s[2 * q + 1] + dsk[2 * q + 1] * ub);
            ow[q] = pk2(ya, yb);
        }
        bf16_t* d = y1 + (size_t)token * 512 + g * 16;
        *(u32x4*)d = (u32x4){ow[0], ow[1], ow[2], ow[3]}; *(u32x4*)(d + 8) = (u32x4){ow[4], ow[5], ow[6], ow[7]};
    }
}

constexpr int KSTR = 72, VSTR = 68;
constexpr int KSLOT = 64 * KSTR, VSLOT = 64 * VSTR;
constexpr int AT_KBUF = 0;
constexpr int AT_VBUF = AT_KBUF + 3 * KSLOT * 2;
constexpr int VCSTR = 260;
constexpr int AT_CK   = 0;
constexpr int AT_CV   = AT_CK + 256 * KSTR * 2;
constexpr int AT_RING_END = AT_VBUF + 3 * VSLOT * 2;
constexpr int AT_CEND = AT_CV + 64 * VCSTR * 2;
constexpr int AT_IMP  = (AT_CEND > AT_RING_END ? AT_CEND : AT_RING_END);
constexpr int IMPS = 65;
constexpr int AT_MASK = AT_IMP + 4 * 64 * IMPS * 4;
constexpr int AT_INVL = AT_MASK + 64 * 8;
constexpr int AT_END  = AT_INVL + 256 * 4;

struct KVRegs { u32x4 k; u32x4 v; };
DI void kv_load(KVRegs& r, const bf16_t* Kt, const bf16_t* Vt, long ldv, int tid) {
    r.k = *(const u32x4*)(Kt + (tid >> 3) * 64 + (tid & 7) * 8);
    r.v = *(const u32x4*)(Vt + (long)(tid >> 3) * ldv + (tid & 7) * 8);
}
DI void kv_store(const KVRegs& r, bf16_t* Kb, bf16_t* Vb, int tid) {
    *(u32x4*)(Kb + (tid >> 3) * KSTR + (tid & 7) * 8) = r.k;
    u32x2 lo, hi; lo.x = r.v.x; lo.y = r.v.y; hi.x = r.v.z; hi.y = r.v.w;
    *(u32x2*)(Vb + (tid >> 3) * VSTR + (tid & 7) * 8) = lo;
    *(u32x2*)(Vb + (tid >> 3) * VSTR + (tid & 7) * 8 + 4) = hi;
}
DI bf16x8 pack8(const f32x16& x, int s) {
    u32x4 p;
    p.x = pk2(x[8 * s], x[8 * s + 1]); p.y = pk2(x[8 * s + 2], x[8 * s + 3]); p.z = pk2(x[8 * s + 4], x[8 * s + 5]); p.w = pk2(x[8 * s + 6], x[8 * s + 7]);
    return __builtin_bit_cast(bf16x8, p);
}
DI void qk_tile(f32x16 (&S)[2], const bf16_t* Kb, const bf16x8 (&qf)[4], int r, int h, bool edge, int d0, int dmax, int pm) {
    const int NEGB = __builtin_bit_cast(int, -1e30f);
    if (edge) {
#pragma unroll
        for (int kh = 0; kh < 2; ++kh)
#pragma unroll
            for (int i = 0; i < 16; ++i) {
                const int d = d0 - (32 * kh + (i & 3) + 8 * (i >> 2));
                const int m = (d >> 31) | ((dmax - d) >> 31) | pm;
                S[kh][i] = __builtin_bit_cast(float, m & NEGB);
            }
    } else {
        const float iv = __builtin_bit_cast(float, pm & NEGB);
#pragma unroll
        for (int kh = 0; kh < 2; ++kh)
#pragma unroll
            for (int i = 0; i < 16; ++i) S[kh][i] = iv;
    }
    bf16x8 kf[2][4];
#pragma unroll
    for (int kh = 0; kh < 2; ++kh)
#pragma unroll
        for (int s = 0; s < 4; ++s) kf[kh][s] = *(const bf16x8*)(Kb + (32 * kh + r) * KSTR + 16 * s + 8 * h);
    asm volatile("" ::: "memory");
#pragma unroll
    for (int s = 0; s < 4; ++s)
#pragma unroll
        for (int kh = 0; kh < 2; ++kh) S[kh] = MFMA32(kf[kh][s], qf[s], S[kh]);
}
DI void qk_tile_p(f32x16 (&S)[2], const bf16_t* Kb, const bf16x8 (&qf)[2], const bf16_t* qp, int r, int h, bool edge, int d0, int dmax, int pm) {
    const int NEGB = __builtin_bit_cast(int, -1e30f);
    bf16x8 kf[2][4];
#pragma unroll
    for (int kh = 0; kh < 2; ++kh)
#pragma unroll
        for (int s = 0; s < 4; ++s) kf[kh][s] = *(const bf16x8*)(Kb + (32 * kh + r) * KSTR + 16 * s + 8 * h);
    const bf16x8 q2 = *(const bf16x8*)qp, q3 = *(const bf16x8*)(qp + 4096);
    if (edge) {
#pragma unroll
        for (int kh = 0; kh < 2; ++kh)
#pragma unroll
            for (int i = 0; i < 16; ++i) {
                const int d = d0 - (32 * kh + (i & 3) + 8 * (i >> 2));
                const int m = (d >> 31) | ((dmax - d) >> 31) | pm;
                S[kh][i] = __builtin_bit_cast(float, m & NEGB);
            }
        asm volatile("" ::: "memory");
#pragma unroll
        for (int kh = 0; kh < 2; ++kh) S[kh] = MFMA32(kf[kh][0], qf[0], S[kh]);
    } else {
        const float iv = __builtin_bit_cast(float, pm & NEGB);
        f32x16 ci;
#pragma unroll
        for (int i = 0; i < 16; ++i) ci[i] = iv;
        asm volatile("" ::: "memory");
#pragma unroll
        for (int kh = 0; kh < 2; ++kh) S[kh] = MFMA32(kf[kh][0], qf[0], ci);
    }
#pragma unroll
    for (int kh = 0; kh < 2; ++kh) S[kh] = MFMA32(kf[kh][1], qf[1], S[kh]);
#pragma unroll
    for (int kh = 0; kh < 2; ++kh) S[kh] = MFMA32(kf[kh][2], q2, S[kh]);
#pragma unroll
    for (int kh = 0; kh < 2; ++kh) S[kh] = MFMA32(kf[kh][3], q3, S[kh]);
}
#ifndef AT_X
#define AT_X 0
#endif
DI void softmax_tile_p(f32x16 (&S)[2], float& lsum) {
    f32x2 a0 = {0.f, 0.f}, a1 = {0.f, 0.f};
#pragma unroll
    for (int kh = 0; kh < 2; ++kh)
#pragma unroll
        for (int i = 0; i < 16; i += 4) {
            const float p0 = __builtin_amdgcn_exp2f(S[kh][i]), p1 = __builtin_amdgcn_exp2f(S[kh][i + 1]);
            const float p2 = __builtin_amdgcn_exp2f(S[kh][i + 2]), p3 = __builtin_amdgcn_exp2f(S[kh][i + 3]);
            S[kh][i] = p0; S[kh][i + 1] = p1; S[kh][i + 2] = p2; S[kh][i + 3] = p3;
            a0 += (f32x2){p0, p1}; a1 += (f32x2){p2, p3};
        }
    a0 += a1;
    lsum += a0.x + a0.y;
}
DI void softmax_tile(f32x16 (&S)[2], float& lsum, int ax = 0) {
    float ls = 0.f;
#pragma unroll
    for (int kh = 0; kh < 2; ++kh)
#pragma unroll
        for (int i = 0; i < 16; ++i) { const float p = (ax == 1) ? S[kh][i] * 0.001f : __builtin_amdgcn_exp2f(S[kh][i]); S[kh][i] = p; ls += p; }
    lsum += ls;
}
DI void pv_tile(f32x16 (&O)[2], const f32x16 (&Pm)[2], const bf16_t* Vb, int r, int h) {
    bf16x8 vf[2][2][2];
#pragma unroll
    for (int kh = 0; kh < 2; ++kh)
#pragma unroll
        for (int sp = 0; sp < 2; ++sp)
#pragma unroll
            for (int dh = 0; dh < 2; ++dh) {
                const bf16_t* vp = Vb + (32 * dh + r) * VSTR + 32 * kh + 16 * sp + 4 * h;
                const s16x4 lo = *(const s16x4*)vp, hi = *(const s16x4*)(vp + 8);
                vf[kh][sp][dh] = __builtin_shufflevector(lo, hi, 0, 1, 2, 3, 4, 5, 6, 7);
            }
    asm volatile("" ::: "memory");
#pragma unroll
    for (int kh = 0; kh < 2; ++kh)
#pragma unroll
        for (int sp = 0; sp < 2; ++sp) {
            const bf16x8 pf = pack8(Pm[kh], sp);
#pragma unroll
            for (int dh = 0; dh < 2; ++dh) O[dh] = MFMA32(vf[kh][sp][dh], pf, O[dh]);
        }
}
DI void pv_tile_c(f32x16 (&O)[2], const f32x16 (&Pm)[2], const bf16_t* Vc, int kt, int r, int h) {
    bf16x8 vf[2][2][2];
#pragma unroll
    for (int kh = 0; kh < 2; ++kh)
#pragma unroll
        for (int sp = 0; sp < 2; ++sp)
#pragma unroll
            for (int dh = 0; dh < 2; ++dh) {
                const bf16_t* vp = Vc + (32 * dh + r) * VCSTR + 64 * kt + 32 * kh + 16 * sp + 4 * h;
                const s16x4 lo = *(const s16x4*)vp, hi = *(const s16x4*)(vp + 8);
                vf[kh][sp][dh] = __builtin_shufflevector(lo, hi, 0, 1, 2, 3, 4, 5, 6, 7);
            }
    asm volatile("" ::: "memory");
#pragma unroll
    for (int kh = 0; kh < 2; ++kh)
#pragma unroll
        for (int sp = 0; sp < 2; ++sp) {
            const bf16x8 pf = pack8(Pm[kh], sp);
#pragma unroll
            for (int dh = 0; dh < 2; ++dh) O[dh] = MFMA32(vf[kh][sp][dh], pf, O[dh]);
        }
}
struct SeqBits { unsigned long long rem; DI int pop() { if (rem == 0ull) return -1; const int k = __builtin_ctzll(rem); rem &= rem - 1; return k; } };
struct SeqDown { int cur, lo; DI int pop() { if (cur < lo) return -1; return cur--; } };
template <int BR, class Seq>
DI void attn_stream(f32x16 (&O)[2], float& lsum, Seq seq, const bf16_t* Kg, const bf16_t* Vg, bf16_t* Kbuf, bf16_t* Vbuf,
                    const bf16x8 (&qf)[2], const bf16_t* qp, int qt, int tq, unsigned long long mymask, int r, int h, int tid, int ax = 0) {
#define AT_QK(SREG, T, SLOT) do { const int _t = (T); const bool _edge = (_t == qt) || (BR == 2 && _t == qt - 8); \
        const int _pm = (BR == 1) ? ((int)((mymask >> _t) & 1ull) - 1) : 0; int _d0 = tq - 64 * _t - 4 * h; asm volatile("" : "+v"(_d0)); \
        qk_tile_p(SREG, Kbuf + (SLOT) * KSLOT, qf, qp, r, h, _edge, _d0, BR == 2 ? 511 : 0x3fffffff, _pm); } while (0)
    int t0 = seq.pop(), t1 = seq.pop(), t2 = seq.pop();
    KVRegs R0;
    {
        KVRegs R1;
        kv_load(R0, Kg + (size_t)t0 * 64 * 64, Vg + t0 * 64, 4096, tid);
        if (t1 >= 0) kv_load(R1, Kg + (size_t)t1 * 64 * 64, Vg + t1 * 64, 4096, tid);
        kv_store(R0, Kbuf, Vbuf, tid);
        if (t1 >= 0) kv_store(R1, Kbuf + KSLOT, Vbuf + VSLOT, tid);
    }
    __syncthreads();
    f32x16 Sc[2], Sn[2];
    AT_QK(Sc, t0, 0);
    int sl = 0;
#define AT_STEP(SC, SN) { \
        const int s1 = sl == 2 ? 0 : sl + 1, s2 = s1 == 2 ? 0 : s1 + 1; \
        if (t2 >= 0) kv_load(R0, Kg + (size_t)t2 * 64 * 64, Vg + t2 * 64, 4096, tid); \
        if (t1 >= 0) AT_QK(SN, t1, s1); \
        softmax_tile_p(SC, lsum); \
        pv_tile(O, SC, Vbuf + sl * VSLOT, r, h); \
        if (t2 >= 0) kv_store(R0, Kbuf + s2 * KSLOT, Vbuf + s2 * VSLOT, tid); \
        __syncthreads(); \
        if (t1 < 0) break; \
        t0 = t1; t1 = t2; t2 = seq.pop(); sl = s1; }
    while (true) {
        AT_STEP(Sc, Sn)
        AT_STEP(Sn, Sc)
    }
#undef AT_STEP
    (void)ax;
#undef AT_QK
}

DI void attn_unit(const Params& P, unsigned char* lds_raw, int a, int tid, bool dry = false, int ax = 0) {
    unsigned char* ws = P.ws;
    const int qt = 63 - (a >> 3), bg = a & 7, b = bg >> 1, g = bg & 1;
    const int lane = tid & 63, w = tid >> 6, r = lane & 31, h = lane >> 5;
    const int hh = w >> 1, th = w & 1;
    const int t0 = qt * 64;
    const int tql = 32 * th + r;
    const int tq = t0 + tql;
    const size_t tqg = (size_t)b * 4096 + tq;
    bf16_t* Kbuf = (bf16_t*)(lds_raw + AT_KBUF);
    bf16_t* Vbuf = (bf16_t*)(lds_raw + AT_VBUF);
    float* imp = (float*)(lds_raw + AT_IMP);
    unsigned long long* selm = (unsigned long long*)(lds_raw + AT_MASK);
    float* invl = (float*)(lds_raw + AT_INVL);

    bf16x8 qf[4];
    {
        const bf16_t* qp = (const bf16_t*)(ws + OFF_QN) + tqg * 512 + g * 256 + hh * 64 + 8 * h;
#pragma unroll
        for (int s = 0; s < 4; ++s) qf[s] = *(const bf16x8*)(qp + 16 * s);
    }
    const float* gp = (const float*)(ws + OFF_GATES) + tqg * 24 + g * 12 + hh * 3;
    const float gate_c = gp[0], gate_s = gp[1], gate_w = gp[2];

    const bf16_t* Kc = (const bf16_t*)(ws + OFF_KCMP) + (size_t)bg * 256 * 64;
    const bf16_t* Vc = (const bf16_t*)(ws + OFF_VCMPT) + (size_t)bg * 64 * 256;
    int ncmp = (4 * qt + 2) / 64 + 1; if (ncmp > 4) ncmp = 4;
    int lko = (tid >> 3) * 64 + (tid & 7) * 8, lvo = (tid >> 3) * 256 + (tid & 7) * 8;
    asm volatile("" : "+v"(lko), "+v"(lvo));
    u32x4 kq[4], vq[4];
#pragma unroll
    for (int i = 0; i < 4; ++i) if (i < ncmp) {
        kq[i] = *(const u32x4*)(Kc + 64 * 64 * i + lko);
        vq[i] = *(const u32x4*)(Vc + 64 * i + lvo);
    }
    __syncthreads();
    float* impw = imp + ((hh * 64 + 32 * th) * IMPS);
    for (int i = lane; i < 32 * IMPS; i += 64) impw[i] = 0.f;
    f32x16 O[2];
#pragma unroll
    for (int dh = 0; dh < 2; ++dh)
#pragma unroll
        for (int i = 0; i < 16; ++i) O[dh][i] = 0.f;
    float inv_c;
    {
        float lsum = 0.f;
        bf16_t* Kcl = (bf16_t*)(lds_raw + AT_CK); bf16_t* Vcl = (bf16_t*)(lds_raw + AT_CV);
        {
#pragma unroll
            for (int i = 0; i < 4; ++i) if (i < ncmp) {
                *(u32x4*)(Kcl + (64 * i + (tid >> 3)) * KSTR + (tid & 7) * 8) = kq[i];
                bf16_t* vd = Vcl + (tid >> 3) * VCSTR + 64 * i + (tid & 7) * 8;
                u32x2 t; t.x = vq[i].x; t.y = vq[i].y; *(u32x2*)vd = t; t.x = vq[i].z; t.y = vq[i].w; *(u32x2*)(vd + 4) = t;
            }
        }
        __syncthreads();
        int jmax = tq >= 31 ? ((tq - 31) >> 4) : -1; jmax = jmax < 254 ? jmax : 254;
        for (int kt = 0; kt < ncmp; ++kt) {
            f32x16 S[2];
            const int dc0 = jmax - 64 * kt - 4 * h;
            qk_tile(S, Kcl + kt * 64 * KSTR, qf, r, h, __ballot(dc0 < 59) != 0ull, dc0, 0x3fffffff, 0);
            softmax_tile_p(S, lsum);
            float* ir = impw + r * IMPS + 16 * kt + h;
#pragma unroll
            for (int kh = 0; kh < 2; ++kh)
#pragma unroll
                for (int gq = 0; gq < 4; ++gq)
                    ir[8 * kh + 2 * gq] += (S[kh][4 * gq] + S[kh][4 * gq + 1]) + (S[kh][4 * gq + 2] + S[kh][4 * gq + 3]);
            asm volatile("s_waitcnt lgkmcnt(0)" ::: "memory");
#pragma unroll
            for (int kh = 0; kh < 2; ++kh)
#pragma unroll
                for (int gq = 0; gq < 4; ++gq) {
                    const int sl = 8 * kh + 2 * gq + 1;
                    if (16 * kt + h + sl < 64) ir[sl] += S[kh][4 * gq + 3];
                }
            asm volatile("s_waitcnt lgkmcnt(0)" ::: "memory");
            pv_tile_c(O, S, Vcl, kt, r, h);
        }
        lsum += __shfl_xor(lsum, 32);
        inv_c = lsum > 0.f ? 1.f / lsum : 0.f;
        if (h == 0) invl[hh * 64 + tql] = inv_c;
    }
    __syncthreads();
    {
        const int cur = qt;
        const bool forced = (lane == 0) || (lane == cur) || (lane == cur - 1);
        const bool valid = lane <= cur;
        unsigned key[8]; unsigned thr[8];
#pragma unroll
        for (int i = 0; i < 8; ++i) {
            const int tl = w * 8 + i;
            const float v = (imp[(0 * 64 + tl) * IMPS + lane] * invl[tl] + imp[(1 * 64 + tl) * IMPS + lane] * invl[64 + tl]) + (imp[(2 * 64 + tl) * IMPS + lane] * invl[128 + tl] + imp[(3 * 64 + tl) * IMPS + lane] * invl[192 + tl]);
            key[i] = forced ? 0xFFFFFFFFu : (valid ? __builtin_bit_cast(unsigned, v) : 0u);
            thr[i] = 0u;
        }
#pragma unroll 1
        for (int bit = 30; bit >= 0; --bit) {
#pragma unroll
            for (int i = 0; i < 8; ++i) {
                const unsigned cand = thr[i] | (1u << bit);
                if (__popcll(__ballot(key[i] >= cand)) >= 16) thr[i] = cand;
            }
        }
#pragma unroll
        for (int i = 0; i < 8; ++i) {
            const int tl = w * 8 + i;
            const unsigned long long gtm = __ballot(key[i] > thr[i]), eqm = __ballot(key[i] == thr[i]);
            const int need = 16 - __popcll(gtm);
            const bool sel = (key[i] > thr[i]) || ((key[i] == thr[i]) && (__popcll(eqm & ((1ull << lane) - 1ull)) < need));
            const unsigned long long mask = __ballot(sel);
            if (lane == 0) selm[tl] = mask;
        }
    }
    __syncthreads();
    float* accw = imp + (w * 32) * 64 + lane;
    {
        const float g_cmp = gate_c * inv_c;
#pragma unroll
        for (int dh = 0; dh < 2; ++dh)
#pragma unroll
            for (int i = 0; i < 16; ++i) accw[(dh * 16 + i) * 64] = g_cmp * O[dh][i];
    }
    bf16_t* qpk = (bf16_t*)(lds_raw + AT_RING_END) + (size_t)tid * 8;
    *(bf16x8*)qpk = qf[2]; *(bf16x8*)(qpk + 4096) = qf[3];
    bf16x8 qh[2]; qh[0] = qf[0]; qh[1] = qf[1];
    const unsigned long long mymask = selm[tql];
    unsigned long long ormask = selm[lane];
#pragma unroll
    for (int o = 1; o < 64; o <<= 1) ormask |= __shfl_xor(ormask, o);
    ormask &= (qt >= 63) ? ~0ull : ((1ull << (qt + 1)) - 1ull);
    ormask |= 1ull;
    {
        const bf16_t* Ks = (const bf16_t*)(ws + OFF_KSN) + (size_t)bg * 4096 * 64;
        const bf16_t* Vs = (const bf16_t*)(ws + OFF_VST) + (size_t)bg * 64 * 4096;
#pragma unroll
        for (int dh = 0; dh < 2; ++dh)
#pragma unroll
            for (int i = 0; i < 16; ++i) O[dh][i] = 0.f;
        float l = 0.f;
        if (ax != 4) attn_stream<1>(O, l, SeqBits{ormask}, Ks, Vs, Kbuf, Vbuf, qh, qpk, qt, tq, mymask, r, h, tid, ax); else l = 1.f;
        l += __shfl_xor(l, 32);
        const float sc = gate_s / l;
#pragma unroll
        for (int dh = 0; dh < 2; ++dh)
#pragma unroll
            for (int i = 0; i < 16; ++i) accw[(dh * 16 + i) * 64] += sc * O[dh][i];
    }
    {
        const bf16_t* Kw = (const bf16_t*)(ws + OFF_KWN) + (size_t)bg * 4096 * 64;
        const bf16_t* Vw = (const bf16_t*)(ws + OFF_VWT) + (size_t)bg * 64 * 4096;
#pragma unroll
        for (int dh = 0; dh < 2; ++dh)
#pragma unroll
            for (int i = 0; i < 16; ++i) O[dh][i] = 0.f;
        float l = 0.f;
        if (ax != 4) attn_stream<2>(O, l, SeqDown{qt, qt >= 8 ? qt - 8 : 0}, Kw, Vw, Kbuf, Vbuf, qh, qpk, qt, tq, 0ull, r, h, tid, ax); else l = 1.f;
        l += __shfl_xor(l, 32);
        const float sc = gate_w / l;
        bf16_t* dst = (bf16_t*)(ws + OFF_XN) + tqg * 1024 + 512 + g * 256 + hh * 64;
        float sq = 0.f;
#pragma unroll
        for (int dh = 0; dh < 2; ++dh)
#pragma unroll
            for (int gq = 0; gq < 4; ++gq) {
                const float o0 = accw[(dh * 16 + 4 * gq + 0) * 64] + sc * O[dh][4 * gq + 0];
                const float o1 = accw[(dh * 16 + 4 * gq + 1) * 64] + sc * O[dh][4 * gq + 1];
                const float o2 = accw[(dh * 16 + 4 * gq + 2) * 64] + sc * O[dh][4 * gq + 2];
                const float o3 = accw[(dh * 16 + 4 * gq + 3) * 64] + sc * O[dh][4 * gq + 3];
                u32x2 o; o.x = pk2(o0, o1); o.y = pk2(o2, o3);
                if (ax == 0 || o.x == 0x12345678u) *(u32x2*)(dst + 32 * dh + 8 * gq + 4 * h) = o;
                sq += (o0 * o0 + o1 * o1) + (o2 * o2 + o3 * o3);
            }
        sq += __shfl_xor(sq, 32);
        if (h == 0 && !dry) __hip_atomic_fetch_add((float*)(ws + OFF_SSQ) + tqg * 2 + 1, sq, __ATOMIC_RELAXED, __HIP_MEMORY_SCOPE_AGENT);
    }
}
DI void phase4(const Params& P, unsigned char* lds_raw, int tid, int xmode = 0) {
    for (int b = blockIdx.x; b < 256; b += gridDim.x) {
        if (xmode == 2) break;
        attn_unit(P, lds_raw, b, tid, xmode != 0, xmode >= 10 ? xmode - 10 : 0);
        attn_unit(P, lds_raw, 504 - 8 * (b >> 3) + (b & 7), tid, xmode != 0, xmode >= 10 ? xmode - 10 : 0);
    }
    if (xmode != 1 && xmode < 10) {
        if (gridDim.x == 256) {
            const int x = blockIdx.x & 7, j = blockIdx.x >> 3;
            int u;
            if (j < 8) u = (4 * x + (j >> 1)) * 8 + (j & 1) * 4 + 3;
            else { const int i = j - 8, gq = i / 6, rem = i - gq * 6, mq = rem / 3; u = (4 * x + gq) * 8 + mq * 4 + (rem - mq * 3); }
            s5_main_unit(P, lds_raw, u, tid);
        } else for (int u = vbid(); u < 256; u += gridDim.x) s5_main_unit(P, lds_raw, u, tid);
    }
    __syncthreads();
}

DI void phase5(const Params& P, unsigned char* lds_raw, int tid) {
    bf16_t* lds = (bf16_t*)lds_raw; float* Ct = (float*)lds_raw;
    unsigned char* ws = P.ws;
    const bf16_t* y1 = (const bf16_t*)(ws + OFF_Y1);
    for (int u = vbid(); u < 256; u += gridDim.x) {
        const int mt = u >> 2, nt = u & 3, m0 = mt * 256, n0 = nt * 128;
        f32x16 acc[2][2]; zero_acc(acc);
        const ASrc As = make_a(y1, 512, nullptr, T, m0, tid);
        const BSrcBf bs = make_bbf((const bf16_t*)(ws + OFF_WGLUT), 512, 512, n0, tid);
        __syncthreads();
        gemm_mainloop(acc, As, bs, 512, lds, tid);
        dump_acc(acc, Ct, tid);
        __syncthreads();
        const float* bglu = P.in[12];
        bf16_t* mix = (bf16_t*)(ws + OFF_XN);
        const int c4 = tid & 31, n = n0 + c4 * 4;
        const f32x4 bb = *(const f32x4*)(bglu + n);
        u32x2 yq[16];
#pragma unroll
        for (int j = 0; j < 16; ++j) yq[j] = *(const u32x2*)(y1 + (size_t)(m0 + (tid >> 5) + 16 * j) * 512 + n);
#pragma unroll
        for (int j = 0; j < 16; ++j) {
            const int row = (tid >> 5) + 16 * j;
            const f32x4 v = *(const f32x4*)(Ct + row * CT_STRIDE + c4 * 4);
            const u32x2 yy = yq[j];
            const float y0 = bf2f(yy.x & 0xffffu), y1v = bf2f(yy.x >> 16), y2 = bf2f(yy.y & 0xffffu), y3 = bf2f(yy.y >> 16);
            const float o0 = y0 * sigmoidf(v.x + bb.x), o1 = y1v * sigmoidf(v.y + bb.y), o2 = y2 * sigmoidf(v.z + bb.z), o3 = y3 * sigmoidf(v.w + bb.w);
            u32x2 o; o.x = pk2(o0, o1); o.y = pk2(o2, o3);
            *(u32x2*)(mix + (size_t)(m0 + row) * 1024 + n) = o;
            float sq = (o0 * o0 + o1 * o1) + (o2 * o2 + o3 * o3);
            sq += __shfl_xor(sq, 1); sq += __shfl_xor(sq, 2); sq += __shfl_xor(sq, 4); sq += __shfl_xor(sq, 8); sq += __shfl_xor(sq, 16);
            if ((tid & 31) == 0) __hip_atomic_fetch_add((float*)(ws + OFF_SSQ) + (size_t)(m0 + row) * 2, sq, __ATOMIC_RELAXED, __HIP_MEMORY_SCOPE_AGENT);
        }
    }
    __syncthreads();
}
DI void phase6(const Params& P, int tid, bool dry = false) {
    const int lane = tid & 63, wv = tid >> 6;
    bf16_t* mix = (bf16_t*)(P.ws + OFF_XN);
    for (int row = blockIdx.x * 8 + wv; row < T; row += gridDim.x * 8) {
#pragma unroll
        for (int seg = 0; seg < 2; ++seg) {
            bf16_t* p = mix + (size_t)row * 1024 + seg * 512 + lane * 8;
            const u32x4 v = *(const u32x4*)p;
            float f[8] = {bf2f(v.x & 0xffffu), bf2f(v.x >> 16), bf2f(v.y & 0xffffu), bf2f(v.y >> 16), bf2f(v.z & 0xffffu), bf2f(v.z >> 16), bf2f(v.w & 0xffffu), bf2f(v.w >> 16)};
            float s = 0.f;
#pragma unroll
            for (int i = 0; i < 8; ++i) s += f[i] * f[i];
            s = wave_sum(s);
            const float rs = rsqrtf(s * (1.f / 512.f) + EPS);
            const float* gw = P.in[seg ? 24 : 23] + lane * 8;
            const f32x4 g0 = *(const f32x4*)gw, g1 = *(const f32x4*)(gw + 4);
            u32x4 o; o.x = pk2(f[0] * rs * g0.x, f[1] * rs * g0.y); o.y = pk2(f[2] * rs * g0.z, f[3] * rs * g0.w);
            o.z = pk2(f[4] * rs * g1.x, f[5] * rs * g1.y); o.w = pk2(f[6] * rs * g1.z, f[7] * rs * g1.w);
            if (dry) o = v;
            *(u32x4*)p = o;
        }
    }
}
DI void phase7(const Params& P, unsigned char* lds_raw, int tid, int xmode = 0) {
    bf16_t* lds = (bf16_t*)lds_raw; float* Ct = (float*)lds_raw;
    const bf16_t* mix = (const bf16_t*)(P.ws + OFF_XN);
    const float* x = P.in[0];
    for (int u = vbid(); u < 256; u += gridDim.x) {
        const int mt = u >> 2, nt2 = u & 3, m0 = mt * 256;
        f32x16 acc[2][4]; zero_acc2(acc);
        const ASrc As = make_a(mix, 1024, nullptr, T, m0, tid);
        const BSrc2 bs = make_b2((const bf16_t*)(P.ws + OFF_WOUTT), 1024, 1024, nt2 * 256, tid);
        __syncthreads();
        float* tab = (float*)(lds_raw + 147456);
        if (tid < 256) {
            const float* ssq = (const float*)(P.ws + OFF_SSQ) + (size_t)(m0 + tid) * 2;
            const float q1 = ssq[0] * (1.f / 512.f) + EPS, q2 = ssq[1] * (1.f / 512.f) + EPS;
            tab[tid * 2] = __builtin_sqrtf(q2 * __builtin_amdgcn_rcpf(q1)); tab[tid * 2 + 1] = rsqrtf(q2);
        }
        __syncthreads();
        if (xmode != 4) gemm_mainloop2m(acc, As, bs, 1024, lds, tid, tab);
        int tid_e = tid; asm volatile("" : "+v"(tid_e));
        float* outp = xmode ? (float*)(P.ws + OFF_U) : P.out;
#pragma unroll 1
        for (int half = 0; half < 2; ++half) {
            const int n0 = nt2 * 256 + half * 128;
            if (xmode == 3) { if (tid == 0) outp[(size_t)m0 * 1024 + n0] = acc[0][0][0] + acc[1][3][5]; continue; }
            dump_acc2(acc, Ct, tid_e, half);
            __syncthreads();
            {
                const int c4 = tid_e & 31, r0 = tid_e >> 5;
#pragma unroll 1
                for (int jb = 0; jb < 16; jb += 4) {
                    f32x4 xv[4];
#pragma unroll
                    for (int j = 0; j < 4; ++j) xv[j] = *(const f32x4*)(x + (size_t)(m0 + r0 + 16 * (jb + j)) * 1024 + n0 + c4 * 4);
#pragma unroll
                    for (int j = 0; j < 4; ++j) {
                        const int row = r0 + 16 * (jb + j);
                        const f32x4 v = *(const f32x4*)(Ct + row * CT_STRIDE + c4 * 4);
                        *(f32x4*)(outp + (size_t)(m0 + row) * 1024 + n0 + c4 * 4) = xv[j] + v;
                    }
                }
            }
            __syncthreads();
        }
    }
    __syncthreads();
}
constexpr int RSTR = 264;
constexpr int R_AHI = 0, R_ALO = 64 * RSTR * 2, R_WHI = 2 * 64 * RSTR * 2, R_WLO = R_WHI + 40 * RSTR * 2, R_END = R_WLO + 40 * RSTR * 2;
struct RtRegs { f32x4 x[8]; u32x4 w[5]; };
DI void rt_load(RtRegs& R, const float* x1, const bf16_t* WrT, int m0, int c, int tid) {
    const int lane = tid & 63, w = tid >> 6;
#pragma unroll
    for (int i = 0; i < 8; ++i) R.x[i] = *(const f32x4*)(x1 + (size_t)(m0 + w * 8 + i) * 1024 + c * 256 + lane * 4);
#pragma unroll
    for (int i = 0; i < 5; ++i) { const int ch = tid + 512 * i, rw = ch >> 5, c16 = ch & 31;
        R.w[i] = *(const u32x4*)(WrT + (size_t)rw * 1024 + c * 256 + c16 * 8); }
}
DI void phase8(const Params& P, unsigned char* lds_raw, int tid, bool dry = false) {
    unsigned char* ws = P.ws;
    const float* x1 = P.out; const float* g2 = P.in[26];
    bf16_t* xg = (bf16_t*)(ws + (dry ? OFF_XN : OFF_H2HI));
    const bf16_t* WrT = (const bf16_t*)(ws + OFF_WRT);
    float* rs2 = (float*)(ws + OFF_RS2);
    unsigned* cnt = (unsigned*)(ws + OFF_CTL) + CW_CNT + (dry ? 64 * CNT_STRIDE : 0);
    int* list = (int*)(ws + (dry ? OFF_ACT : OFF_LIST)); float* listw = (float*)(ws + (dry ? OFF_ACT + (size_t)64 * T * 4 : OFF_LISTW));
    bf16_t* Ahi = (bf16_t*)(lds_raw + R_AHI); bf16_t* Alo = (bf16_t*)(lds_raw + R_ALO);
    bf16_t* Whi = (bf16_t*)(lds_raw + R_WHI);
    float* part = (float*)lds_raw;
    float* ssqp = (float*)(lds_raw + R_END);
    unsigned* hist = (unsigned*)(lds_raw + R_END + 256);
    unsigned* lbase = hist + 64;
    const int lane = tid & 63, w = tid >> 6, r = lane & 31, h = lane >> 5, mh = w & 1, ks = w >> 1;
    const int n0 = r, n1 = 32 + r < 40 ? 32 + r : 39;
    for (int u = blockIdx.x; u < 256; u += gridDim.x) {
        const int m0 = u * 64;
        f32x16 acc0, acc1;
#pragma unroll
        for (int i = 0; i < 16; ++i) { acc0[i] = 0.f; acc1[i] = 0.f; }
        float ssq[8];
#pragma unroll
        for (int i = 0; i < 8; ++i) ssq[i] = 0.f;
        RtRegs R;
        rt_load(R, x1, WrT, m0, 0, tid);
        __syncthreads();
#pragma unroll 1
        for (int c = 0; c < 4; ++c) {
            {
                const f32x4 g = *(const f32x4*)(g2 + c * 256 + lane * 4);
#pragma unroll
                for (int i = 0; i < 8; ++i) {
                    f32x4 v = R.x[i];
                    ssq[i] += (v.x * v.x + v.y * v.y) + (v.z * v.z + v.w * v.w);
                    v = v * g;
                    u32x2 hv; hv.x = pk2(v.x, v.y); hv.y = pk2(v.z, v.w);
                    u32x2 lv; lv.x = pk2(v.x - bf2f(hv.x & 0xffffu), v.y - bf2f(hv.x >> 16)); lv.y = pk2(v.z - bf2f(hv.y & 0xffffu), v.w - bf2f(hv.y >> 16));
                    const int row = w * 8 + i;
                    *(u32x2*)(Ahi + row * RSTR + lane * 4) = hv;
                    *(u32x2*)(Alo + row * RSTR + lane * 4) = lv;
                    *(u32x2*)(xg + (size_t)(m0 + row) * 1024 + c * 256 + lane * 4) = hv;
                }
#pragma unroll
                for (int i = 0; i < 5; ++i) { const int ch = tid + 512 * i, rw = ch >> 5, c16 = ch & 31; *(u32x4*)(Whi + rw * RSTR + c16 * 8) = R.w[i]; }
            }
            if (c < 3) rt_load(R, x1, WrT, m0, c + 1, tid);
            __syncthreads();
#pragma unroll 2
            for (int s4 = 0; s4 < 4; ++s4) {
                const int ko = (ks * 4 + s4) * 16 + 8 * h;
                const bf16x8 ah = *(const bf16x8*)(Ahi + (32 * mh + r) * RSTR + ko), al = *(const bf16x8*)(Alo + (32 * mh + r) * RSTR + ko);
                const bf16x8 wh0 = *(const bf16x8*)(Whi + n0 * RSTR + ko), wh1 = *(const bf16x8*)(Whi + n1 * RSTR + ko);
                const bf16x8 wl0 = *(const bf16x8*)(Whi + (40 + n0) * RSTR + ko), wl1 = *(const bf16x8*)(Whi + (40 + n1) * RSTR + ko);
                acc0 = MFMA32(ah, wh0, acc0); acc1 = MFMA32(ah, wh1, acc1);
                acc0 = MFMA32(ah, wl0, acc0); acc1 = MFMA32(ah, wl1, acc1);
                acc0 = MFMA32(al, wh0, acc0); acc1 = MFMA32(al, wh1, acc1);
            }
            __syncthreads();
        }
#pragma unroll
        for (int i = 0; i < 16; ++i) {
            float* d = part + ((ks * 64) + 32 * mh + crow(i, h)) * 64 + r;
            d[0] = acc0[i]; d[32] = acc1[i];
        }
#pragma unroll
        for (int i = 0; i < 8; ++i) { const float sv = wave_sum(ssq[i]); if (lane == 0) ssqp[w * 8 + i] = sv; }
        if (tid < 64) hist[tid] = 0u;
        __syncthreads();
        int vl0 = 0, vl1 = 0; unsigned lr0 = 0, lr1 = 0; float w0 = 0.f, w1 = 0.f;
        if (tid < 64) {
            const int t = tid, grow = m0 + t;
            const float rs = rsqrtf(ssqp[t] * (1.f / 1024.f) + EPS);
            const float* b_grp = P.in[28]; const float* b_exp = P.in[30];
            float gl[4]; int gsel = 0; float gmax = -3e38f;
#pragma unroll
            for (int j = 0; j < 4; ++j) {
                gl[j] = rs * ((part[t * 64 + j] + part[(64 + t) * 64 + j]) + (part[(128 + t) * 64 + j] + part[(192 + t) * 64 + j])) + b_grp[j];
                if (gl[j] > gmax) { gmax = gl[j]; gsel = j; }
            }
            float gsum = 0.f;
#pragma unroll
            for (int j = 0; j < 4; ++j) gsum += __expf(gl[j] - gmax);
            const float gprob = 1.f / gsum;
            float el[8]; float emax = -3e38f;
#pragma unroll
            for (int j = 0; j < 8; ++j) {
                const int cc = 4 + gsel * 8 + j;
                el[j] = rs * ((part[t * 64 + cc] + part[(64 + t) * 64 + cc]) + (part[(128 + t) * 64 + cc] + part[(192 + t) * 64 + cc])) + b_exp[gsel * 8 + j];
                emax = fmaxf(emax, el[j]);
            }
            int i0 = 0; float v0 = -3e38f;
#pragma unroll
            for (int j = 0; j < 8; ++j) if (el[j] > v0) { v0 = el[j]; i0 = j; }
            int i1 = 0; float v1 = -3e38f;
#pragma unroll
            for (int j = 0; j < 8; ++j) if (j != i0 && el[j] > v1) { v1 = el[j]; i1 = j; }
            const float p0 = __expf(v0 - emax), p1 = __expf(v1 - emax);
            w0 = p0 / (p0 + p1) * gprob; w1 = p1 / (p0 + p1) * gprob;
            vl0 = gsel * 8 + i0; vl1 = 32 + gsel * 8 + i1;
            if (!dry) rs2[grow] = rs;
            lr0 = atomicAdd(&hist[vl0], 1u);
            lr1 = atomicAdd(&hist[vl1], 1u);
        }
        __syncthreads();
        if (tid < 64) { const unsigned hc = hist[tid]; lbase[tid] = hc ? atomicAdd(&cnt[tid * CNT_STRIDE], hc) : 0u; }
        __syncthreads();
        if (tid < 64) {
            const int grow = m0 + tid;
            const unsigned q0 = lbase[vl0] + lr0, q1 = lbase[vl1] + lr1;
            list[(size_t)vl0 * T + q0] = grow; listw[(size_t)vl0 * T + q0] = w0;
            list[(size_t)vl1 * T + q1] = grow; listw[(size_t)vl1 * T + q1] = w1;
        }
    }
    __syncthreads();
}
DI bool moe_unit(const unsigned* cnt, int u, int ntn, int vlo, int vhi, int& v, int& mt, int& nt, int& base, int& M) {
    int acc = 0, b = 0;
    for (int vv = 0; vv < vhi; ++vv) {
        const int c = (int)cnt[vv * CNT_STRIDE];
        if (vv >= vlo) {
            const int nu = ((c + 255) >> 8) * ntn;
            if (u < acc + nu) { const int loc = u - acc; v = vv; mt = loc / ntn; nt = loc - mt * ntn; base = b; M = c; return true; }
            acc += nu;
        }
        b += c;
    }
    return false;
}
DI void phase9(const Params& P, unsigned char* lds_raw, int tid, float* outp, int mode = 0) {
    asm volatile("" : "+v"(tid));
    bf16_t* lds = (bf16_t*)lds_raw; float* Ct = (float*)lds_raw;
    unsigned char* ws = P.ws;
    unsigned* ctl = (unsigned*)(ws + OFF_CTL);
    const unsigned* cnt = ctl + CW_CNT;
    const bf16_t* hi = (const bf16_t*)(ws + OFF_H2HI);
    const int* list = (const int*)(ws + OFF_LIST); const float* listw = (const float*)(ws + OFF_LISTW);
    const float* rs2 = (const float*)(ws + OFF_RS2);
    bf16_t* act = (bf16_t*)(ws + OFF_ACT);
    float* rowf = (float*)(lds_raw + 147456);
    int* rowi = (int*)(lds_raw + 147456 + 1024);
    bf16_t* Y0 = (bf16_t*)(ws + OFF_XN);
    int* cntL = (int*)(lds_raw + 147456 + 2048); int* baseL = cntL + 64; int* mtp = baseL + 64;
    if (tid < 64) {
        const int c = (int)cnt[tid * CNT_STRIDE], m = (c + 255) >> 8;
        int ci = c, mi = m;
#pragma unroll
        for (int o = 1; o < 64; o <<= 1) { const int a = __shfl_up(ci, o), b = __shfl_up(mi, o); if (tid >= o) { ci += a; mi += b; } }
        cntL[tid] = c; baseL[tid] = ci - c; mtp[tid] = mi - m;
        if (tid == 63) mtp[64] = mi;
    }
    __syncthreads();
    const int lane_ = tid & 63;
    const int mlo = mtp[lane_], mhi = mtp[lane_ + 1];
    const int total1 = 2 * mtp[64], total2a = 4 * mtp[32], total = total1 + 4 * mtp[64];
    volatile unsigned* wq = (volatile unsigned*)(lds_raw + LDS_BYTES - 64) + 8;
    int u = vbid();
    while (u < total) {
        unsigned nxt = 0;
        if (tid == 0) nxt = gridDim.x + __hip_atomic_fetch_add(ctl + CW_WQ, 1u, __ATOMIC_RELAXED, __HIP_MEMORY_SCOPE_AGENT);
        int v, mt, nt, base, M;
        if ((mode == 2 && u >= total1) || (mode == 3 && u < total1)) {
        } else if (u < total1) {
            {
                const int q = u >> 1;
                v = __builtin_ctzll(__ballot(mlo <= q && q < mhi)); mt = q - mtp[v]; nt = u & 1; base = baseL[v]; M = cntL[v];
            }
            const int e = v & 31;
            const int m0 = mt * 256;
            const int* rows = list + (size_t)v * T;
            f32x16 acc[2][4]; zero_acc2(acc);
            const ASrc As = make_a(hi, 1024, rows, M, m0, tid);
            const BSrc2 bs = make_b2((const bf16_t*)(ws + OFF_WGUT) + (size_t)e * 512 * 1024, 1024, 512, nt * 256, tid);
            float rsr = 0.f;
            if (tid < 256 && m0 + tid < M) rsr = rs2[rows[m0 + tid]];
            __syncthreads();
            gemm_mainloop2(acc, As, bs, 1024, lds, tid);
            if (tid < 256) rowf[tid] = rsr;
#pragma unroll 1
            for (int half = 0; half < 2; ++half) {
                const int nq = nt * 2 + half;
                dump_acc2(acc, Ct, tid, half);
                __syncthreads();
                for (int it = tid; it < 256 * 16; it += NTHREADS) {
                    const int row = it >> 4, q = it & 15, wn_ = q >> 3, c = (q & 7) * 4;
                    if (m0 + row < M) {
                        const float rs = rowf[row];
                        const f32x4 gt = *(const f32x4*)(Ct + row * CT_STRIDE + wn_ * 64 + c) * rs;
                        const f32x4 up = *(const f32x4*)(Ct + row * CT_STRIDE + wn_ * 64 + 32 + c) * rs;
                        u32x2 o; o.x = pk2(gt.x * sigmoidf(gt.x) * up.x, gt.y * sigmoidf(gt.y) * up.y); o.y = pk2(gt.z * sigmoidf(gt.z) * up.z, gt.w * sigmoidf(gt.w) * up.w);
                        st_wt8(act + (size_t)(base + m0 + row) * 256 + nq * 64 + wn_ * 32 + c, o);
                    }
                }
                __syncthreads();
            }
            unit_signal(ctl + CW_DONE + v * 64 + mt, tid);
        } else {
            const bool slot1 = u >= total1 + total2a;
            {
                const int q = (u - total1) >> 2;
                v = __builtin_ctzll(__ballot(mlo <= q && q < mhi)); mt = q - mtp[v]; nt = (u - total1) & 3; base = baseL[v]; M = cntL[v];
            }
            const int e = v & 31;
            const int m0 = mt * 256;
            const bf16_t* A = act + (size_t)base * 256;
            f32x16 acc[2][4]; zero_acc2(acc);
            const ASrc As = make_a(A, 256, nullptr, M, m0, tid);
            const BSrc2 bs = make_b2((const bf16_t*)(ws + OFF_WDT) + (size_t)e * 1024 * 256, 256, 1024, nt * 256, tid);
            int tokr = 0; float wgtr = 0.f;
            if (tid < 256) { const int rr = m0 + tid < M ? m0 + tid : M - 1; tokr = list[(size_t)v * T + rr]; wgtr = listw[(size_t)v * T + rr]; }
            unit_wait(ctl + CW_DONE + v * 64 + mt, 2u, tid);
            gemm_mainloop2(acc, As, bs, 256, lds, tid);
            if (tid < 256) { rowi[tid] = tokr; rowf[tid] = wgtr; }
            if (slot1) { const int eg = e >> 3; unit_wait(ctl + CW_S0DONE + eg * 32, (unsigned)(4 * (mtp[8 * eg + 8] - mtp[8 * eg])), tid); }
#pragma unroll 1
            for (int half = 0; half < 2; ++half) {
                const int n0 = nt * 256 + half * 128;
                dump_acc2(acc, Ct, tid, half);
                __syncthreads();
                {
                    const int c4 = tid & 31, r0 = tid >> 5;
                    if (!slot1) {
#pragma unroll 4
                        for (int j = 0; j < 16; ++j) {
                            const int row = r0 + 16 * j;
                            if (m0 + row < M) {
                                const f32x4 cv = *(const f32x4*)(Ct + row * CT_STRIDE + c4 * 4) * rowf[row];
                                u32x2 o; o.x = pk2(cv.x, cv.y); o.y = pk2(cv.z, cv.w);
                                st_wt8(Y0 + (size_t)rowi[row] * 1024 + n0 + c4 * 4, o);
                            }
                        }
                    } else {
#pragma unroll 1
                        for (int jb = 0; jb < 16; jb += 8) {
                            f32x4 ov[8]; u32x2 yv[8];
#pragma unroll
                            for (int j = 0; j < 8; ++j) {
                                const size_t o = (size_t)rowi[r0 + 16 * (jb + j)] * 1024 + n0 + c4 * 4;
                                ov[j] = *(const f32x4*)(outp + o);
                                yv[j] = *(const u32x2*)(Y0 + o);
                            }
#pragma unroll
                            for (int j = 0; j < 8; ++j) {
                                const int row = r0 + 16 * (jb + j);
                                if (m0 + row < M) {
                                    const f32x4 cv = *(const f32x4*)(Ct + row * CT_STRIDE + c4 * 4) * rowf[row];
                                    f32x4 nv = ov[j] + cv;
                                    nv.x += bf2f(yv[j].x & 0xffffu); nv.y += bf2f(yv[j].x >> 16); nv.z += bf2f(yv[j].y & 0xffffu); nv.w += bf2f(yv[j].y >> 16);
                                    *(f32x4*)(outp + (size_t)rowi[row] * 1024 + n0 + c4 * 4) = nv;
                                }
                            }
                        }
                    }
                }
                __syncthreads();
            }
            if (!slot1) unit_signal(ctl + CW_S0DONE + (e >> 3) * 32, tid);
        }
        if (tid == 0) wq[0] = nxt;
        __syncthreads();
        u = __builtin_amdgcn_readfirstlane((int)wq[0]);
    }
    __syncthreads();
}

constexpr int NPHASES = 10;
__global__ void __launch_bounds__(NTHREADS, 2) mk(Params P) {
    extern __shared__ __attribute__((aligned(16))) unsigned char lds_raw[];
    const int tid = threadIdx.x;
    volatile unsigned* misc = (volatile unsigned*)(lds_raw + LDS_BYTES - 64);
    if (tid < 2) misc[tid] = 0u;
    __syncthreads();
    XcdBarrier bar; bar.bar = nullptr; bar.x = 0; bar.st = nullptr;
    const bool multi = (P.ph_hi - P.ph_lo) > 1;
    if (multi) bar = xcd_barrier_post((unsigned*)(P.ws + OFF_CTL) + CW_BAR, misc);
    const int lo = P.ph_lo, hi = P.ph_hi;
#define IN(k) (lo <= (k) && (k) < hi)
#define SEAM(k) do { if (IN(k) && IN((k) + 1)) xcd_barrier(bar); } while (0)
#ifndef PROBE_PHASE
#define PROBE_PHASE -1
#endif
#ifndef PROBE_XMODE
#define PROBE_XMODE 0
#endif
#define RUN(k, call, calldry) do { if (IN(k)) { call; if (PROBE_PHASE == (k) || PROBE_PHASE == 100 + (k) / 4) { xcd_barrier(bar); calldry; } } } while (0)
    RUN(0, phase0(P, lds_raw, tid), phase0(P, lds_raw, tid, PROBE_XMODE));
    SEAM(0);
    RUN(1, phase1(P, lds_raw, tid), phase1(P, lds_raw, tid, PROBE_XMODE));
    SEAM(1);
    RUN(2, phase2(P, lds_raw, tid), phase2(P, lds_raw, tid));
    SEAM(2);
    RUN(4, phase4(P, lds_raw, tid), phase4(P, lds_raw, tid, PROBE_XMODE ? PROBE_XMODE : 3));
    SEAM(4);
    RUN(5, phase5(P, lds_raw, tid), phase5(P, lds_raw, tid));
    SEAM(5);
    RUN(7, phase7(P, lds_raw, tid), phase7(P, lds_raw, tid, PROBE_XMODE));
    SEAM(7);
    if (IN(8)) {
        if (PROBE_PHASE == 8) {
            phase8(P, lds_raw, tid); xcd_barrier(bar);
            if (blockIdx.x == 0 && tid < 64) ((unsigned*)(P.ws + OFF_CTL))[CW_CNT + tid * CNT_STRIDE] = 0u;
            xcd_barrier(bar);
        }
        phase8(P, lds_raw, tid);
    }
    SEAM(8);
    if (IN(9)) {
        if (PROBE_PHASE == 9) {
            unsigned* ctl = (unsigned*)(P.ws + OFF_CTL);
            phase9(P, lds_raw, tid, PROBE_XMODE == 0 ? (float*)(P.ws + OFF_KC) : P.out);
            xcd_barrier(bar);
            if (blockIdx.x == 0) {
                if (PROBE_XMODE == 0) { for (int i = tid; i < 4096; i += NTHREADS) ctl[CW_DONE + i] = 0u; if (tid < 4) ctl[CW_S0DONE + tid * 32] = 0u; }
                if (tid == 0) ctl[CW_WQ] = 0u;
            }
            xcd_barrier(bar);
            phase9(P, lds_raw, tid, PROBE_XMODE == 0 ? P.out : (float*)(P.ws + OFF_KC), PROBE_XMODE >= 2 ? PROBE_XMODE : 0);
        } else phase9(P, lds_raw, tid, P.out);
    }
#undef RUN
#undef IN
#undef SEAM
}

extern "C" void kernel_launch(void* const* d_in, const int* in_sizes, int n_in, void* d_out, int out_size, void* d_ws, size_t ws_size, hipStream_t stream) {
    static int grid = 0;
    if (grid == 0) {
        if (n_in != 34 || out_size != T * DM || ws_size < WS_END) {
            fprintf(stderr, "kernel_launch: unexpected shapes: n_in %d out %d ws %zu (need %zu)\n", n_in, out_size, ws_size, (size_t)WS_END);
            grid = -1; return;
        }
        int dev = 0, cus = 0;
        hipGetDevice(&dev);
        hipDeviceGetAttribute(&cus, hipDeviceAttributeMultiprocessorCount, dev);
        hipFuncSetAttribute((const void*)mk, hipFuncAttributeMaxDynamicSharedMemorySize, LDS_BYTES);
        int per_cu = 0;
        hipOccupancyMaxActiveBlocksPerMultiprocessor(&per_cu, (const void*)mk, NTHREADS, LDS_BYTES);
        (void)hipGetLastError();
        if (per_cu < 1) fprintf(stderr, "kernel_launch: occupancy query says %d blocks/CU\n", per_cu);
        grid = cus > 0 ? cus : 256;
    }
    if (grid < 0) return;
    hipMemsetAsync((char*)d_ws + OFF_CTL, 0, CTL_BYTES, stream);
    Params p{};
    for (int i = 0; i < 34; ++i) p.in[i] = (const float*)d_in[i];
    p.out = (float*)d_out; p.ws = (unsigned char*)d_ws;
#ifndef MK_ONE_LAUNCH
    for (int ph = 0; ph < NPHASES; ++ph) {
        p.ph_lo = ph; p.ph_hi = ph + 1;
        hipLaunchKernelGGL(mk, dim3(grid), dim3(NTHREADS), LDS_BYTES, stream, p);
    }
#else
    p.ph_lo = 0; p.ph_hi = NPHASES;
    hipLaunchKernelGGL(mk, dim3(grid), dim3(NTHREADS), LDS_BYTES, stream, p);
#endif
}
```
